# Optimizing an MI355X kernel written in HIP

```python
import math
import jax
import jax.numpy as jnp
from jax import lax
import numpy as np

D_MODEL = 1024
BATCH = 16
SEQ = 256
DEPTH = 4
DEC_BATCH = 2
DEC_SEQ = 4096
PAST_LEN = 256

GRID_W = 64
N_AB = (DEPTH + 1) // 2
N_CD = DEPTH // 2
CHUNK = 64
NORM_EPS = 1e-6
POS_BASE = 10000.0
CONV_W = 4
CONV_PAD_LO = 1
GLA_HEADS = 4
GLA_DV = D_MODEL // 8
GLA_DK = GLA_DV // 2
GLA_RANK = 16
GLA_TAU = 16.0
RG_WIDTH = D_MODEL // 2
RG_BLOCKS = 8
RG_BLOCK = RG_WIDTH // RG_BLOCKS
RG_C = 8.0
S5_WIDTH = D_MODEL // 2
S5_GROUP = 16
S5_GROUPS = S5_WIDTH // S5_GROUP
S5_STATE = 64
DN_HEADS = 4
DN_DK = D_MODEL // 8
DN_DV = D_MODEL // 8
DN_CONV_CH = 2 * DN_HEADS * DN_DK + DN_HEADS * DN_DV
AB_IN = 2 * GLA_HEADS * GLA_DK + 2 * GLA_HEADS * GLA_DV + 2 * GLA_RANK + 2 * RG_WIDTH
AB_OUT = GLA_HEADS * GLA_DV + RG_WIDTH
CD_IN = S5_WIDTH + DN_CONV_CH + DN_HEADS * DN_DV + 4 * DN_HEADS
CD_OUT = S5_WIDTH + DN_HEADS * DN_DV
D_FF = -(-8 * D_MODEL // (3 * 256)) * 256

kernel_name = 'hybrid_bidir_recurrent_diffusion_step'


def _split(x, sizes):
    parts, start = [], 0
    for s in sizes:
        parts.append(x[..., start:start + s])
        start += s
    return parts


def _flip(x):
    return jnp.flip(x, axis=1)


def rmsnorm(x, w):
    xf = x.astype(jnp.float32)
    y = xf * lax.rsqrt(jnp.mean(xf * xf, axis=-1, keepdims=True) + NORM_EPS)
    return (y * w.astype(jnp.float32)).astype(x.dtype)


def _head_rms(x, w):
    return x * lax.rsqrt(jnp.mean(x * x, axis=-1, keepdims=True) + NORM_EPS) * w.astype(jnp.float32)


def _l2norm(x):
    return x * lax.rsqrt(jnp.sum(x * x, axis=-1, keepdims=True) + 1e-6)


def centred_dwconv(x, w, b=None):
    n_tok = x.shape[1]
    xp = jnp.pad(x, ((0, 0), (CONV_PAD_LO, CONV_W - 1 - CONV_PAD_LO), (0, 0)))
    y = xp[:, 0:n_tok] * w[0]
    for j in range(1, CONV_W):
        y = y + xp[:, j:j + n_tok] * w[j]
    return y if b is None else y + b


def diag_scan(a, b, h0):
    def comb(left, right):
        a_l, b_l = left
        a_r, b_r = right
        return a_r * a_l, a_r * b_l + b_r
    a_cum, h = lax.associative_scan(comb, (a, b), axis=1)
    return h + a_cum * h0[:, None]


def gla_chunked(q, k, v, log_a, s0):
    bsz, n_tok, n_h, _ = q.shape
    dv = v.shape[-1]
    n_chunks = n_tok // CHUNK
    blk = lambda t: jnp.moveaxis(t.reshape((bsz, n_chunks, CHUNK) + t.shape[2:]), 2, 3)
    q, k, v, log_a = blk(q), blk(k), blk(v), blk(log_a)
    b = jnp.cumsum(log_a, axis=3)
    b_end = b[:, :, :, -1:]
    q_dec = q * jnp.exp(b)
    k_inv = k * jnp.exp(-b)
    k_end = k * jnp.exp(b_end - b)
    causal = jnp.tril(jnp.ones((CHUNK, CHUNK), bool))
    att = jnp.where(causal, jnp.einsum('bnhtk,bnhsk->bnhts', q_dec, k_inv), 0.0)
    o_intra = jnp.einsum('bnhts,bnhsv->bnhtv', att, v)
    kv = jnp.einsum('bnhsk,bnhsv->bnhkv', k_end, v)
    dec_end = jnp.exp(b_end[:, :, :, 0])

    def step(state, inp):
        d, kv_c = inp
        return d[..., None] * state + kv_c, state

    s_fin, s_prev = lax.scan(step, s0, (jnp.moveaxis(dec_end, 1, 0), jnp.moveaxis(kv, 1, 0)))
    o_inter = jnp.einsum('bnhtk,nbhkv->bnhtv', q_dec, s_prev)
    o = jnp.transpose(o_intra + o_inter, (0, 1, 3, 2, 4)).reshape(bsz, n_tok, n_h, dv)
    return o, s_fin


def delta_chunked(q, k, v, beta, log_alpha, s0):
    bsz, n_tok, n_h, _ = q.shape
    dv = v.shape[-1]
    n_chunks = n_tok // CHUNK
    blk = lambda t: jnp.moveaxis(t.reshape((bsz, n_chunks, CHUNK) + t.shape[2:]), 2, 3)
    q, k, v, beta, log_alpha = blk(q), blk(k), blk(v), blk(beta), blk(log_alpha)
    g = jnp.cumsum(log_alpha, axis=-1)
    diff = g[..., :, None] - g[..., None, :]
    causal = jnp.tril(jnp.ones((CHUNK, CHUNK), bool))
    strict = jnp.tril(jnp.ones((CHUNK, CHUNK), bool), -1)
    dec = jnp.exp(jnp.where(causal, diff, -jnp.inf))
    kk = jnp.einsum('bnhtk,bnhsk->bnhts', k, k)
    lhs = jnp.eye(CHUNK, dtype=q.dtype) + jnp.where(strict, beta[..., :, None] * kk * dec, 0.0)
    rhs = jnp.concatenate([beta[..., None] * v, (beta * jnp.exp(g))[..., None] * k], axis=-1)
    sol = lax.linalg.triangular_solve(lhs, rhs, left_side=True, lower=True, unit_diagonal=True)
    u_pre, w_pre = sol[..., :dv], sol[..., dv:]
    qk = jnp.einsum('bnhtk,bnhsk->bnhts', q, k) * dec
    q_dec = q * jnp.exp(g)[..., None]
    k_end = k * jnp.exp(g[..., -1:] - g)[..., None]
    g_end = jnp.exp(g[..., -1])

    def step(state, inp):
        u_c, w_c, qk_c, qd_c, ke_c, ge_c = inp
        w_new = u_c - jnp.einsum('bhck,bhkv->bhcv', w_c, state)
        o = jnp.einsum('bhck,bhkv->bhcv', qd_c, state) + jnp.einsum('bhts,bhsv->bhtv', qk_c, w_new)
        state = ge_c[..., None, None] * state + jnp.einsum('bhck,bhcv->bhkv', ke_c, w_new)
        return state, o

    xs = tuple(jnp.moveaxis(t, 1, 0) for t in (u_pre, w_pre, qk, q_dec, k_end, g_end))
    s_fin, o = lax.scan(step, s0, xs)
    o = jnp.transpose(o, (1, 0, 3, 2, 4)).reshape(bsz, n_tok, n_h, dv)
    return o, s_fin


def rglru_scan(x, wa, ba, wx, bx, lam, h0):
    bsz, n_tok, width = x.shape
    xb = x.reshape(bsz, n_tok, RG_BLOCKS, RG_BLOCK)
    r = jax.nn.sigmoid(jnp.einsum('blnj,njk->blnk', xb, wa).reshape(bsz, n_tok, width) + ba)
    i = jax.nn.sigmoid(jnp.einsum('blnj,njk->blnk', xb, wx).reshape(bsz, n_tok, width) + bx)
    log_a = -RG_C * r * jax.nn.softplus(-lam)
    a = jnp.exp(log_a)
    b = jnp.sqrt(-jnp.expm1(2.0 * log_a)) * (i * x)
    h = diag_scan(a, b, h0)
    return h, h[:, -1]


def s5_scan(u, lam_re, lam_im, log_dt, b_re, b_im, c_re, c_im, h0):
    lam = lax.complex(lam_re, lam_im)
    a_bar = jnp.exp(lam * jnp.exp(log_dt)[:, None])
    b_bar = ((a_bar - 1.0) / lam)[..., None] * lax.complex(b_re, b_im)
    bu = jnp.einsum('gpj,blgj->blgp', b_bar, u.astype(jnp.complex64))
    h = diag_scan(jnp.broadcast_to(a_bar, bu.shape), bu, h0)
    y = jnp.einsum('gjp,blgp->blgj', lax.complex(c_re, c_im), h).real
    return y, h[:, -1]


def mixer_ab(h, p, j, s_gla, s_rg):
    bsz, n_tok, _ = h.shape
    f32 = jnp.float32
    proj = jnp.einsum('bld,de->ble', h, p['ab_w_in'][j]).astype(f32)
    q, k, v, g, lr_f, lr_b, rx, rgate = _split(proj, (GLA_HEADS * GLA_DK, GLA_HEADS * GLA_DK, GLA_HEADS * GLA_DV, GLA_HEADS * GLA_DV, GLA_RANK, GLA_RANK, RG_WIDTH, RG_WIDTH))
    heads = lambda t, d: t.reshape(bsz, n_tok, GLA_HEADS, d)
    q = heads(q, GLA_DK) * GLA_DK ** -0.5
    k = heads(k, GLA_DK)
    v = heads(v, GLA_DV)
    wg2 = p['gla_wg2'][j].astype(f32)
    bg = p['gla_bg'][j].astype(f32)
    la_f = heads(jax.nn.log_sigmoid(lr_f @ wg2[0] + bg[0]), GLA_DK) / GLA_TAU
    la_b = heads(jax.nn.log_sigmoid(lr_b @ wg2[1] + bg[1]), GLA_DK) / GLA_TAU
    s_gla = s_gla.astype(f32)
    o_f, sg_f = gla_chunked(q, k, v, la_f, s_gla[:, 0])
    o_b, sg_b = gla_chunked(_flip(q), _flip(k), _flip(v), _flip(la_b), s_gla[:, 1])
    o_gla = _head_rms(o_f + _flip(o_b), p['gla_norm_w'][j]) * jax.nn.silu(heads(g, GLA_DV))
    xc = centred_dwconv(rx, p['rg_conv_w'][j].astype(f32), p['rg_conv_b'][j].astype(f32))
    wa, ba, wx, bx, lam = (p[name][j].astype(f32) for name in ('rg_wa', 'rg_ba', 'rg_wx', 'rg_bx', 'rg_lam'))
    s_rg = s_rg.astype(f32)
    h_f, sr_f = rglru_scan(xc, wa[0], ba[0], wx[0], bx[0], lam[0], s_rg[:, 0])
    h_b, sr_b = rglru_scan(_flip(xc), wa[1], ba[1], wx[1], bx[1], lam[1], s_rg[:, 1])
    o_rg = jax.nn.gelu(rgate) * (h_f + _flip(h_b))
    mixed = jnp.concatenate([o_gla.reshape(bsz, n_tok, GLA_HEADS * GLA_DV), o_rg], axis=-1).astype(h.dtype)
    out = jnp.einsum('ble,ed->bld', mixed, p['ab_w_out'][j])
    return out, jnp.stack([sg_f, sg_b], axis=1), jnp.stack([sr_f, sr_b], axis=1)


def mixer_cd(h, p, j, s_s5, s_dn):
    bsz, n_tok, _ = h.shape
    f32 = jnp.float32
    proj = jnp.einsum('bld,de->ble', h, p['cd_w_in'][j]).astype(f32)
    u, qkv, z, a_in, b_in = _split(proj, (S5_WIDTH, DN_CONV_CH, DN_HEADS * DN_DV, 2 * DN_HEADS, 2 * DN_HEADS))
    lam_re, lam_im, log_dt, b_re, b_im, c_re, c_im, s5_d, glu_w, glu_b = (p[name][j].astype(f32) for name in ('s5_lam_re', 's5_lam_im', 's5_log_dt', 's5_b_re', 's5_b_im', 's5_c_re', 's5_c_im', 's5_d', 's5_glu_w', 's5_glu_b'))
    ug = u.reshape(bsz, n_tok, S5_GROUPS, S5_GROUP)
    s_s5 = s_s5.astype(f32)
    h0 = lax.complex(s_s5[..., 0], s_s5[..., 1])
    y_f, h5_f = s5_scan(ug, lam_re[0], lam_im[0], log_dt[0], b_re[0], b_im[0], c_re[0], c_im[0], h0[:, 0])
    y_b, h5_b = s5_scan(_flip(ug), lam_re[1], lam_im[1], log_dt[1], b_re[1], b_im[1], c_re[1], c_im[1], h0[:, 1])
    y = (y_f + _flip(y_b)).reshape(bsz, n_tok, S5_WIDTH) + s5_d * u
    zg = jax.nn.gelu(y)
    o_s5 = zg * jax.nn.sigmoid(zg @ glu_w + glu_b)
    h5 = jnp.stack([h5_f, h5_b], axis=1)
    s5_new = jnp.stack([h5.real, h5.imag], axis=-1)
    conv_w, a_log, dt_bias = (p[name][j].astype(f32) for name in ('dn_conv_w', 'dn_a_log', 'dn_dt_bias'))
    qkv = jax.nn.silu(centred_dwconv(qkv, conv_w))
    q, k, v = _split(qkv, (DN_HEADS * DN_DK, DN_HEADS * DN_DK, DN_HEADS * DN_DV))
    q = _l2norm(q.reshape(bsz, n_tok, DN_HEADS, DN_DK)) * DN_DK ** -0.5
    k = _l2norm(k.reshape(bsz, n_tok, DN_HEADS, DN_DK))
    v = v.reshape(bsz, n_tok, DN_HEADS, DN_DV)
    log_alpha = -jnp.exp(a_log) * jax.nn.softplus(a_in.reshape(bsz, n_tok, 2, DN_HEADS) + dt_bias)
    beta = jax.nn.sigmoid(b_in.reshape(bsz, n_tok, 2, DN_HEADS))
    s_dn = s_dn.astype(f32)
    o_f, sd_f = delta_chunked(q, k, v, beta[:, :, 0], log_alpha[:, :, 0], s_dn[:, 0])
    o_b, sd_b = delta_chunked(_flip(q), _flip(k), _flip(v), _flip(beta[:, :, 1]), _flip(log_alpha[:, :, 1]), s_dn[:, 1])
    o_dn = _head_rms(o_f + _flip(o_b), p['dn_norm_w'][j]) * jax.nn.silu(z.reshape(bsz, n_tok, DN_HEADS, DN_DV))
    mixed = jnp.concatenate([o_s5, o_dn.reshape(bsz, n_tok, DN_HEADS * DN_DV)], axis=-1).astype(h.dtype)
    out = jnp.einsum('ble,ed->bld', mixed, p['cd_w_out'][j])
    return out, s5_new, jnp.stack([sd_f, sd_b], axis=1)


def swiglu(x, w_gate, w_up, w_down):
    return jnp.einsum('blf,fd->bld', jax.nn.silu(x @ w_gate) * (x @ w_up), w_down)


def grid_pos_embed(n_tokens, d):
    rows = n_tokens // GRID_W
    r, col = jnp.meshgrid(jnp.arange(rows, dtype=jnp.float32), jnp.arange(GRID_W, dtype=jnp.float32), indexing='ij')
    quarter = d // 4
    freqs = jnp.exp(-math.log(POS_BASE) * jnp.arange(quarter, dtype=jnp.float32) / quarter)
    er = r.reshape(-1, 1) * freqs
    ec = col.reshape(-1, 1) * freqs
    return jnp.concatenate([jnp.sin(er), jnp.cos(er), jnp.sin(ec), jnp.cos(ec)], axis=-1)


def trunk(x, cvec, s_gla, s_rg, s_s5, s_dn, p):
    gla_out, rg_out, s5_out, dn_out = [], [], [], []
    for l in range(DEPTH):
        j = l // 2
        mod = jnp.einsum('bd,de->be', jax.nn.silu(cvec), p['w_mod'][l]) + p['b_mod'][l]
        shift1, scale1, gate1, shift2, scale2, gate2 = jnp.split(mod[:, None, :].astype(x.dtype), 6, axis=-1)
        hn = rmsnorm(x, p['norm1_w'][l]) * (1.0 + scale1) + shift1
        if l % 2 == 0:
            out, sg, sr = mixer_ab(hn, p, j, s_gla[:, j], s_rg[:, j])
            gla_out.append(sg)
            rg_out.append(sr)
        else:
            out, ss, sd = mixer_cd(hn, p, j, s_s5[:, j], s_dn[:, j])
            s5_out.append(ss)
            dn_out.append(sd)
        x = x + gate1 * out
        hn = rmsnorm(x, p['norm2_w'][l]) * (1.0 + scale2) + shift2
        x = x + gate2 * swiglu(hn, p['ffn_w_gate'][l], p['ffn_w_up'][l], p['ffn_w_down'][l])
    y = rmsnorm(x, p['final_norm_w'])
    return y, jnp.stack(gla_out, axis=1), jnp.stack(rg_out, axis=1), jnp.stack(s5_out, axis=1), jnp.stack(dn_out, axis=1)


def setup_inputs(seed: int = 0) -> dict:
    key = jax.random.key(seed)
    keys = iter(jax.random.split(key, 64))
    f32 = jnp.float32

    def nrm(shape, scale=1.0):
        return jax.random.normal(next(keys), shape, f32) * scale

    def unif(shape, lo, hi):
        return jax.random.uniform(next(keys), shape, f32, lo, hi)

    def gain(shape):
        return 1.0 + nrm(shape, 0.01)

    rg_a = unif((N_AB, 2, RG_WIDTH), 0.9, 0.999) ** (1.0 / RG_C)
    dn_dt = jnp.exp(unif((N_CD, 2, DN_HEADS), math.log(1e-3), math.log(1e-1)))
    s5_n = jnp.pi * jnp.arange(S5_STATE, dtype=f32)
    return {
        'x_prompt': nrm((BATCH, SEQ, D_MODEL)),
        'x_sample': nrm((DEC_BATCH, DEC_SEQ, D_MODEL)),
        'state_gla': nrm((DEC_BATCH, N_AB, 2, GLA_HEADS, GLA_DK, GLA_DV), 0.3),
        'state_rglru': nrm((DEC_BATCH, N_AB, 2, RG_WIDTH), 0.5),
        'state_s5': nrm((DEC_BATCH, N_CD, 2, S5_GROUPS, S5_STATE, 2), 0.1),
        'state_delta': nrm((DEC_BATCH, N_CD, 2, DN_HEADS, DN_DK, DN_DV), 0.1),
        'c': nrm((DEC_BATCH, D_MODEL)),
        'c_ctx': nrm((D_MODEL,)),
        'norm1_w': gain((DEPTH, D_MODEL)),
        'norm2_w': gain((DEPTH, D_MODEL)),
        'w_mod': nrm((DEPTH, D_MODEL, 6 * D_MODEL), 0.5 * D_MODEL ** -0.5),
        'b_mod': nrm((DEPTH, 6 * D_MODEL), 0.02),
        'ab_w_in': nrm((N_AB, D_MODEL, AB_IN), D_MODEL ** -0.5),
        'ab_w_out': nrm((N_AB, AB_OUT, D_MODEL), AB_OUT ** -0.5),
        'gla_wg2': nrm((N_AB, 2, GLA_RANK, GLA_HEADS * GLA_DK), GLA_RANK ** -0.5),
        'gla_bg': nrm((N_AB, 2, GLA_HEADS * GLA_DK), 0.5),
        'gla_norm_w': gain((N_AB, GLA_DV)),
        'rg_conv_w': nrm((N_AB, CONV_W, RG_WIDTH), CONV_W ** -0.5),
        'rg_conv_b': nrm((N_AB, RG_WIDTH), 0.02),
        'rg_wa': nrm((N_AB, 2, RG_BLOCKS, RG_BLOCK, RG_BLOCK), RG_BLOCK ** -0.5),
        'rg_ba': nrm((N_AB, 2, RG_WIDTH), 0.02),
        'rg_wx': nrm((N_AB, 2, RG_BLOCKS, RG_BLOCK, RG_BLOCK), RG_BLOCK ** -0.5),
        'rg_bx': nrm((N_AB, 2, RG_WIDTH), 0.02),
        'rg_lam': jnp.log(rg_a) - jnp.log1p(-rg_a),
        'cd_w_in': nrm((N_CD, D_MODEL, CD_IN), D_MODEL ** -0.5),
        'cd_w_out': nrm((N_CD, CD_OUT, D_MODEL), CD_OUT ** -0.5),
        's5_lam_re': -0.5 + nrm((N_CD, 2, S5_GROUPS, S5_STATE), 0.01),
        's5_lam_im': s5_n + nrm((N_CD, 2, S5_GROUPS, S5_STATE), 0.01),
        's5_log_dt': unif((N_CD, 2, S5_GROUPS), math.log(1e-3), math.log(1e-1)),
        's5_b_re': nrm((N_CD, 2, S5_GROUPS, S5_STATE, S5_GROUP), (2 * S5_GROUP) ** -0.5),
        's5_b_im': nrm((N_CD, 2, S5_GROUPS, S5_STATE, S5_GROUP), (2 * S5_GROUP) ** -0.5),
        's5_c_re': nrm((N_CD, 2, S5_GROUPS, S5_GROUP, S5_STATE), (2 * S5_STATE) ** -0.5),
        's5_c_im': nrm((N_CD, 2, S5_GROUPS, S5_GROUP, S5_STATE), (2 * S5_STATE) ** -0.5),
        's5_d': nrm((N_CD, S5_WIDTH)),
        's5_glu_w': nrm((N_CD, S5_WIDTH, S5_WIDTH), S5_WIDTH ** -0.5),
        's5_glu_b': nrm((N_CD, S5_WIDTH), 0.02),
        'dn_conv_w': nrm((N_CD, CONV_W, DN_CONV_CH), CONV_W ** -0.5),
        'dn_a_log': jnp.log(unif((N_CD, 2, DN_HEADS), 1.0, 16.0)),
        'dn_dt_bias': dn_dt + jnp.log(-jnp.expm1(-dn_dt)),
        'dn_norm_w': gain((N_CD, DN_DV)),
        'ffn_w_gate': nrm((DEPTH, D_MODEL, D_FF), D_MODEL ** -0.5),
        'ffn_w_up': nrm((DEPTH, D_MODEL, D_FF), D_MODEL ** -0.5),
        'ffn_w_down': nrm((DEPTH, D_FF, D_MODEL), D_FF ** -0.5),
        'final_norm_w': gain((D_MODEL,)),
    }


def reference(x_prompt, x_sample, state_gla, state_rglru, state_s5, state_delta, c, c_ctx,
              norm1_w, norm2_w, w_mod, b_mod, ab_w_in, ab_w_out, gla_wg2, gla_bg, gla_norm_w,
              rg_conv_w, rg_conv_b, rg_wa, rg_ba, rg_wx, rg_bx, rg_lam, cd_w_in, cd_w_out,
              s5_lam_re, s5_lam_im, s5_log_dt, s5_b_re, s5_b_im, s5_c_re, s5_c_im, s5_d, s5_glu_w, s5_glu_b,
              dn_conv_w, dn_a_log, dn_dt_bias, dn_norm_w, ffn_w_gate, ffn_w_up, ffn_w_down, final_norm_w):
    p = {
        'norm1_w': norm1_w, 'norm2_w': norm2_w, 'w_mod': w_mod, 'b_mod': b_mod,
        'ab_w_in': ab_w_in, 'ab_w_out': ab_w_out, 'gla_wg2': gla_wg2, 'gla_bg': gla_bg, 'gla_norm_w': gla_norm_w,
        'rg_conv_w': rg_conv_w, 'rg_conv_b': rg_conv_b, 'rg_wa': rg_wa, 'rg_ba': rg_ba, 'rg_wx': rg_wx,
        'rg_bx': rg_bx, 'rg_lam': rg_lam, 'cd_w_in': cd_w_in, 'cd_w_out': cd_w_out,
        's5_lam_re': s5_lam_re, 's5_lam_im': s5_lam_im, 's5_log_dt': s5_log_dt, 's5_b_re': s5_b_re,
        's5_b_im': s5_b_im, 's5_c_re': s5_c_re, 's5_c_im': s5_c_im, 's5_d': s5_d, 's5_glu_w': s5_glu_w,
        's5_glu_b': s5_glu_b, 'dn_conv_w': dn_conv_w, 'dn_a_log': dn_a_log, 'dn_dt_bias': dn_dt_bias,
        'dn_norm_w': dn_norm_w, 'ffn_w_gate': ffn_w_gate, 'ffn_w_up': ffn_w_up, 'ffn_w_down': ffn_w_down,
        'final_norm_w': final_norm_w,
    }
    n_req = x_prompt.shape[0]
    zeros_like_cache = lambda s: jnp.zeros((n_req,) + s.shape[1:], jnp.float32)
    c_prompt = jnp.broadcast_to(c_ctx, (n_req, c_ctx.shape[0]))
    y_prompt, new_state_gla, new_state_rglru, new_state_s5, new_state_delta = trunk(
        x_prompt, c_prompt, zeros_like_cache(state_gla), zeros_like_cache(state_rglru),
        zeros_like_cache(state_s5), zeros_like_cache(state_delta), p)
    x_lat = x_sample + grid_pos_embed(x_sample.shape[1], x_sample.shape[2]).astype(x_sample.dtype)
    y_sample = trunk(x_lat, c, state_gla, state_rglru, state_s5, state_delta, p)[0]
    return (y_prompt, y_sample, new_state_gla, new_state_rglru, new_state_s5, new_state_delta)
```

```cpp
#include <hip/hip_runtime.h>
#include <hip/hip_cooperative_groups.h>
#include <cstdio>
namespace cg = cooperative_groups;
__device__ __forceinline__ int otid() { int t = threadIdx.x; asm volatile("" : "+v"(t)); return t; }
namespace pg8 {
#define PG8_LAS __attribute__((address_space(3)))
typedef unsigned short bf16_t;
typedef short bf16x8 __attribute__((ext_vector_type(8)));
typedef float f32x4 __attribute__((ext_vector_type(4)));
typedef unsigned u32x4 __attribute__((ext_vector_type(4)));
constexpr int BM = 256, BK = 64, HALF = 128, HTB = HALF * BK * 2  , STAGE_BYTES = 8 * HTB, NXCD = 8, WGM = 8;

__host__ __device__ __forceinline__ int lds_byte(int r, int c) { const int st = (r >> 4) * 2 + (c >> 5), rr = r & 15, cc = c & 31, ob = rr * 64 + cc * 2; return st * 1024 + (ob ^ (((ob >> 9) & 1) << 5)); }
__host__ __device__ __forceinline__ void stage_rc(int b, int& R, int& C) { const int st = b / 1024, sb = b % 1024, swz = sb ^ (((sb >> 9) & 1) << 5); R = (st >> 1) * 16 + swz / 64; C = (st & 1) * 32 + (swz % 64) / 2; }
__host__ __device__ __forceinline__ int perm32(int rho) { const int n = rho >> 4, i = rho & 15; return 8 * (i >> 2) + 4 * n + (i & 3); }

struct Unit { int pm, pn; };
struct Gemm { const bf16_t* A; const bf16_t* Bt; int M, N, K; };

struct StaticOrder {
    int nM, nN, nwg, G, c;
    __host__ __device__ void init(int M, int N, int G_, int c_) { nM = M / BM; nN = N / BM; nwg = nM * nN; G = G_; c = c_; }
    __host__ __device__ bool next(int i, Unit& u) const {
        const long L = (long)i * G + c; if (L >= nwg) return false;
        int wgid = (int)L; { const int q = nwg / NXCD, r = nwg % NXCD, xcd = wgid % NXCD, off = wgid / NXCD; wgid = (xcd < r ? xcd * (q + 1) : r * (q + 1) + (xcd - r) * q) + off; }
        const int nig = WGM * nN, gid = wgid / nig, fm = gid * WGM, gsz = (nM - fm) < WGM ? (nM - fm) : WGM;
        u.pm = fm + ((wgid % nig) % gsz); u.pn = (wgid % nig) / gsz; return true;
    }
    __device__ __forceinline__ void a_ready(const Unit&) const {}
    __device__ __forceinline__ void done(const Unit&) const {}
};
__device__ __forceinline__ unsigned cvt_pk_bf16(float lo, float hi) { unsigned r; asm volatile("v_cvt_pk_bf16_f32 %0, %1, %2" : "=v"(r) : "v"(lo), "v"(hi)); return r; }
typedef float f32x2 __attribute__((ext_vector_type(2)));
template <class Epi, class Sched, bool STAMP = false>
__device__ __forceinline__ void gemm_phase(PG8_LAS unsigned char* lds, const Gemm g, const Sched& S, const Epi& E, unsigned long long* stamps) {
    const int tid = otid(), wid = __builtin_amdgcn_readfirstlane(tid >> 6), lane = tid & 63, wr = wid >> 2, wc = wid & 3, fr = lane & 15, fq = lane >> 4;
    const int K = g.K, nt = K / BK;
    int ts_lo = 0, ts_hi = 0, nts = 0; const unsigned long long rt_entry = STAMP ? (unsigned long long)wall_clock64() : 0ull;
#define PG8_STAMP() do { if (STAMP && wid == 0 && nts < 64) { const unsigned long long _c = (unsigned long long)clock64(); \
        ts_lo = (lane == nts) ? (int)(unsigned)_c : ts_lo; ts_hi = (lane == nts) ? (int)(unsigned)(_c >> 32) : ts_hi; ++nts; } } while (0)
    PG8_STAMP();
    unsigned voffA[2], voffB[2];
#pragma unroll
    for (int i = 0; i < 2; ++i) { int R, C; stage_rc(tid * 16 + i * 8192, R, C); const int Rb = Epi::PERM ? ((R & ~31) + perm32(R & 31)) : R;
        voffA[i] = (unsigned)(R * K + C) * 2u; voffB[i] = (unsigned)(Rb * K + C) * 2u; }
    const size_t kstep = (size_t)(BK * 2);
    const size_t hstep = (size_t)HALF * K * 2;
    const size_t tstep = 2 * hstep;
    const unsigned ldsw = (unsigned)wid * 1024u;
    const int aoff = lds_byte(wr * 64 + fr, fq * 8), boff = lds_byte(wc * 32 + fr, fq * 8);
#define PG8_SA(b, h) (((b) * 2 + (h)) * HTB)
#define PG8_SB(b, h) ((4 + (b) * 2 + (h)) * HTB)
#define PG8_STAGE(bufoff, gbase, voff) do { _Pragma("unroll") for (int _i = 0; _i < 2; ++_i) \
        __builtin_amdgcn_global_load_lds((const unsigned*)((const char*)(gbase) + (voff)[_i]), (PG8_LAS unsigned*)(lds + (bufoff) + ldsw + _i * 8192), 16, 0, 0); } while (0)
#define PG8_LDA(dst, b, h) do { _Pragma("unroll") for (int m = 0; m < 4; ++m) _Pragma("unroll") for (int k = 0; k < 2; ++k) dst[m][k] = *(const PG8_LAS bf16x8*)(lds + PG8_SA(b, h) + aoff + m * 2048 + k * 1024); } while (0)
#define PG8_LDB(dst, b, h) do { _Pragma("unroll") for (int n = 0; n < 2; ++n) _Pragma("unroll") for (int k = 0; k < 2; ++k) dst[n][k] = *(const PG8_LAS bf16x8*)(lds + PG8_SB(b, h) + boff + n * 2048 + k * 1024); } while (0)
#define PG8_MMA(ai, bj, At, Bt) do { __builtin_amdgcn_s_setprio(1); _Pragma("unroll") for (int m = 0; m < 4; ++m) _Pragma("unroll") for (int n = 0; n < 2; ++n) _Pragma("unroll") for (int k = 0; k < 2; ++k) \
        acc[ai][bj][m][n] = __builtin_amdgcn_mfma_f32_16x16x32_bf16(Bt[n][k], At[m][k], acc[ai][bj][m][n], 0, 0, 0); __builtin_amdgcn_s_setprio(0); } while (0)
#define PG8_WAIT_V(n) asm volatile("s_waitcnt vmcnt(" #n ")" ::: "memory")
#define PG8_WAIT_L(n) asm volatile("s_waitcnt lgkmcnt(" #n ")" ::: "memory")
#define PG8_BAR __builtin_amdgcn_s_barrier()
#define PG8_SCHED __builtin_amdgcn_sched_barrier(0)
    Unit cur, nxt; int ui = 0;
    if (!S.next(0, cur)) return;
    f32x4 acc[2][2][4][2];
#pragma unroll
    for (int a = 0; a < 2; ++a)
#pragma unroll
        for (int b = 0; b < 2; ++b)
#pragma unroll
            for (int m = 0; m < 4; ++m)
#pragma unroll
                for (int n = 0; n < 2; ++n) acc[a][b][m][n] = (f32x4){0.f, 0.f, 0.f, 0.f};
    bf16x8 At[4][2], B0[2][2], B1[2][2];
    const char* cA = (const char*)g.A + (size_t)cur.pm * tstep; const char* cB = (const char*)g.Bt + (size_t)cur.pn * tstep;
    S.a_ready(cur);
    PG8_STAGE(PG8_SB(0, 0), cB, voffB); PG8_STAGE(PG8_SA(0, 0), cA, voffA); PG8_STAGE(PG8_SB(0, 1), cB + hstep, voffB); PG8_STAGE(PG8_SA(0, 1), cA + hstep, voffA);
    if (wr == 1) PG8_BAR;
    PG8_WAIT_V(4); PG8_BAR;
    PG8_STAGE(PG8_SB(1, 0), cB + kstep, voffB); PG8_STAGE(PG8_SA(1, 0), cA + kstep, voffA); PG8_STAGE(PG8_SB(1, 1), cB + hstep + kstep, voffB);
    PG8_WAIT_V(6); PG8_BAR;
    PG8_STAMP();
    for (;;) {
        const bool has_next = S.next(ui + 1, nxt);
        const char* nA = has_next ? (const char*)g.A + (size_t)nxt.pm * tstep : cA; const char* nB = has_next ? (const char*)g.Bt + (size_t)nxt.pn * tstep : cB;
        for (int t = 0; t < nt; t += 2) {
            const bool last = (t == nt - 2);
            const char* a1 = cA + (size_t)(t + 1) * kstep;
            const char* a2 = last ? nA : cA + (size_t)(t + 2) * kstep; const char* b2 = last ? nB : cB + (size_t)(t + 2) * kstep;
            const char* a3 = a2 + kstep; const char* b3 = b2 + kstep;
            if (last && has_next) S.a_ready(nxt);
            PG8_LDB(B0, 0, 0); PG8_SCHED; PG8_LDA(At, 0, 0); PG8_STAGE(PG8_SA(1, 1), a1 + hstep, voffA);
            PG8_WAIT_L(8); PG8_BAR; PG8_WAIT_L(0); PG8_MMA(0, 0, At, B0); PG8_BAR; PG8_SCHED;
            PG8_LDB(B1, 0, 1); PG8_STAGE(PG8_SB(0, 0), b2, voffB);
            PG8_BAR; PG8_WAIT_L(0); PG8_MMA(0, 1, At, B1); PG8_BAR;
            PG8_LDA(At, 0, 1); PG8_STAGE(PG8_SA(0, 0), a2, voffA);
            PG8_BAR; PG8_WAIT_L(0); PG8_MMA(1, 0, At, B0); PG8_BAR; PG8_SCHED;
            PG8_STAGE(PG8_SB(0, 1), b2 + hstep, voffB);
            PG8_WAIT_V(6); PG8_BAR; PG8_MMA(1, 1, At, B1); PG8_BAR;
            PG8_LDB(B0, 1, 0); PG8_SCHED; PG8_LDA(At, 1, 0); PG8_STAGE(PG8_SA(0, 1), a2 + hstep, voffA);
            PG8_WAIT_L(8); PG8_BAR; PG8_WAIT_L(0); PG8_MMA(0, 0, At, B0); PG8_BAR; PG8_SCHED;
            PG8_LDB(B1, 1, 1); PG8_STAGE(PG8_SB(1, 0), b3, voffB);
            PG8_BAR; PG8_WAIT_L(0); PG8_MMA(0, 1, At, B1); PG8_BAR;
            PG8_LDA(At, 1, 1); PG8_STAGE(PG8_SA(1, 0), a3, voffA);
            PG8_BAR; PG8_WAIT_L(0); PG8_MMA(1, 0, At, B0); PG8_BAR; PG8_SCHED;
            PG8_STAGE(PG8_SB(1, 1), b3 + hstep, voffB);
            PG8_WAIT_V(6); PG8_BAR; PG8_MMA(1, 1, At, B1); PG8_BAR;
        }
        PG8_STAMP();
        if constexpr (!Epi::AFTER_DRAIN) { E(acc, cur, wr, wc, fr, fq); S.done(cur); }
        PG8_STAMP();
        if (!has_next) break;
#pragma unroll
        for (int a = 0; a < 2; ++a)
#pragma unroll
            for (int b = 0; b < 2; ++b)
#pragma unroll
                for (int m = 0; m < 4; ++m)
#pragma unroll
                    for (int n = 0; n < 2; ++n) acc[a][b][m][n] = (f32x4){0.f, 0.f, 0.f, 0.f};
        cur = nxt; cA = nA; cB = nB; ++ui;
    }
    PG8_WAIT_V(0);
    if (wr == 0) PG8_BAR;
    PG8_BAR;
    if constexpr (Epi::AFTER_DRAIN) { E.fused(acc, cur, wr, wc, fr, fq, lds, wid, lane); S.done(cur); }
    PG8_STAMP();
    if (STAMP && wid == 0) { stamps[lane] = lane < nts ? (((unsigned long long)(unsigned)ts_hi << 32) | (unsigned)ts_lo) : 0ull;
        if (lane == 62) stamps[62] = rt_entry; if (lane == 63) stamps[63] = (unsigned long long)wall_clock64(); }
#undef PG8_STAMP
#undef PG8_SA
#undef PG8_SB
#undef PG8_STAGE
#undef PG8_LDA
#undef PG8_LDB
#undef PG8_MMA
#undef PG8_WAIT_V
#undef PG8_WAIT_L
#undef PG8_BAR
#undef PG8_SCHED
}
}

using pg8::bf16_t; using pg8::f32x4; using pg8::u32x4; using pg8::Unit;
#define LAS __attribute__((address_space(3)))
typedef unsigned u32x2 __attribute__((ext_vector_type(2)));
typedef float f32x2 __attribute__((ext_vector_type(2)));

constexpr int NT = 12288, DM = 1024, SEG = 256, NSEG = 48, NSSEG = 32, PLD = 2816, DFF = 2816;
constexpr float EPS = 1e-6f;
constexpr int LDS_BYTES = 131072;

constexpr size_t WS_X     = 0;
constexpr size_t WS_HN    = WS_X + (size_t)NT * DM * 4;
constexpr size_t WS_PROJ  = WS_HN + (size_t)NT * DM * 2;
constexpr size_t WS_WIN   = WS_PROJ + (size_t)NT * PLD * 2;
constexpr size_t WS_WOUT  = WS_WIN + (size_t)2816 * 1024 * 2;
constexpr size_t WS_WGU   = WS_WOUT + (size_t)1024 * 1024 * 2;
constexpr size_t WS_WDN   = WS_WGU + (size_t)5632 * 1024 * 2;
constexpr size_t WS_WGLU  = WS_WDN + (size_t)1024 * 2816 * 2;
constexpr size_t WS_MOD   = WS_WGLU + (size_t)512 * 512 * 2;
constexpr size_t WS_OSUM  = WS_MOD + (size_t)4 * 3 * 6144 * 4;
constexpr size_t WS_QN    = WS_OSUM + (size_t)NT * 1024 * 4;
constexpr size_t WS_AB    = WS_QN + (size_t)3 * NT * 512 * 4;
constexpr size_t WS_ZG    = WS_AB + (size_t)NT * 16 * 4;
constexpr size_t WS_CE    = WS_ZG + (size_t)NT * 512 * 2;
constexpr size_t CARRY_SZ = (size_t)NSSEG * 2 * 4 * 128 * 128 * 4;
constexpr size_t WS_CP    = WS_CE + CARRY_SZ;
constexpr size_t WS_CS    = WS_CP + CARRY_SZ;
constexpr size_t WS_C2E   = WS_CS + CARRY_SZ;
constexpr size_t C2_SZ    = (size_t)NSSEG * 2 * 32 * 64 * 2 * 4;
constexpr size_t WS_C2D   = WS_C2E + C2_SZ;
constexpr size_t WS_C2S   = WS_C2D + C2_SZ;
constexpr size_t WS_END   = WS_C2S + C2_SZ;

constexpr size_t OUT_Y   = 0;
constexpr size_t OUT_GLA = (size_t)NT * 1024;
constexpr size_t OUT_RG  = OUT_GLA + (size_t)16 * 2 * 2 * 4 * 64 * 128;
constexpr size_t OUT_S5  = OUT_RG + (size_t)16 * 2 * 2 * 512;
constexpr size_t OUT_DN  = OUT_S5 + (size_t)16 * 2 * 2 * 32 * 64 * 2;

struct Params { const float* in[44]; float* out; unsigned char* ws; };

enum { I_XP = 0, I_XS, I_SGLA, I_SRG, I_SS5, I_SDN, I_C, I_CCTX, I_N1W, I_N2W, I_WMOD, I_BMOD, I_ABIN, I_ABOUT, I_WG2, I_BG, I_GLANW,
       I_RGCW, I_RGCB, I_RGWA, I_RGBA, I_RGWX, I_RGBX, I_RGLAM, I_CDIN, I_CDOUT, I_LAMRE, I_LAMIM, I_LOGDT, I_BRE, I_BIM, I_CRE, I_CIM,
       I_S5D, I_GLUW, I_GLUB, I_DNCW, I_ALOG, I_DTB, I_DNNW, I_FG, I_FU, I_FD, I_FNW };

__device__ __forceinline__ float bf2f(bf16_t b) { return __uint_as_float(((unsigned)b) << 16); }
__device__ __forceinline__ float bflo(unsigned w) { return __uint_as_float(w << 16); }
__device__ __forceinline__ float bfhi(unsigned w) { return __uint_as_float(w & 0xffff0000u); }
__device__ __forceinline__ unsigned f2bf(float f) { unsigned u = __float_as_uint(f); return (u + 0x7fffu + ((u >> 16) & 1u)) >> 16; }
__device__ __forceinline__ unsigned pk2(float lo, float hi) { return f2bf(lo) | (f2bf(hi) << 16); }
__device__ __forceinline__ float rdl(float v, int l) { return __int_as_float(__builtin_amdgcn_readlane(__float_as_int(v), l)); }
__device__ __forceinline__ float sigmoidf_(float x) { return 1.0f / (1.0f + expf(-x)); }
__device__ __forceinline__ float siluf_(float x) { return x / (1.0f + expf(-x)); }
__device__ __forceinline__ float softplusf_(float x) { return fmaxf(x, 0.f) + log1pf(expf(-fabsf(x))); }
__device__ __forceinline__ float geluf_(float x) { return 0.5f * x * (1.0f + tanhf(0.7978845608028654f * (x + 0.044715f * x * x * x))); }
__device__ __forceinline__ float wave_sum(float v) {
#pragma unroll
    for (int o = 32; o >= 1; o >>= 1) v += __shfl_xor(v, o);
    return v;
}
__device__ __forceinline__ int cv_of_tok(int t) { return t < 4096 ? 0 : 1 + ((t - 4096) >> 12); }
__device__ __forceinline__ void seq_bounds(int t, int& lo, int& hi) { if (t < 4096) { lo = t & ~255; hi = lo + 256; } else { lo = 4096 + ((t - 4096) & ~4095); hi = lo + 4096; } }

struct EpiProj {
    static constexpr bool PERM = true, AFTER_DRAIN = false;
    bf16_t* O; int ldc;
    __device__ __forceinline__ void operator()(const f32x4 (&acc)[2][2][4][2], const Unit& u, int wr, int wc, int fr, int fq) const {
        const int row0 = u.pm * 256 + wr * 64 + fr, col0 = u.pn * 256 + wc * 32 + 8 * fq;
#pragma unroll
        for (int ai = 0; ai < 2; ++ai)
#pragma unroll
            for (int m = 0; m < 4; ++m) { bf16_t* rowp = O + (size_t)(row0 + ai * 128 + m * 16) * ldc + col0;
#pragma unroll
                for (int bj = 0; bj < 2; ++bj) { const f32x4 v0 = acc[ai][bj][m][0], v1 = acc[ai][bj][m][1];
                    u32x4 w; w.x = pk2(v0[0], v0[1]); w.y = pk2(v0[2], v0[3]); w.z = pk2(v1[0], v1[1]); w.w = pk2(v1[2], v1[3]);
                    *(u32x4*)(rowp + bj * 128) = w; } }
    }
};
struct EpiResid {
    static constexpr bool PERM = false, AFTER_DRAIN = false;
    float* X; const float* gate;
    __device__ __forceinline__ void operator()(const f32x4 (&acc)[2][2][4][2], const Unit& u, int wr, int wc, int fr, int fq) const {
        const int row0 = u.pm * 256 + wr * 64 + fr, col0 = u.pn * 256 + wc * 32 + 4 * fq;
        const int cv = u.pm < 16 ? 0 : 1 + ((u.pm - 16) >> 4);
        const float* gp = gate + cv * 6144 + col0;
        f32x4 gv[2][2];
#pragma unroll
        for (int bj = 0; bj < 2; ++bj)
#pragma unroll
            for (int n = 0; n < 2; ++n) gv[bj][n] = *(const f32x4*)(gp + bj * 128 + n * 16);
#pragma unroll
        for (int ai = 0; ai < 2; ++ai)
#pragma unroll
            for (int m = 0; m < 4; ++m) { float* rowp = X + (size_t)(row0 + ai * 128 + m * 16) * 1024 + col0;
#pragma unroll
                for (int bj = 0; bj < 2; ++bj)
#pragma unroll
                    for (int n = 0; n < 2; ++n) { f32x4* q = (f32x4*)(rowp + bj * 128 + n * 16); *q = *q + gv[bj][n] * acc[ai][bj][m][n]; } }
    }
};
struct EpiSwiGLU {
    static constexpr bool PERM = true, AFTER_DRAIN = false;
    bf16_t* O;
    __device__ __forceinline__ void operator()(const f32x4 (&acc)[2][2][4][2], const Unit& u, int wr, int wc, int fr, int fq) const {
        const int row0 = u.pm * 256 + wr * 64 + fr, col0 = u.pn * 128 + wc * 32 + 8 * fq;
#pragma unroll
        for (int ai = 0; ai < 2; ++ai)
#pragma unroll
            for (int m = 0; m < 4; ++m) { bf16_t* rowp = O + (size_t)(row0 + ai * 128 + m * 16) * DFF + col0;
                float r[8];
#pragma unroll
                for (int n = 0; n < 2; ++n)
#pragma unroll
                    for (int j = 0; j < 4; ++j) { const float g = acc[ai][0][m][n][j], up = acc[ai][1][m][n][j]; r[n * 4 + j] = g / (1.0f + __expf(-g)) * up; }
                u32x4 w; w.x = pk2(r[0], r[1]); w.y = pk2(r[2], r[3]); w.z = pk2(r[4], r[5]); w.w = pk2(r[6], r[7]);
                *(u32x4*)rowp = w; }
    }
};
struct EpiGLU {
    static constexpr bool PERM = true, AFTER_DRAIN = false;
    bf16_t* O; const bf16_t* ZG; const float* bias;
    __device__ __forceinline__ void operator()(const f32x4 (&acc)[2][2][4][2], const Unit& u, int wr, int wc, int fr, int fq) const {
        const int row0 = u.pm * 256 + wr * 64 + fr, col0 = u.pn * 256 + wc * 32 + 8 * fq;
#pragma unroll
        for (int ai = 0; ai < 2; ++ai)
#pragma unroll
            for (int m = 0; m < 4; ++m) { const int row = row0 + ai * 128 + m * 16;
#pragma unroll
                for (int bj = 0; bj < 2; ++bj) { const int c = col0 + bj * 128;
                    const u32x4 z = *(const u32x4*)(ZG + (size_t)row * 512 + c);
                    const f32x4 b0 = *(const f32x4*)(bias + c), b1 = *(const f32x4*)(bias + c + 4);
                    const f32x4 v0 = acc[ai][bj][m][0] + b0, v1 = acc[ai][bj][m][1] + b1;
                    float r[8];
                    r[0] = bflo(z.x) * sigmoidf_(v0[0]); r[1] = bfhi(z.x) * sigmoidf_(v0[1]); r[2] = bflo(z.y) * sigmoidf_(v0[2]); r[3] = bfhi(z.y) * sigmoidf_(v0[3]);
                    r[4] = bflo(z.z) * sigmoidf_(v1[0]); r[5] = bfhi(z.z) * sigmoidf_(v1[1]); r[6] = bflo(z.w) * sigmoidf_(v1[2]); r[7] = bfhi(z.w) * sigmoidf_(v1[3]);
                    u32x4 w; w.x = pk2(r[0], r[1]); w.y = pk2(r[2], r[3]); w.z = pk2(r[4], r[5]); w.w = pk2(r[6], r[7]);
                    *(u32x4*)(O + (size_t)row * 1024 + c) = w; } }
    }
};

__device__ __forceinline__ void prep_mat(LAS unsigned char* lds, bf16_t* dst, int NR, int K, const float* src0, const float* src1, int ldsrc, int nvalid, int mode) {
    LAS float* tl = (LAS float*)lds;
    const int tid = otid(), ntn = NR >> 6, ntk = K >> 6, ntile = ntn * ntk;
    for (int tile = blockIdx.x; tile < ntile; tile += gridDim.x) {
        const int n0 = (tile % ntn) * 64, k0 = (tile / ntn) * 64;
        { const int nl = tid & 63, kl0 = tid >> 6, n = n0 + nl; const float* sp = src0; int col;
          if (mode == 0) col = n < nvalid ? n : -1; else { col = ((n >> 8) << 7) + (n & 127); if ((n >> 7) & 1) sp = src1; }
#pragma unroll
          for (int i = 0; i < 8; ++i) { const int kl = kl0 + 8 * i; tl[kl * 65 + nl] = col >= 0 ? sp[(size_t)(k0 + kl) * ldsrc + col] : 0.f; } }
        __syncthreads();
        { const int nl = tid >> 3, ks = tid & 7; float v[8];
#pragma unroll
          for (int j = 0; j < 8; ++j) v[j] = tl[(ks * 8 + j) * 65 + nl];
          u32x4 w; w.x = pk2(v[0], v[1]); w.y = pk2(v[2], v[3]); w.z = pk2(v[4], v[5]); w.w = pk2(v[6], v[7]);
          *(u32x4*)(dst + (size_t)(n0 + nl) * K + k0 + ks * 8) = w; }
        __syncthreads();
    }
}
__device__ __forceinline__ void prep_weights(const Params& p, LAS unsigned char* lds, int l) {
    unsigned char* ws = p.ws; const int jl = l >> 1;
    if ((l & 1) == 0) {
        prep_mat(lds, (bf16_t*)(ws + WS_WIN), 2816, 1024, p.in[I_ABIN] + (size_t)jl * 1024 * 2592, nullptr, 2592, 2592, 0);
        prep_mat(lds, (bf16_t*)(ws + WS_WOUT), 1024, 1024, p.in[I_ABOUT] + (size_t)jl * 1024 * 1024, nullptr, 1024, 1024, 0);
    } else {
        prep_mat(lds, (bf16_t*)(ws + WS_WIN), 2816, 1024, p.in[I_CDIN] + (size_t)jl * 1024 * 2576, nullptr, 2576, 2576, 0);
        prep_mat(lds, (bf16_t*)(ws + WS_WOUT), 1024, 1024, p.in[I_CDOUT] + (size_t)jl * 1024 * 1024, nullptr, 1024, 1024, 0);
        prep_mat(lds, (bf16_t*)(ws + WS_WGLU), 512, 512, p.in[I_GLUW] + (size_t)jl * 512 * 512, nullptr, 512, 512, 0);
    }
    prep_mat(lds, (bf16_t*)(ws + WS_WGU), 5632, 1024, p.in[I_FG] + (size_t)l * 1024 * 2816, p.in[I_FU] + (size_t)l * 1024 * 2816, 2816, 0, 1);
    prep_mat(lds, (bf16_t*)(ws + WS_WDN), 1024, 2816, p.in[I_FD] + (size_t)l * 2816 * 1024, nullptr, 1024, 1024, 0);
}
__device__ __forceinline__ void phase0(const Params& p, LAS unsigned char* lds) {
    const int tid = otid(), G = gridDim.x;
    {
        LAS float* sc = (LAS float*)lds;
        LAS float* red = (LAS float*)(lds + 16384);
        for (int i = tid; i < 3072; i += 512) { const int cv = i >> 10, k = i & 1023; const float c = cv == 0 ? p.in[I_CCTX][k] : p.in[I_C][(cv - 1) * 1024 + k]; sc[i] = siluf_(c); }
        __syncthreads();
        const int w = tid >> 6, lane = tid & 63;
        for (int item = blockIdx.x; item < 384; item += G) {
            const int l = item / 96, col = (item % 96) * 64 + lane;
            const float* wp = p.in[I_WMOD] + (size_t)l * 1024 * 6144 + (size_t)(w * 128) * 6144 + col;
            float a0 = 0.f, a1 = 0.f, a2 = 0.f;
#pragma unroll 8
            for (int k = 0; k < 128; ++k) { const float wv = wp[(size_t)k * 6144]; const int kk = w * 128 + k; a0 += sc[kk] * wv; a1 += sc[1024 + kk] * wv; a2 += sc[2048 + kk] * wv; }
            red[(w * 3 + 0) * 64 + lane] = a0; red[(w * 3 + 1) * 64 + lane] = a1; red[(w * 3 + 2) * 64 + lane] = a2;
            __syncthreads();
            if (tid < 192) { const int cv = tid >> 6, ln = tid & 63, c2 = (item % 96) * 64 + ln; float s = p.in[I_BMOD][l * 6144 + c2];
#pragma unroll
                for (int ww = 0; ww < 8; ++ww) s += red[(ww * 3 + cv) * 64 + ln];
                ((float*)(p.ws + WS_MOD))[(l * 3 + cv) * 6144 + c2] = s; }
            __syncthreads();
        }
    }
    {
        float4* X = (float4*)(p.ws + WS_X);
        const float4* xp = (const float4*)p.in[I_XP]; const float4* xs = (const float4*)p.in[I_XS];
        for (size_t i = (size_t)blockIdx.x * 512 + tid; i < (size_t)NT * 256; i += (size_t)G * 512) {
            const int t = (int)(i >> 8), d4 = (int)(i & 255) * 4;
            float4 v;
            if (t < 4096) v = xp[i];
            else { v = xs[i - (size_t)4096 * 256]; const int tt = (t - 4096) & 4095; const float row = (float)(tt >> 6), colf = (float)(tt & 63);
                float pe[4];
#pragma unroll
                for (int j = 0; j < 4; ++j) { const int d = d4 + j, q = d >> 8, fi = d & 255; const float fr = expf(-9.210340371976184f * (float)fi / 256.0f);
                    const float arg = (q < 2 ? row : colf) * fr; pe[j] = (q & 1) ? cosf(arg) : sinf(arg); }
                v.x += pe[0]; v.y += pe[1]; v.z += pe[2]; v.w += pe[3]; }
            X[i] = v;
        }
    }
    prep_weights(p, lds, 0);
}

template <bool FINAL>
__device__ __forceinline__ void norm_phase(const float* X, const float* w, const float* shift, const float* scale, bf16_t* hn, float* yout) {
    const int lane = otid() & 63, gw = blockIdx.x * 8 + (otid() >> 6), nw = gridDim.x * 8;
    for (int row = gw; row < NT; row += nw) {
        const float4* xr = (const float4*)(X + (size_t)row * 1024);
        float4 v[4]; float ss = 0.f;
#pragma unroll
        for (int i = 0; i < 4; ++i) { v[i] = xr[i * 64 + lane]; ss += v[i].x * v[i].x + v[i].y * v[i].y + v[i].z * v[i].z + v[i].w * v[i].w; }
        ss = wave_sum(ss);
        const float rs = rsqrtf(ss * (1.0f / 1024.0f) + EPS);
        const int cv = cv_of_tok(row);
#pragma unroll
        for (int i = 0; i < 4; ++i) { const int c = i * 256 + lane * 4; const float4 wv = *(const float4*)(w + c);
            if (FINAL) { float4 o; o.x = v[i].x * rs * wv.x; o.y = v[i].y * rs * wv.y; o.z = v[i].z * rs * wv.z; o.w = v[i].w * rs * wv.w; *(float4*)(yout + (size_t)row * 1024 + c) = o; }
            else { const float4 sh = *(const float4*)(shift + cv * 6144 + c), sl = *(const float4*)(scale + cv * 6144 + c);
                u32x2 o; o.x = pk2(v[i].x * rs * wv.x * (1.f + sl.x) + sh.x, v[i].y * rs * wv.y * (1.f + sl.y) + sh.y);
                o.y = pk2(v[i].z * rs * wv.z * (1.f + sl.z) + sh.z, v[i].w * rs * wv.w * (1.f + sl.w) + sh.w);
                *(u32x2*)(hn + (size_t)row * 1024 + c) = o; } }
    }
}
__device__ __forceinline__ void zero_osum(const Params& p) {
    float4* o = (float4*)(p.ws + WS_OSUM); const float4 z = {0.f, 0.f, 0.f, 0.f};
    for (size_t i = (size_t)blockIdx.x * 512 + otid(); i < (size_t)NT * 256; i += (size_t)gridDim.x * 512) o[i] = z;
}

template <bool PASSB>
__device__ __forceinline__ void gla_task(const Params& p, int jl, int seg, int dir, int head, int ch) {
    const int lane = otid() & 63, col = ch * 64 + lane;
    const bf16_t* proj = (const bf16_t*)(p.ws + WS_PROJ);
    float* osum = (float*)(p.ws + WS_OSUM);
    float S[64];
    const int sseg = seg - 16;
    if (PASSB && seg >= 16) { const float* si = (const float*)(p.ws + WS_CS) + ((size_t)((sseg * 2 + dir) * 4 + head) * 64) * 128 + col;
#pragma unroll
        for (int k = 0; k < 64; ++k) { S[k] = *si; si += 128; asm volatile("" : "+v"(si)); } }
    else {
#pragma unroll
        for (int k = 0; k < 64; ++k) S[k] = 0.f; }
    float wg[16];
#pragma unroll
    for (int r = 0; r < 16; ++r) wg[r] = p.in[I_WG2][((size_t)(jl * 2 + dir) * 16 + r) * 256 + head * 64 + lane];
    const float bgv = p.in[I_BG][(jl * 2 + dir) * 256 + head * 64 + lane];
    float lsum = 0.f;
    const int base = seg * SEG;
    int t = dir ? base + SEG - 1 : base; const int dt = dir ? -1 : 1;
    const bf16_t* pr = proj + (size_t)t * PLD;
    unsigned short nq = pr[head * 64 + lane], nk = pr[256 + head * 64 + lane], nv = pr[512 + head * 128 + col];
    u32x4 nl0 = *(const u32x4*)(pr + 1536 + dir * 16), nl1 = *(const u32x4*)(pr + 1536 + dir * 16 + 8);
    for (int i = 0; i < SEG; ++i) {
        const float qv = bf2f(nq) * 0.125f, kv = bf2f(nk), vv = bf2f(nv);
        const u32x4 l0 = nl0, l1 = nl1; const int tc = t;
        if (i + 1 < SEG) { t += dt; pr = proj + (size_t)t * PLD; nq = pr[head * 64 + lane]; nk = pr[256 + head * 64 + lane]; nv = pr[512 + head * 128 + col];
            nl0 = *(const u32x4*)(pr + 1536 + dir * 16); nl1 = *(const u32x4*)(pr + 1536 + dir * 16 + 8); }
        float pre = bgv;
        pre += bflo(l0.x) * wg[0] + bfhi(l0.x) * wg[1] + bflo(l0.y) * wg[2] + bfhi(l0.y) * wg[3] + bflo(l0.z) * wg[4] + bfhi(l0.z) * wg[5] + bflo(l0.w) * wg[6] + bfhi(l0.w) * wg[7];
        pre += bflo(l1.x) * wg[8] + bfhi(l1.x) * wg[9] + bflo(l1.y) * wg[10] + bfhi(l1.y) * wg[11] + bflo(l1.z) * wg[12] + bfhi(l1.z) * wg[13] + bflo(l1.w) * wg[14] + bfhi(l1.w) * wg[15];
        const float ls = (fminf(pre, 0.f) - log1pf(expf(-fabsf(pre)))) * (1.0f / 16.0f);
        const float alpha = expf(ls);
        if (!PASSB) lsum += ls;
        float o = 0.f;
#pragma unroll
        for (int k = 0; k < 64; ++k) { const float a = rdl(alpha, k), kk = rdl(kv, k); S[k] = a * S[k] + kk * vv; if (PASSB) o += rdl(qv, k) * S[k]; }
        if (PASSB) unsafeAtomicAdd(osum + (size_t)tc * 1024 + head * 128 + col, o);
    }
    if (!PASSB) { float* e = (float*)(p.ws + WS_CE) + ((size_t)((sseg * 2 + dir) * 4 + head) * 64) * 128 + col;
#pragma unroll
        for (int k = 0; k < 64; ++k) { *e = S[k]; e += 128; asm volatile("" : "+v"(e)); }
        if (ch == 0) ((float*)(p.ws + WS_CP))[((sseg * 2 + dir) * 4 + head) * 64 + lane] = expf(lsum); }
    else if (seg < 16) { float* e = p.out + OUT_GLA + ((size_t)(((seg * 2 + jl) * 2 + dir) * 4 + head) * 64) * 128 + col;
#pragma unroll
        for (int k = 0; k < 64; ++k) { *e = S[k]; e += 128; asm volatile("" : "+v"(e)); } }
}
template <bool PASSB>
__device__ __forceinline__ void rg_task(const Params& p, int jl, int seg, int dir, int n) {
    const int lane = otid() & 63, chn = n * 64 + lane;
    const bf16_t* proj = (const bf16_t*)(p.ws + WS_PROJ);
    float* osum = (float*)(p.ws + WS_OSUM);
    float wa[64], wx[64];
    { const float* a = p.in[I_RGWA] + ((size_t)((jl * 2 + dir) * 8 + n) * 64) * 64 + lane; const float* x = p.in[I_RGWX] + ((size_t)((jl * 2 + dir) * 8 + n) * 64) * 64 + lane;
#pragma unroll
      for (int j = 0; j < 64; ++j) { wa[j] = a[j * 64]; wx[j] = x[j * 64]; } }
    const float ba = p.in[I_RGBA][(jl * 2 + dir) * 512 + chn], bx = p.in[I_RGBX][(jl * 2 + dir) * 512 + chn];
    const float sp = softplusf_(-p.in[I_RGLAM][(jl * 2 + dir) * 512 + chn]);
    float cw[4];
#pragma unroll
    for (int j = 0; j < 4; ++j) cw[j] = p.in[I_RGCW][(jl * 4 + j) * 512 + chn];
    const float cb = p.in[I_RGCB][jl * 512 + chn];
    const int base = seg * SEG, sseg = seg - 16; int lo, hi; seq_bounds(base, lo, hi);
    float h = 0.f, dprod = 1.f;
    if (PASSB && seg >= 16) h = ((const float*)(p.ws + WS_C2S))[(sseg * 2 + dir) * 512 + chn];
    const bf16_t* rx = proj + 1568 + chn;
    for (int i = 0; i < SEG; ++i) {
        const int t = dir ? base + SEG - 1 - i : base + i;
        float xc = cb;
#pragma unroll
        for (int j = 0; j < 4; ++j) { const int tt = t + j - 1; const float xv = (tt >= lo && tt < hi) ? bf2f(rx[(size_t)tt * PLD]) : 0.f; xc += cw[j] * xv; }
        float rp = ba, ip = bx;
#pragma unroll
        for (int j = 0; j < 64; ++j) { const float xj = rdl(xc, j); rp += xj * wa[j]; ip += xj * wx[j]; }
        const float r = sigmoidf_(rp), ig = sigmoidf_(ip);
        const float la = -8.0f * r * sp, a = expf(la), b = sqrtf(-expm1f(2.0f * la)) * (ig * xc);
        h = a * h + b;
        if (!PASSB) dprod *= a;
        if (PASSB) unsafeAtomicAdd(osum + (size_t)t * 1024 + 512 + chn, h);
    }
    if (!PASSB) { ((float*)(p.ws + WS_C2E))[(sseg * 2 + dir) * 512 + chn] = h; ((float*)(p.ws + WS_C2D))[(sseg * 2 + dir) * 512 + chn] = dprod; }
    else if (seg < 16) p.out[OUT_RG + ((seg * 2 + jl) * 2 + dir) * 512 + chn] = h;
}
template <bool PASSB>
__device__ __forceinline__ void ab_pass(const Params& p, int jl) {
    const int wave = __builtin_amdgcn_readfirstlane(otid() >> 6), G = gridDim.x;
    const int nseg = PASSB ? NSEG : NSSEG, s0 = PASSB ? 0 : 16;
    const int ngla = nseg * 16, nrg = nseg * 16;
    for (int idx = wave * G + blockIdx.x; idx < ngla + nrg; idx += 8 * G) {
        if (idx < ngla) { const int seg = s0 + idx / 16, r = idx % 16; gla_task<PASSB>(p, jl, seg, r >> 3, (r >> 1) & 3, r & 1); }
        else { const int j = idx - ngla, seg = s0 + j / 16, r = j % 16; rg_task<PASSB>(p, jl, seg, r >> 3, r & 7); }
    }
}
__device__ __forceinline__ void ab_carry(const Params& p, int jl) {
    const size_t gt = (size_t)blockIdx.x * 512 + otid(), gn = (size_t)gridDim.x * 512;
    for (size_t i = gt; i < (size_t)2 * 2 * 4 * 8192; i += gn) {
        const int e = (int)(i & 8191), head = (int)(i >> 13) & 3, dir = (int)(i >> 15) & 1, b = (int)(i >> 16);
        float S = p.in[I_SGLA][((size_t)(((b * 2 + jl) * 2 + dir) * 4 + head)) * 8192 + e];
        for (int s = 0; s < 16; ++s) { const int j = dir ? 15 - s : s, sseg = b * 16 + j; const size_t o = ((size_t)((sseg * 2 + dir) * 4 + head)) * 8192 + e;
            ((float*)(p.ws + WS_CS))[o] = S;
            S = ((const float*)(p.ws + WS_CP))[((sseg * 2 + dir) * 4 + head) * 64 + (e >> 7)] * S + ((const float*)(p.ws + WS_CE))[o]; }
    }
    for (size_t i = gt; i < (size_t)2 * 2 * 512; i += gn) {
        const int chn = (int)(i & 511), dir = (int)(i >> 9) & 1, b = (int)(i >> 10);
        float h = p.in[I_SRG][((b * 2 + jl) * 2 + dir) * 512 + chn];
        for (int s = 0; s < 16; ++s) { const int j = dir ? 15 - s : s, sseg = b * 16 + j; const int o = (sseg * 2 + dir) * 512 + chn;
            ((float*)(p.ws + WS_C2S))[o] = h; h = ((const float*)(p.ws + WS_C2D))[o] * h + ((const float*)(p.ws + WS_C2E))[o]; }
    }
}
__device__ __forceinline__ void ab_combine(const Params& p, int jl) {
    const int lane = otid() & 63, gw = blockIdx.x * 8 + (otid() >> 6), nw = gridDim.x * 8;
    const bf16_t* proj = (const bf16_t*)(p.ws + WS_PROJ); const float* osum = (const float*)(p.ws + WS_OSUM); bf16_t* mixed = (bf16_t*)(p.ws + WS_HN);
    for (int t = gw; t < NT; t += nw) {
        const bf16_t* pr = proj + (size_t)t * PLD; const float* os = osum + (size_t)t * 1024; bf16_t* mx = mixed + (size_t)t * 1024;
#pragma unroll
        for (int hd = 0; hd < 4; ++hd) { const int c = hd * 128 + 2 * lane; const float2 o = *(const float2*)(os + c);
            const float ss = wave_sum(o.x * o.x + o.y * o.y); const float rs = rsqrtf(ss * (1.0f / 128.0f) + EPS);
            const unsigned g = *(const unsigned*)(pr + 1024 + c); const float2 nw2 = *(const float2*)(p.in[I_GLANW] + jl * 128 + 2 * lane);
            *(unsigned*)(mx + c) = pk2(o.x * rs * nw2.x * siluf_(bflo(g)), o.y * rs * nw2.y * siluf_(bfhi(g))); }
#pragma unroll
        for (int i = 0; i < 4; ++i) { const int c = i * 128 + 2 * lane; const float2 hs = *(const float2*)(os + 512 + c); const unsigned g = *(const unsigned*)(pr + 2080 + c);
            *(unsigned*)(mx + 512 + c) = pk2(geluf_(bflo(g)) * hs.x, geluf_(bfhi(g)) * hs.y); }
    }
}

__device__ __forceinline__ void cd_m1(const Params& p, int jl) {
    const int lane = otid() & 63, gw = blockIdx.x * 8 + (otid() >> 6), nw = gridDim.x * 8;
    const bf16_t* proj = (const bf16_t*)(p.ws + WS_PROJ);
    float* qn = (float*)(p.ws + WS_QN); float* ab = (float*)(p.ws + WS_AB);
    const float* cwp = p.in[I_DNCW] + (size_t)jl * 4 * 1536;
    for (int t = gw; t < NT; t += nw) {
        int lo, hi; seq_bounds(t, lo, hi);
#pragma unroll 1
        for (int g = 0; g < 12; ++g) { const int c = g * 128 + 2 * lane; float a0 = 0.f, a1 = 0.f;
#pragma unroll
            for (int j = 0; j < 4; ++j) { const int tt = t + j - 1; if (tt >= lo && tt < hi) { const unsigned xv = *(const unsigned*)(proj + (size_t)tt * PLD + 512 + c); const float2 w = *(const float2*)(cwp + j * 1536 + c); a0 += w.x * bflo(xv); a1 += w.y * bfhi(xv); } }
            a0 = siluf_(a0); a1 = siluf_(a1);
            if (g < 8) { const float ss = wave_sum(a0 * a0 + a1 * a1); float rs = rsqrtf(ss + 1e-6f); if (g < 4) rs *= 0.08838834764831845f; a0 *= rs; a1 *= rs; }
            float2 o; o.x = a0; o.y = a1;
            *(float2*)(qn + (size_t)(g >> 2) * NT * 512 + (size_t)t * 512 + (g & 3) * 128 + 2 * lane) = o; }
        if (lane < 8) { const int dir = lane >> 2, hd = lane & 3; const float ai = bf2f(proj[(size_t)t * PLD + 2560 + lane]), bi = bf2f(proj[(size_t)t * PLD + 2568 + lane]);
            const float la = -expf(p.in[I_ALOG][(jl * 2 + dir) * 4 + hd]) * softplusf_(ai + p.in[I_DTB][(jl * 2 + dir) * 4 + hd]);
            ab[(size_t)t * 16 + lane] = expf(la); ab[(size_t)t * 16 + 8 + lane] = sigmoidf_(bi); }
    }
}
template <bool PASSB>
__device__ __forceinline__ void dn_task(const Params& p, int jl, int seg, int dir, int head, int cq) {
    const int lane = otid() & 63, col = (cq & 1) * 64 + lane; const bool isP = cq >= 2;
    const float* qn = (const float*)(p.ws + WS_QN); const float* kn = qn + (size_t)NT * 512; const float* vn = kn + (size_t)NT * 512; const float* ab = (const float*)(p.ws + WS_AB);
    float* osum = (float*)(p.ws + WS_OSUM);
    const int sseg = seg - 16;
    float S[128];
    if (PASSB && seg >= 16) { const float* si = (const float*)(p.ws + WS_CS) + ((size_t)((sseg * 2 + dir) * 4 + head) * 128) * 128 + col;
#pragma unroll
        for (int k = 0; k < 128; ++k) { S[k] = *si; si += 128; asm volatile("" : "+v"(si)); } }
    else {
#pragma unroll
        for (int k = 0; k < 128; ++k) S[k] = (!PASSB && isP) ? fmaxf(0.f, 1.f - fabsf((float)(k - col))) : 0.f; }
    const int base = seg * SEG; int t = dir ? base + SEG - 1 : base; const int dt = dir ? -1 : 1;
    float nk0 = kn[(size_t)t * 512 + head * 128 + lane], nk1 = kn[(size_t)t * 512 + head * 128 + 64 + lane];
    float nq0 = 0.f, nq1 = 0.f; if (PASSB) { nq0 = qn[(size_t)t * 512 + head * 128 + lane]; nq1 = qn[(size_t)t * 512 + head * 128 + 64 + lane]; }
    float nv = isP ? 0.f : vn[(size_t)t * 512 + head * 128 + col];
    float nal = ab[(size_t)t * 16 + dir * 4 + head], nbe = ab[(size_t)t * 16 + 8 + dir * 4 + head];
    for (int i = 0; i < SEG; ++i) {
        const float k0 = nk0, k1 = nk1, q0 = nq0, q1 = nq1, vv = nv, al = nal, be = nbe; const int tc = t;
        if (i + 1 < SEG) { t += dt; nk0 = kn[(size_t)t * 512 + head * 128 + lane]; nk1 = kn[(size_t)t * 512 + head * 128 + 64 + lane];
            if (PASSB) { nq0 = qn[(size_t)t * 512 + head * 128 + lane]; nq1 = qn[(size_t)t * 512 + head * 128 + 64 + lane]; }
            nv = isP ? 0.f : vn[(size_t)t * 512 + head * 128 + col]; nal = ab[(size_t)t * 16 + dir * 4 + head]; nbe = ab[(size_t)t * 16 + 8 + dir * 4 + head]; }
        float s0 = 0.f, s1 = 0.f, s2 = 0.f, s3 = 0.f;
#pragma unroll
        for (int k = 0; k < 64; k += 2) { s0 += rdl(k0, k) * S[k]; s1 += rdl(k0, k + 1) * S[k + 1]; s2 += rdl(k1, k) * S[64 + k]; s3 += rdl(k1, k + 1) * S[64 + k + 1]; }
        const float kS = (s0 + s1) + (s2 + s3);
        const float w = be * (vv - al * kS);
        float o0 = 0.f, o1 = 0.f;
#pragma unroll
        for (int k = 0; k < 64; ++k) { S[k] = al * S[k] + rdl(k0, k) * w; S[64 + k] = al * S[64 + k] + rdl(k1, k) * w; if (PASSB) { o0 += rdl(q0, k) * S[k]; o1 += rdl(q1, k) * S[64 + k]; } }
        if (PASSB) unsafeAtomicAdd(osum + (size_t)tc * 1024 + 512 + head * 128 + col, o0 + o1);
    }
    if (!PASSB) { float* e = (float*)(p.ws + (isP ? WS_CP : WS_CE)) + ((size_t)((sseg * 2 + dir) * 4 + head) * 128) * 128 + col;
#pragma unroll
        for (int k = 0; k < 128; ++k) { *e = S[k]; e += 128; asm volatile("" : "+v"(e)); } }
    else if (seg < 16) { float* e = p.out + OUT_DN + ((size_t)(((seg * 2 + jl) * 2 + dir) * 4 + head) * 128) * 128 + col;
#pragma unroll
        for (int k = 0; k < 128; ++k) { *e = S[k]; e += 128; asm volatile("" : "+v"(e)); } }
}
template <bool PASSB>
__device__ __forceinline__ void s5_task(const Params& p, LAS unsigned char* lds, int jl, int seg, int dir, int g) {
    const int lane = otid() & 63, wave = __builtin_amdgcn_readfirstlane(otid() >> 6);
    const bf16_t* proj = (const bf16_t*)(p.ws + WS_PROJ); float* osum = (float*)(p.ws + WS_OSUM);
    const int pi = ((jl * 2 + dir) * 32 + g) * 64 + lane;
    const float lre = p.in[I_LAMRE][pi], lim = p.in[I_LAMIM][pi], dtv = expf(p.in[I_LOGDT][(jl * 2 + dir) * 32 + g]);
    const float xr = lre * dtv, xi = lim * dtv; float sn, cs; sincosf(xi, &sn, &cs);
    const float ea = expf(xr), ar = ea * cs, ai = ea * sn;
    const float sh = sinf(0.5f * xi); const float nr = expm1f(xr) * cs - 2.0f * sh * sh, ni = ai;
    const float den = 1.0f / (lre * lre + lim * lim); const float cr = (nr * lre + ni * lim) * den, ci = (ni * lre - nr * lim) * den;
    float bbr[16], bbi[16];
#pragma unroll
    for (int j = 0; j < 16; ++j) { const float br = p.in[I_BRE][(size_t)pi * 16 + j], bi = p.in[I_BIM][(size_t)pi * 16 + j]; bbr[j] = cr * br - ci * bi; bbi[j] = cr * bi + ci * br; }
    float creg[64], cimg[64];
    const int jrow = lane & 15, tsel = lane >> 4;
    if (PASSB) { const size_t cbase = ((size_t)((jl * 2 + dir) * 32 + g) * 16 + jrow) * 64;
#pragma unroll
        for (int q = 0; q < 64; ++q) { creg[q] = p.in[I_CRE][cbase + q]; cimg[q] = p.in[I_CIM][cbase + q]; } }
    const int sseg = seg - 16; float hr = 0.f, hi = 0.f;
    if (PASSB && seg >= 16) { const float2 s = ((const float2*)(p.ws + WS_C2S))[((sseg * 2 + dir) * 32 + g) * 64 + lane]; hr = s.x; hi = s.y; }
    LAS f32x2* hb = (LAS f32x2*)(lds + wave * 2048);
    const int base = seg * SEG;
    for (int i0 = 0; i0 < SEG; i0 += 4) {
#pragma unroll 1
        for (int ii = 0; ii < 4; ++ii) { const int i = i0 + ii, t = dir ? base + SEG - 1 - i : base + i;
            const bf16_t* pu = proj + (size_t)t * PLD + g * 16; const u32x4 u0 = *(const u32x4*)pu, u1 = *(const u32x4*)(pu + 8);
            float uu[16]; uu[0] = bflo(u0.x); uu[1] = bfhi(u0.x); uu[2] = bflo(u0.y); uu[3] = bfhi(u0.y); uu[4] = bflo(u0.z); uu[5] = bfhi(u0.z); uu[6] = bflo(u0.w); uu[7] = bfhi(u0.w);
            uu[8] = bflo(u1.x); uu[9] = bfhi(u1.x); uu[10] = bflo(u1.y); uu[11] = bfhi(u1.y); uu[12] = bflo(u1.z); uu[13] = bfhi(u1.z); uu[14] = bflo(u1.w); uu[15] = bfhi(u1.w);
            float br = 0.f, bi = 0.f;
#pragma unroll
            for (int j = 0; j < 16; ++j) { br += bbr[j] * uu[j]; bi += bbi[j] * uu[j]; }
            const float nhr = ar * hr - ai * hi + br, nhi = ar * hi + ai * hr + bi; hr = nhr; hi = nhi;
            if (PASSB) { f32x2 hv; hv.x = hr; hv.y = hi; hb[ii * 64 + lane] = hv; } }
        if (PASSB) {
            asm volatile("s_waitcnt lgkmcnt(0)" ::: "memory"); __builtin_amdgcn_wave_barrier();
            float y0 = 0.f, y1 = 0.f;
#pragma unroll
            for (int q = 0; q < 64; q += 2) { const f32x2 a = hb[tsel * 64 + q], b = hb[tsel * 64 + q + 1]; y0 += creg[q] * a.x - cimg[q] * a.y; y1 += creg[q + 1] * b.x - cimg[q + 1] * b.y; }
            const int i = i0 + tsel, t = dir ? base + SEG - 1 - i : base + i;
            unsafeAtomicAdd(osum + (size_t)t * 1024 + g * 16 + jrow, y0 + y1);
            asm volatile("s_waitcnt lgkmcnt(0)" ::: "memory"); __builtin_amdgcn_wave_barrier();
        }
    }
    if (!PASSB) { float2 e; e.x = hr; e.y = hi; ((float2*)(p.ws + WS_C2E))[((sseg * 2 + dir) * 32 + g) * 64 + lane] = e; }
    else if (seg < 16) { float2 e; e.x = hr; e.y = hi; ((float2*)(p.out + OUT_S5))[(((seg * 2 + jl) * 2 + dir) * 32 + g) * 64 + lane] = e; }
}
template <bool PASSB>
__device__ __forceinline__ void cd_pass(const Params& p, LAS unsigned char* lds, int jl) {
    const int wave = __builtin_amdgcn_readfirstlane(otid() >> 6), G = gridDim.x;
    const int nseg = PASSB ? NSEG : NSSEG, s0 = PASSB ? 0 : 16;
    const int per = PASSB ? 16 : 32;
    const int ndn = nseg * per, ns5 = nseg * 64;
    for (int idx = wave * G + blockIdx.x; idx < ndn + ns5; idx += 8 * G) {
        if (idx < ndn) { const int seg = s0 + idx / per, r = idx % per;
            if (PASSB) dn_task<PASSB>(p, jl, seg, r >> 3, (r >> 1) & 3, r & 1); else dn_task<PASSB>(p, jl, seg, r >> 4, (r >> 2) & 3, r & 3); }
        else { const int j = idx - ndn, seg = s0 + j / 64, r = j % 64; s5_task<PASSB>(p, lds, jl, seg, r >> 5, r & 31); }
    }
}
__device__ __forceinline__ void cd_carry(const Params& p, LAS unsigned char* lds, int jl) {
    const int tid = otid();
    if (blockIdx.x < 128) {
        const int chain = blockIdx.x >> 3, cb = blockIdx.x & 7, head = chain & 3, dir = (chain >> 2) & 1, b = chain >> 3;
        LAS float* Sb = (LAS float*)lds;
        const int r = tid >> 2, cq = tid & 3, c = cb * 16 + cq * 4;
        f32x4 cur = *(const f32x4*)(p.in[I_SDN] + ((size_t)(((b * 2 + jl) * 2 + dir) * 4 + head) * 128 + r) * 128 + c);
        for (int s = 0; s < 16; ++s) { const int j = dir ? 15 - s : s, sseg = b * 16 + j; const size_t mo = ((size_t)((sseg * 2 + dir) * 4 + head) * 128 + r) * 128;
            *(f32x4*)((float*)(p.ws + WS_CS) + mo + c) = cur;
            *(LAS f32x4*)(Sb + r * 16 + cq * 4) = cur;
            __syncthreads();
            f32x4 acc = *(const f32x4*)((const float*)(p.ws + WS_CE) + mo + c);
            const float* pr = (const float*)(p.ws + WS_CP) + mo;
#pragma unroll 4
            for (int k = 0; k < 128; k += 4) { const f32x4 pk = *(const f32x4*)(pr + k);
                acc += pk[0] * *(const LAS f32x4*)(Sb + (k + 0) * 16 + cq * 4); acc += pk[1] * *(const LAS f32x4*)(Sb + (k + 1) * 16 + cq * 4);
                acc += pk[2] * *(const LAS f32x4*)(Sb + (k + 2) * 16 + cq * 4); acc += pk[3] * *(const LAS f32x4*)(Sb + (k + 3) * 16 + cq * 4); }
            __syncthreads();
            cur = acc; }
    } else {
        for (int i = (blockIdx.x - 128) * 512 + tid; i < 2 * 2 * 32 * 64; i += (gridDim.x - 128) * 512) {
            const int pp = i & 63, g = (i >> 6) & 31, dir = (i >> 11) & 1, b = i >> 12;
            const int pi = ((jl * 2 + dir) * 32 + g) * 64 + pp;
            const float lre = p.in[I_LAMRE][pi], lim = p.in[I_LAMIM][pi], dtv = expf(p.in[I_LOGDT][(jl * 2 + dir) * 32 + g]);
            const float er = expf(256.0f * (lre * dtv));
            double ph = 256.0 * ((double)lim * (double)dtv); ph -= 6.283185307179586 * rint(ph * 0.15915494309189535);
            float sn, cs; sincosf((float)ph, &sn, &cs);
            const float ar = er * cs, ai = er * sn;
            const float2 s0 = *(const float2*)(p.in[I_SS5] + ((size_t)(((b * 2 + jl) * 2 + dir) * 32 + g) * 64 + pp) * 2);
            float hr = s0.x, hi = s0.y;
            for (int s = 0; s < 16; ++s) { const int j = dir ? 15 - s : s, sseg = b * 16 + j; const int o = ((sseg * 2 + dir) * 32 + g) * 64 + pp;
                float2 v; v.x = hr; v.y = hi; ((float2*)(p.ws + WS_C2S))[o] = v; const float2 e = ((const float2*)(p.ws + WS_C2E))[o];
                const float nhr = ar * hr - ai * hi + e.x, nhi = ar * hi + ai * hr + e.y; hr = nhr; hi = nhi; }
        }
    }
}
__device__ __forceinline__ void cd_combine(const Params& p, int jl) {
    const int lane = otid() & 63, gw = blockIdx.x * 8 + (otid() >> 6), nw = gridDim.x * 8;
    const bf16_t* proj = (const bf16_t*)(p.ws + WS_PROJ); const float* osum = (const float*)(p.ws + WS_OSUM); bf16_t* mixed = (bf16_t*)(p.ws + WS_HN); bf16_t* zg = (bf16_t*)(p.ws + WS_ZG);
    for (int t = gw; t < NT; t += nw) {
        const bf16_t* pr = proj + (size_t)t * PLD; const float* os = osum + (size_t)t * 1024;
#pragma unroll
        for (int i = 0; i < 4; ++i) { const int c = i * 128 + 2 * lane; const float2 y = *(const float2*)(os + c); const unsigned u = *(const unsigned*)(pr + c); const float2 d = *(const float2*)(p.in[I_S5D] + jl * 512 + c);
            *(unsigned*)(zg + (size_t)t * 512 + c) = pk2(geluf_(y.x + d.x * bflo(u)), geluf_(y.y + d.y * bfhi(u))); }
#pragma unroll
        for (int hd = 0; hd < 4; ++hd) { const int c = hd * 128 + 2 * lane; const float2 o = *(const float2*)(os + 512 + c);
            const float ss = wave_sum(o.x * o.x + o.y * o.y); const float rs = rsqrtf(ss * (1.0f / 128.0f) + EPS);
            const unsigned z = *(const unsigned*)(pr + 2048 + c); const float2 nw2 = *(const float2*)(p.in[I_DNNW] + jl * 128 + 2 * lane);
            *(unsigned*)(mixed + (size_t)t * 1024 + 512 + c) = pk2(o.x * rs * nw2.x * siluf_(bflo(z)), o.y * rs * nw2.y * siluf_(bfhi(z))); }
    }
}

__global__ void __launch_bounds__(512) fwd_mega(Params p) {
    extern __shared__ __attribute__((aligned(16))) unsigned char lds_raw[];
    LAS unsigned char* lds = (LAS unsigned char*)lds_raw;
    cg::grid_group grid = cg::this_grid();
    const int G = gridDim.x, bid = blockIdx.x;
    unsigned char* ws = p.ws;
    float* X = (float*)(ws + WS_X); bf16_t* HN = (bf16_t*)(ws + WS_HN); bf16_t* PROJ = (bf16_t*)(ws + WS_PROJ);
    const float* MOD = (const float*)(ws + WS_MOD);

    phase0(p, lds);
    grid.sync();
#pragma unroll 1
    for (int l = 0; l < 4; ++l) {
        const int jl = l >> 1; const bool isAB = (l & 1) == 0;
        const float* mod = MOD + (size_t)l * 3 * 6144;
        if (l > 0) prep_weights(p, lds, l);
        zero_osum(p);
        norm_phase<false>(X, p.in[I_N1W] + l * 1024, mod + 0, mod + 1024, HN, nullptr);
        grid.sync();
        { pg8::Gemm g{HN, (const bf16_t*)(ws + WS_WIN), NT, 2816, 1024}; pg8::StaticOrder S; S.init(NT, 2816, G, bid); EpiProj E{PROJ, PLD};
          pg8::gemm_phase<EpiProj, pg8::StaticOrder>(lds, g, S, E, nullptr); }
        grid.sync();
        if (isAB) {
            ab_pass<false>(p, jl); grid.sync();
            ab_carry(p, jl); grid.sync();
            ab_pass<true>(p, jl); grid.sync();
            ab_combine(p, jl); grid.sync();
        } else {
            cd_m1(p, jl); grid.sync();
            cd_pass<false>(p, lds, jl); grid.sync();
            cd_carry(p, lds, jl); grid.sync();
            cd_pass<true>(p, lds, jl); grid.sync();
            cd_combine(p, jl); grid.sync();
            { pg8::Gemm g{(const bf16_t*)(ws + WS_ZG), (const bf16_t*)(ws + WS_WGLU), NT, 512, 512}; pg8::StaticOrder S; S.init(NT, 512, G, bid);
              EpiGLU E{HN, (const bf16_t*)(ws + WS_ZG), p.in[I_GLUB] + jl * 512};
              pg8::gemm_phase<EpiGLU, pg8::StaticOrder>(lds, g, S, E, nullptr); }
            grid.sync();
        }
        { pg8::Gemm g{HN, (const bf16_t*)(ws + WS_WOUT), NT, 1024, 1024}; pg8::StaticOrder S; S.init(NT, 1024, G, bid); EpiResid E{X, mod + 2048};
          pg8::gemm_phase<EpiResid, pg8::StaticOrder>(lds, g, S, E, nullptr); }
        grid.sync();
        norm_phase<false>(X, p.in[I_N2W] + l * 1024, mod + 3072, mod + 4096, HN, nullptr);
        grid.sync();
        { pg8::Gemm g{HN, (const bf16_t*)(ws + WS_WGU), NT, 5632, 1024}; pg8::StaticOrder S; S.init(NT, 5632, G, bid); EpiSwiGLU E{PROJ};
          pg8::gemm_phase<EpiSwiGLU, pg8::StaticOrder>(lds, g, S, E, nullptr); }
        grid.sync();
        { pg8::Gemm g{PROJ, (const bf16_t*)(ws + WS_WDN), NT, 1024, 2816}; pg8::StaticOrder S; S.init(NT, 1024, G, bid); EpiResid E{X, mod + 5120};
          pg8::gemm_phase<EpiResid, pg8::StaticOrder>(lds, g, S, E, nullptr); }
        grid.sync();
    }
    norm_phase<true>(X, p.in[I_FNW], nullptr, nullptr, nullptr, p.out + OUT_Y);
}

extern "C" void kernel_launch(void* const* d_in, const int* in_sizes, int n_in, void* d_out, int out_size, void* d_ws, size_t ws_size, hipStream_t stream) {
    static int grid_blocks = 0;
    if (grid_blocks == 0) {
        if (n_in != 44 || ws_size < WS_END) { fprintf(stderr, "kernel_launch: need 44 inputs and %zu bytes of workspace; got %d, %zu\n", (size_t)WS_END, n_in, ws_size); grid_blocks = -1; return; }
        int dev = 0, cus = 0, per_cu = 0;
        (void)hipGetDevice(&dev); (void)hipDeviceGetAttribute(&cus, hipDeviceAttributeMultiprocessorCount, dev);
        if (hipFuncSetAttribute((const void*)fwd_mega, hipFuncAttributeMaxDynamicSharedMemorySize, LDS_BYTES) != hipSuccess) { fprintf(stderr, "kernel_launch: hipFuncSetAttribute failed\n"); grid_blocks = -1; return; }
        if (hipOccupancyMaxActiveBlocksPerMultiprocessor(&per_cu, (const void*)fwd_mega, 512, LDS_BYTES) != hipSuccess || per_cu < 1) { fprintf(stderr, "kernel_launch: occupancy query gave %d\n", per_cu); per_cu = 1; }
        (void)hipGetLastError();
        grid_blocks = cus;
    }
    if (grid_blocks < 0) return;
    Params p{};
    for (int i = 0; i < 44; ++i) p.in[i] = (const float*)d_in[i];
    p.out = (float*)d_out; p.ws = (unsigned char*)d_ws;
    void* args[] = {&p};
    hipError_t e = hipLaunchCooperativeKernel((const void*)fwd_mega, dim3(grid_blocks), dim3(512), args, LDS_BYTES, stream);
    if (e != hipSuccess) fprintf(stderr, "cooperative launch failed: %s (grid %d)\n", hipGetErrorString(e), grid_blocks);
}
```

```cpp
#include <hip/hip_runtime.h>
#include <hip/hip_cooperative_groups.h>
#include <cstdio>
namespace cg = cooperative_groups;
__device__ __forceinline__ int otid() { int t = threadIdx.x; asm volatile("" : "+v"(t)); return t; }
__device__ __forceinline__ int obid() { int b = blockIdx.x; asm volatile("" : "+s"(b)); return b; }
namespace pg8 {
#define PG8_LAS __attribute__((address_space(3)))
typedef unsigned short bf16_t;
typedef short bf16x8 __attribute__((ext_vector_type(8)));
typedef float f32x4 __attribute__((ext_vector_type(4)));
typedef unsigned u32x4 __attribute__((ext_vector_type(4)));
constexpr int BM = 256, BK = 64, HALF = 128, HTB = HALF * BK * 2  , STAGE_BYTES = 8 * HTB, NXCD = 8, WGM = 8;

__host__ __device__ __forceinline__ int lds_byte(int r, int c) { const int st = (r >> 4) * 2 + (c >> 5), rr = r & 15, cc = c & 31, ob = rr * 64 + cc * 2; return st * 1024 + (ob ^ (((ob >> 9) & 1) << 5)); }
__host__ __device__ __forceinline__ void stage_rc(int b, int& R, int& C) { const int st = b / 1024, sb = b % 1024, swz = sb ^ (((sb >> 9) & 1) << 5); R = (st >> 1) * 16 + swz / 64; C = (st & 1) * 32 + (swz % 64) / 2; }
__host__ __device__ __forceinline__ int perm32(int rho) { const int n = rho >> 4, i = rho & 15; return 8 * (i >> 2) + 4 * n + (i & 3); }

struct Unit { int pm, pn; };
struct Gemm { const bf16_t* A; const bf16_t* Bt; int M, N, K; };

struct StaticOrder {
    int nM, nN, nwg, G, c;
    __host__ __device__ void init(int M, int N, int G_, int c_) { nM = M / BM; nN = N / BM; nwg = nM * nN; G = G_; c = c_; }
    __host__ __device__ bool next(int i, Unit& u) const {
        const long L = (long)i * G + c; if (L >= nwg) return false;
        int wgid = (int)L; { const int q = nwg / NXCD, r = nwg % NXCD, xcd = wgid % NXCD, off = wgid / NXCD; wgid = (xcd < r ? xcd * (q + 1) : r * (q + 1) + (xcd - r) * q) + off; }
        const int nig = WGM * nN, gid = wgid / nig, fm = gid * WGM, gsz = (nM - fm) < WGM ? (nM - fm) : WGM;
        u.pm = fm + ((wgid % nig) % gsz); u.pn = (wgid % nig) / gsz; return true;
    }
    __device__ __forceinline__ void a_ready(const Unit&) const {}
    __device__ __forceinline__ void done(const Unit&) const {}
};
__device__ __forceinline__ unsigned cvt_pk_bf16(float lo, float hi) { unsigned r; asm volatile("v_cvt_pk_bf16_f32 %0, %1, %2" : "=v"(r) : "v"(lo), "v"(hi)); return r; }
typedef float f32x2 __attribute__((ext_vector_type(2)));
template <class Epi, class Sched, bool STAMP = false>
__device__ __forceinline__ void gemm_phase(PG8_LAS unsigned char* lds, const Gemm g, const Sched& S, const Epi& E, unsigned long long* stamps) {
    const int tid = otid(), wid = __builtin_amdgcn_readfirstlane(tid >> 6), lane = tid & 63, wr = wid >> 2, wc = wid & 3, fr = lane & 15, fq = lane >> 4;
    const int K = g.K, nt = K / BK;
    int ts_lo = 0, ts_hi = 0, nts = 0; const unsigned long long rt_entry = STAMP ? (unsigned long long)wall_clock64() : 0ull;
#define PG8_STAMP() do { if (STAMP && wid == 0 && nts < 64) { const unsigned long long _c = (unsigned long long)clock64(); \
        ts_lo = (lane == nts) ? (int)(unsigned)_c : ts_lo; ts_hi = (lane == nts) ? (int)(unsigned)(_c >> 32) : ts_hi; ++nts; } } while (0)
    PG8_STAMP();
    unsigned voffA[2], voffB[2];
#pragma unroll
    for (int i = 0; i < 2; ++i) { int R, C; stage_rc(tid * 16 + i * 8192, R, C); const int Rb = Epi::PERM ? ((R & ~31) + perm32(R & 31)) : R;
        voffA[i] = (unsigned)(R * K + C) * 2u; voffB[i] = (unsigned)(Rb * K + C) * 2u; }
    const size_t kstep = (size_t)(BK * 2);
    const size_t hstep = (size_t)HALF * K * 2;
    const size_t tstep = 2 * hstep;
    const unsigned ldsw = (unsigned)wid * 1024u;
    const int aoff = lds_byte(wr * 64 + fr, fq * 8), boff = lds_byte(wc * 32 + fr, fq * 8);
#define PG8_SA(b, h) (((b) * 2 + (h)) * HTB)
#define PG8_SB(b, h) ((4 + (b) * 2 + (h)) * HTB)
#define PG8_STAGE(bufoff, gbase, voff) do { _Pragma("unroll") for (int _i = 0; _i < 2; ++_i) \
        __builtin_amdgcn_global_load_lds((const unsigned*)((const char*)(gbase) + (voff)[_i]), (PG8_LAS unsigned*)(lds + (bufoff) + ldsw + _i * 8192), 16, 0, 0); } while (0)
#define PG8_LDA(dst, b, h) do { _Pragma("unroll") for (int m = 0; m < 4; ++m) _Pragma("unroll") for (int k = 0; k < 2; ++k) dst[m][k] = *(const PG8_LAS bf16x8*)(lds + PG8_SA(b, h) + aoff + m * 2048 + k * 1024); } while (0)
#define PG8_LDB(dst, b, h) do { _Pragma("unroll") for (int n = 0; n < 2; ++n) _Pragma("unroll") for (int k = 0; k < 2; ++k) dst[n][k] = *(const PG8_LAS bf16x8*)(lds + PG8_SB(b, h) + boff + n * 2048 + k * 1024); } while (0)
#define PG8_MMA(ai, bj, At, Bt) do { __builtin_amdgcn_s_setprio(1); _Pragma("unroll") for (int m = 0; m < 4; ++m) _Pragma("unroll") for (int n = 0; n < 2; ++n) _Pragma("unroll") for (int k = 0; k < 2; ++k) \
        acc[ai][bj][m][n] = __builtin_amdgcn_mfma_f32_16x16x32_bf16(Bt[n][k], At[m][k], acc[ai][bj][m][n], 0, 0, 0); __builtin_amdgcn_s_setprio(0); } while (0)
#define PG8_WAIT_V(n) asm volatile("s_waitcnt vmcnt(" #n ")" ::: "memory")
#define PG8_WAIT_L(n) asm volatile("s_waitcnt lgkmcnt(" #n ")" ::: "memory")
#define PG8_BAR __builtin_amdgcn_s_barrier()
#define PG8_SCHED __builtin_amdgcn_sched_barrier(0)
    Unit cur, nxt; int ui = 0;
    if (!S.next(0, cur)) return;
    f32x4 acc[2][2][4][2];
#pragma unroll
    for (int a = 0; a < 2; ++a)
#pragma unroll
        for (int b = 0; b < 2; ++b)
#pragma unroll
            for (int m = 0; m < 4; ++m)
#pragma unroll
                for (int n = 0; n < 2; ++n) acc[a][b][m][n] = (f32x4){0.f, 0.f, 0.f, 0.f};
    bf16x8 At[4][2], B0[2][2], B1[2][2];
    const char* cA = (const char*)g.A + (size_t)cur.pm * tstep; const char* cB = (const char*)g.Bt + (size_t)cur.pn * tstep;
    S.a_ready(cur);
    PG8_STAGE(PG8_SB(0, 0), cB, voffB); PG8_STAGE(PG8_SA(0, 0), cA, voffA); PG8_STAGE(PG8_SB(0, 1), cB + hstep, voffB); PG8_STAGE(PG8_SA(0, 1), cA + hstep, voffA);
    if (wr == 1) PG8_BAR;
    PG8_WAIT_V(4); PG8_BAR;
    PG8_STAGE(PG8_SB(1, 0), cB + kstep, voffB); PG8_STAGE(PG8_SA(1, 0), cA + kstep, voffA); PG8_STAGE(PG8_SB(1, 1), cB + hstep + kstep, voffB);
    PG8_WAIT_V(6); PG8_BAR;
    PG8_STAMP();
    for (;;) {
        const bool has_next = S.next(ui + 1, nxt);
        const char* nA = has_next ? (const char*)g.A + (size_t)nxt.pm * tstep : cA; const char* nB = has_next ? (const char*)g.Bt + (size_t)nxt.pn * tstep : cB;
        for (int t = 0; t < nt; t += 2) {
            const bool last = (t == nt - 2);
            const char* a1 = cA + (size_t)(t + 1) * kstep;
            const char* a2 = last ? nA : cA + (size_t)(t + 2) * kstep; const char* b2 = last ? nB : cB + (size_t)(t + 2) * kstep;
            const char* a3 = a2 + kstep; const char* b3 = b2 + kstep;
            if (last && has_next) S.a_ready(nxt);
            PG8_LDB(B0, 0, 0); PG8_SCHED; PG8_LDA(At, 0, 0); PG8_STAGE(PG8_SA(1, 1), a1 + hstep, voffA);
            PG8_WAIT_L(8); PG8_BAR; PG8_WAIT_L(0); PG8_MMA(0, 0, At, B0); PG8_BAR; PG8_SCHED;
            PG8_LDB(B1, 0, 1); PG8_STAGE(PG8_SB(0, 0), b2, voffB);
            PG8_BAR; PG8_WAIT_L(0); PG8_MMA(0, 1, At, B1); PG8_BAR;
            PG8_LDA(At, 0, 1); PG8_STAGE(PG8_SA(0, 0), a2, voffA);
            PG8_BAR; PG8_WAIT_L(0); PG8_MMA(1, 0, At, B0); PG8_BAR; PG8_SCHED;
            PG8_STAGE(PG8_SB(0, 1), b2 + hstep, voffB);
            PG8_WAIT_V(6); PG8_BAR; PG8_MMA(1, 1, At, B1); PG8_BAR;
            PG8_LDB(B0, 1, 0); PG8_SCHED; PG8_LDA(At, 1, 0); PG8_STAGE(PG8_SA(0, 1), a2 + hstep, voffA);
            PG8_WAIT_L(8); PG8_BAR; PG8_WAIT_L(0); PG8_MMA(0, 0, At, B0); PG8_BAR; PG8_SCHED;
            PG8_LDB(B1, 1, 1); PG8_STAGE(PG8_SB(1, 0), b3, voffB);
            PG8_BAR; PG8_WAIT_L(0); PG8_MMA(0, 1, At, B1); PG8_BAR;
            PG8_LDA(At, 1, 1); PG8_STAGE(PG8_SA(1, 0), a3, voffA);
            PG8_BAR; PG8_WAIT_L(0); PG8_MMA(1, 0, At, B0); PG8_BAR; PG8_SCHED;
            PG8_STAGE(PG8_SB(1, 1), b3 + hstep, voffB);
            PG8_WAIT_V(6); PG8_BAR; PG8_MMA(1, 1, At, B1); PG8_BAR;
        }
        PG8_STAMP();
        if constexpr (!Epi::AFTER_DRAIN) { E(acc, cur, wr, wc, fr, fq); S.done(cur); }
        PG8_STAMP();
        if (!has_next) break;
#pragma unroll
        for (int a = 0; a < 2; ++a)
#pragma unroll
            for (int b = 0; b < 2; ++b)
#pragma unroll
                for (int m = 0; m < 4; ++m)
#pragma unroll
                    for (int n = 0; n < 2; ++n) acc[a][b][m][n] = (f32x4){0.f, 0.f, 0.f, 0.f};
        cur = nxt; cA = nA; cB = nB; ++ui;
    }
    PG8_WAIT_V(0);
    if (wr == 0) PG8_BAR;
    PG8_BAR;
    if constexpr (Epi::AFTER_DRAIN) { E.fused(acc, cur, wr, wc, fr, fq, lds, wid, lane); S.done(cur); }
    PG8_STAMP();
    if (STAMP && wid == 0) { stamps[lane] = lane < nts ? (((unsigned long long)(unsigned)ts_hi << 32) | (unsigned)ts_lo) : 0ull;
        if (lane == 62) stamps[62] = rt_entry; if (lane == 63) stamps[63] = (unsigned long long)wall_clock64(); }
#undef PG8_STAMP
#undef PG8_SA
#undef PG8_SB
#undef PG8_STAGE
#undef PG8_LDA
#undef PG8_LDB
#undef PG8_MMA
#undef PG8_WAIT_V
#undef PG8_WAIT_L
#undef PG8_BAR
#undef PG8_SCHED
}
}

using pg8::bf16_t; using pg8::f32x4; using pg8::u32x4; using pg8::Unit;
#define LAS __attribute__((address_space(3)))
typedef unsigned u32x2 __attribute__((ext_vector_type(2)));
typedef float f32x2 __attribute__((ext_vector_type(2)));

constexpr int NT = 12288, DM = 1024, SEG = 256, NSEG = 48, NSSEG = 32, PLD = 2816, DFF = 2816;
constexpr float EPS = 1e-6f;
constexpr int LDS_BAR = 159776, LDS_BYTES = LDS_BAR + 256;

constexpr size_t WS_X     = 0;
constexpr size_t WS_HN    = WS_X + (size_t)NT * DM * 4;
constexpr size_t WS_PROJ  = WS_HN + (size_t)NT * DM * 2;
constexpr size_t WS_WIN   = WS_PROJ + (size_t)NT * PLD * 2;
constexpr size_t WS_WOUT  = WS_WIN + (size_t)2816 * 1024 * 2;
constexpr size_t WS_WGU   = WS_WOUT + (size_t)1024 * 1024 * 2;
constexpr size_t WS_WDN   = WS_WGU + (size_t)5632 * 1024 * 2;
constexpr size_t WS_WGLU  = WS_WDN + (size_t)1024 * 2816 * 2;
constexpr size_t WS_MOD   = WS_WGLU + (size_t)512 * 512 * 2;
constexpr size_t WS_OSUM  = WS_MOD + (size_t)4 * 3 * 6144 * 4;
constexpr size_t WS_YS    = WS_OSUM + (size_t)NT * 512 * 4;
constexpr size_t WS_IMG   = WS_OSUM + (size_t)NT * 1024 * 4;
constexpr size_t WS_ZG    = WS_IMG + (size_t)1536 * 81984;
constexpr size_t WS_CE    = WS_ZG + (size_t)NT * 512 * 2;
constexpr size_t CARRY_SZ = (size_t)NSSEG * 2 * 4 * 64 * 128 * 4;
constexpr size_t WS_OB    = WS_CE;
constexpr size_t WS_CP    = WS_CE + CARRY_SZ;
constexpr size_t WS_CS    = WS_CP + CARRY_SZ;
constexpr size_t WS_C2E   = WS_CS + CARRY_SZ;
constexpr size_t C2_SZ    = (size_t)NSSEG * 2 * 32 * 64 * 2 * 4;
constexpr size_t WS_C2D   = WS_C2E + C2_SZ;
constexpr size_t WS_C2S   = WS_C2D + C2_SZ;
constexpr size_t WS_BAR   = WS_C2S + C2_SZ;
constexpr size_t WS_END   = WS_BAR + 32768;

constexpr size_t OUT_Y   = 0;
constexpr size_t OUT_GLA = (size_t)NT * 1024;
constexpr size_t OUT_RG  = OUT_GLA + (size_t)16 * 2 * 2 * 4 * 64 * 128;
constexpr size_t OUT_S5  = OUT_RG + (size_t)16 * 2 * 2 * 512;
constexpr size_t OUT_DN  = OUT_S5 + (size_t)16 * 2 * 2 * 32 * 64 * 2;

struct Params { const float* in[44]; float* out; unsigned char* ws; };

typedef const __attribute__((address_space(4))) char* kptr_t;
__device__ __forceinline__ kptr_t KARG() { kptr_t k = (kptr_t)__builtin_amdgcn_kernarg_segment_ptr(); asm volatile("" : "+s"(k)); return k; }
#define AS1 __attribute__((address_space(1)))
__device__ __forceinline__ const float* PIN(int i) { const float* q = *(const float* const __attribute__((address_space(4)))*)(KARG() + i * 8); return (const float*)(const AS1 float*)q; }
__device__ __forceinline__ float* POUT() { float* q = *(float* const __attribute__((address_space(4)))*)(KARG() + 44 * 8); return (float*)(AS1 float*)q; }
__device__ __forceinline__ unsigned char* WSP(const Params& p) { unsigned char* w = *(unsigned char* const __attribute__((address_space(4)))*)(KARG() + 45 * 8); asm volatile("" : "+s"(w)); return (unsigned char*)(AS1 unsigned char*)w; }
__device__ __forceinline__ void gatomic_add(float* q, float v) { (void)__builtin_amdgcn_global_atomic_fadd_f32((AS1 float*)q, v); }
enum { I_XP = 0, I_XS, I_SGLA, I_SRG, I_SS5, I_SDN, I_C, I_CCTX, I_N1W, I_N2W, I_WMOD, I_BMOD, I_ABIN, I_ABOUT, I_WG2, I_BG, I_GLANW,
       I_RGCW, I_RGCB, I_RGWA, I_RGBA, I_RGWX, I_RGBX, I_RGLAM, I_CDIN, I_CDOUT, I_LAMRE, I_LAMIM, I_LOGDT, I_BRE, I_BIM, I_CRE, I_CIM,
       I_S5D, I_GLUW, I_GLUB, I_DNCW, I_ALOG, I_DTB, I_DNNW, I_FG, I_FU, I_FD, I_FNW };

__device__ __forceinline__ float bf2f(bf16_t b) { return __uint_as_float(((unsigned)b) << 16); }
__device__ __forceinline__ float bflo(unsigned w) { return __uint_as_float(w << 16); }
__device__ __forceinline__ float bfhi(unsigned w) { return __uint_as_float(w & 0xffff0000u); }
typedef __bf16 bf16x2_t __attribute__((ext_vector_type(2)));
__device__ __forceinline__ unsigned pk2(float lo, float hi) { f32x2 f = {lo, hi}; bf16x2_t r = __builtin_convertvector(f, bf16x2_t); return __builtin_bit_cast(unsigned, r); }
__device__ __forceinline__ unsigned f2bf(float f) { return pk2(f, 0.f) & 0xffffu; }
__device__ __forceinline__ float rdl(float v, int l) { return __int_as_float(__builtin_amdgcn_readlane(__float_as_int(v), l)); }
__device__ __forceinline__ float sigmoidf_(float x) { return __builtin_amdgcn_rcpf(1.0f + __expf(-x)); }
__device__ __forceinline__ float siluf_(float x) { return x * __builtin_amdgcn_rcpf(1.0f + __expf(-x)); }
__device__ __forceinline__ float softplusf_(float x) { return fmaxf(x, 0.f) + __logf(1.0f + __expf(-fabsf(x))); }
__device__ __forceinline__ float geluf_(float x) { return x * sigmoidf_(1.5957691216057308f * (x + 0.044715f * x * x * x)); }
__device__ __forceinline__ float wave_sum(float v) {
#pragma unroll
    for (int o = 32; o >= 1; o >>= 1) v += __shfl_xor(v, o);
    return v;
}
__device__ __forceinline__ int cv_of_tok(int t) { return t < 4096 ? 0 : 1 + ((t - 4096) >> 12); }
__device__ __forceinline__ void seq_bounds(int t, int& lo, int& hi) { if (t < 4096) { lo = t & ~255; hi = lo + 256; } else { lo = 4096 + ((t - 4096) & ~4095); hi = lo + 4096; } }

#define XB_TMO      128
#define XB_XCNT(j)  (256  + 64 * (j))
#define XB_XSUB(j)  (1280 + 64 * (j))
#define XB_XGEN(j)  (2304 + 64 * (j))
#define XB_TOP      3328
#define XB_TOPGEN   3392
#define XCD_BAR_WORDS 3456
#define XB_SPIN_CAP (1u << 18)

__device__ __forceinline__ unsigned xb_ld(unsigned* p)              { return __hip_atomic_load(p, __ATOMIC_RELAXED, __HIP_MEMORY_SCOPE_AGENT); }
__device__ __forceinline__ unsigned xb_add(unsigned* p, unsigned v) { return __hip_atomic_fetch_add(p, v, __ATOMIC_RELAXED, __HIP_MEMORY_SCOPE_AGENT); }
__device__ __forceinline__ unsigned xb_xcc_id() { return (unsigned)__builtin_amdgcn_s_getreg((3 << 11) | 20) & 0xFu; }
#define XB_SPIN(cond, bar) do { unsigned _sp = 0; while (cond) { __builtin_amdgcn_s_sleep(1); \
    if ((++_sp & 255u) == 0u) { if (xb_ld(&(bar)[XB_TMO])) break; if (_sp > XB_SPIN_CAP) { atomicAdd(&(bar)[XB_TMO], 1u); break; } } } } while (0)
struct XcdBarrier {
    unsigned* bar; unsigned x; unsigned G;
    volatile LAS unsigned* st;
};

__device__ __forceinline__ XcdBarrier xcd_barrier_post(unsigned* bar, volatile LAS unsigned* st, unsigned G) {
    XcdBarrier b; b.bar = bar; b.x = xb_xcc_id(); b.st = st; b.G = G;
    if (threadIdx.x == 0) (void)xb_add(&bar[XB_XCNT(b.x)], 1u);
    return b;
}
__device__ __forceinline__ void xcd_barrier_complete(unsigned* bar, unsigned x, unsigned G, unsigned& nloc, unsigned& nx) {
    unsigned sum, cnt, mine, sp = 0u;
    for (;;) {
        sum = 0u; cnt = 0u; mine = 0u;
#pragma unroll
        for (unsigned j = 0; j < 16; ++j) { const unsigned c = xb_ld(&bar[XB_XCNT(j)]); sum += c; cnt += (c > 0u) ? 1u : 0u; mine = (j == x) ? c : mine; }
        if (sum == G) break;
        __builtin_amdgcn_s_sleep(1);
        if ((++sp & 255u) == 0u) { if (xb_ld(&bar[XB_TMO])) break; if (sp > XB_SPIN_CAP) { atomicAdd(&bar[XB_TMO], 1u); break; } }
    }
    nloc = mine > 0u ? mine : 1u; nx = cnt > 0u ? cnt : 1u;
}

__device__ __forceinline__ void xcd_barrier(const XcdBarrier& b) {
    asm volatile("s_waitcnt vmcnt(0)" ::: "memory");
    __syncthreads();
    if (threadIdx.x == 0) {
        unsigned* bar = b.bar;
        __builtin_amdgcn_s_waitcnt(0);
        unsigned nloc = b.st[0], nx = b.st[1];
        if (nloc == 0u) { xcd_barrier_complete(bar, b.x, b.G, nloc, nx); b.st[0] = nloc; b.st[1] = nx; }
        const unsigned old = xb_add(&bar[XB_XSUB(b.x)], 1u);
        const unsigned gen = old / nloc;
        if (old + 1u == (gen + 1u) * nloc) {
            __builtin_amdgcn_fence(__ATOMIC_RELEASE, "agent");
            asm volatile("s_waitcnt vmcnt(0)" ::: "memory");
            const unsigned og = xb_add(&bar[XB_TOP], 1u);
            const unsigned tg = og / nx;
            if (og + 1u == (tg + 1u) * nx) xb_add(&bar[XB_TOPGEN], 1u);
            else XB_SPIN(xb_ld(&bar[XB_TOPGEN]) == tg, bar);
            __builtin_amdgcn_fence(__ATOMIC_ACQUIRE, "agent");
            xb_add(&bar[XB_XGEN(b.x)], 1u);
            asm volatile("s_waitcnt vmcnt(0)" ::: "memory");
        } else {
            XB_SPIN(xb_ld(&bar[XB_XGEN(b.x)]) == gen, bar);
            __builtin_amdgcn_fence(__ATOMIC_ACQUIRE, "agent");
            asm volatile("s_waitcnt vmcnt(0)" ::: "memory");
        }
    }
    __syncthreads();
}

struct EpiProj {
    static constexpr bool PERM = true, AFTER_DRAIN = false;
    bf16_t* O; int ldc;
    __device__ __forceinline__ void operator()(const f32x4 (&acc)[2][2][4][2], const Unit& u, int wr, int wc, int fr, int fq) const {
        const int row0 = u.pm * 256 + wr * 64 + fr, col0 = u.pn * 256 + wc * 32 + 8 * fq;
#pragma unroll
        for (int ai = 0; ai < 2; ++ai)
#pragma unroll
            for (int m = 0; m < 4; ++m) { bf16_t* rowp = O + (size_t)(row0 + ai * 128 + m * 16) * ldc + col0;
#pragma unroll
                for (int bj = 0; bj < 2; ++bj) { const f32x4 v0 = acc[ai][bj][m][0], v1 = acc[ai][bj][m][1];
                    u32x4 w; w.x = pk2(v0[0], v0[1]); w.y = pk2(v0[2], v0[3]); w.z = pk2(v1[0], v1[1]); w.w = pk2(v1[2], v1[3]);
                    *(u32x4*)(rowp + bj * 128) = w; } }
    }
};
struct EpiResid {
    static constexpr bool PERM = false, AFTER_DRAIN = false;
    float* X; const float* gate;
    __device__ __forceinline__ void operator()(const f32x4 (&acc)[2][2][4][2], const Unit& u, int wr, int wc, int fr, int fq) const {
        const int row0 = u.pm * 256 + wr * 64 + fr, col0 = u.pn * 256 + wc * 32 + 4 * fq;
        const int cv = u.pm < 16 ? 0 : 1 + ((u.pm - 16) >> 4);
        const float* gp = gate + cv * 6144 + col0;
        f32x4 gv[2][2];
#pragma unroll
        for (int bj = 0; bj < 2; ++bj)
#pragma unroll
            for (int n = 0; n < 2; ++n) gv[bj][n] = *(const f32x4*)(gp + bj * 128 + n * 16);
#pragma unroll
        for (int ai = 0; ai < 2; ++ai)
#pragma unroll
            for (int m = 0; m < 4; ++m) { float* rowp = X + (size_t)(row0 + ai * 128 + m * 16) * 1024 + col0;
#pragma unroll
                for (int bj = 0; bj < 2; ++bj)
#pragma unroll
                    for (int n = 0; n < 2; ++n) { f32x4* q = (f32x4*)(rowp + bj * 128 + n * 16); *q = *q + gv[bj][n] * acc[ai][bj][m][n]; } }
    }
};
struct EpiSwiGLU {
    static constexpr bool PERM = true, AFTER_DRAIN = false;
    bf16_t* O;
    __device__ __forceinline__ void operator()(const f32x4 (&acc)[2][2][4][2], const Unit& u, int wr, int wc, int fr, int fq) const {
        const int row0 = u.pm * 256 + wr * 64 + fr, col0 = u.pn * 128 + wc * 32 + 8 * fq;
#pragma unroll
        for (int ai = 0; ai < 2; ++ai)
#pragma unroll
            for (int m = 0; m < 4; ++m) { bf16_t* rowp = O + (size_t)(row0 + ai * 128 + m * 16) * DFF + col0;
                float r[8];
#pragma unroll
                for (int n = 0; n < 2; ++n)
#pragma unroll
                    for (int j = 0; j < 4; ++j) { const float g = acc[ai][0][m][n][j], up = acc[ai][1][m][n][j]; r[n * 4 + j] = g * __builtin_amdgcn_rcpf(1.0f + __expf(-g)) * up; }
                u32x4 w; w.x = pk2(r[0], r[1]); w.y = pk2(r[2], r[3]); w.z = pk2(r[4], r[5]); w.w = pk2(r[6], r[7]);
                *(u32x4*)rowp = w; }
    }
};
struct EpiGLU {
    static constexpr bool PERM = true, AFTER_DRAIN = false;
    bf16_t* O; const bf16_t* ZG; const float* bias;
    __device__ __forceinline__ void operator()(const f32x4 (&acc)[2][2][4][2], const Unit& u, int wr, int wc, int fr, int fq) const {
        const int row0 = u.pm * 256 + wr * 64 + fr, col0 = u.pn * 256 + wc * 32 + 8 * fq;
#pragma unroll
        for (int ai = 0; ai < 2; ++ai)
#pragma unroll
            for (int m = 0; m < 4; ++m) { const int row = row0 + ai * 128 + m * 16;
#pragma unroll
                for (int bj = 0; bj < 2; ++bj) { const int c = col0 + bj * 128;
                    const u32x4 z = *(const u32x4*)(ZG + (size_t)row * 512 + c);
                    const f32x4 b0 = *(const f32x4*)(bias + c), b1 = *(const f32x4*)(bias + c + 4);
                    const f32x4 v0 = acc[ai][bj][m][0] + b0, v1 = acc[ai][bj][m][1] + b1;
                    float r[8];
                    r[0] = bflo(z.x) * sigmoidf_(v0[0]); r[1] = bfhi(z.x) * sigmoidf_(v0[1]); r[2] = bflo(z.y) * sigmoidf_(v0[2]); r[3] = bfhi(z.y) * sigmoidf_(v0[3]);
                    r[4] = bflo(z.z) * sigmoidf_(v1[0]); r[5] = bfhi(z.z) * sigmoidf_(v1[1]); r[6] = bflo(z.w) * sigmoidf_(v1[2]); r[7] = bfhi(z.w) * sigmoidf_(v1[3]);
                    u32x4 w; w.x = pk2(r[0], r[1]); w.y = pk2(r[2], r[3]); w.z = pk2(r[4], r[5]); w.w = pk2(r[6], r[7]);
                    *(u32x4*)(O + (size_t)row * 1024 + c) = w; } }
    }
};

__device__ __forceinline__ void prep_mat(LAS unsigned char* lds, bf16_t* dst, int NR, int K, const float* src0, const float* src1, int ldsrc, int nvalid, int mode, int fb = 0) {
    LAS float* tl = (LAS float*)lds;
    const int tid = otid(), ntn = NR >> 6, ntk = K >> 7, ntile = ntn * ntk;
    for (int tile = obid() - fb; tile < ntile; tile += gridDim.x - fb) {
        const int n0 = (tile % ntn) * 64, k0 = (tile / ntn) * 128;
        { const int nl = tid & 63, kl0 = tid >> 6, n = n0 + nl; const float* sp = src0; int col;
          if (mode == 0) col = n < nvalid ? n : -1; else { col = ((n >> 8) << 7) + (n & 127); if ((n >> 7) & 1) sp = src1; }
          float v[16];
#pragma unroll
          for (int i = 0; i < 16; ++i) v[i] = col >= 0 ? sp[(size_t)(k0 + kl0 + 8 * i) * ldsrc + col] : 0.f;
#pragma unroll
          for (int i = 0; i < 16; ++i) tl[(kl0 + 8 * i) * 65 + nl] = v[i]; }
        __syncthreads();
        { const int nl = tid >> 3, ks = tid & 7;
#pragma unroll
          for (int h = 0; h < 2; ++h) { float v[8];
#pragma unroll
            for (int jq = 0; jq < 8; ++jq) v[jq] = tl[(h * 64 + ks * 8 + jq) * 65 + nl];
            u32x4 w; w.x = pk2(v[0], v[1]); w.y = pk2(v[2], v[3]); w.z = pk2(v[4], v[5]); w.w = pk2(v[6], v[7]);
            *(u32x4*)(dst + (size_t)(n0 + nl) * K + k0 + h * 64 + ks * 8) = w; } }
        __syncthreads();
    }
}
__device__ __forceinline__ void prep_in_out(const Params& p, LAS unsigned char* lds, int l, int fb) {
    unsigned char* ws = WSP(p); const int jl = l >> 1;
    if ((l & 1) == 0) { prep_mat(lds, (bf16_t*)(ws + WS_WIN), 2816, 1024, PIN(I_ABIN) + (size_t)jl * 1024 * 2592, nullptr, 2592, 2592, 0, fb);
                        prep_mat(lds, (bf16_t*)(ws + WS_WOUT), 1024, 1024, PIN(I_ABOUT) + (size_t)jl * 1024 * 1024, nullptr, 1024, 1024, 0, fb); }
    else { prep_mat(lds, (bf16_t*)(ws + WS_WIN), 2816, 1024, PIN(I_CDIN) + (size_t)jl * 1024 * 2576, nullptr, 2576, 2576, 0, fb);
           prep_mat(lds, (bf16_t*)(ws + WS_WOUT), 1024, 1024, PIN(I_CDOUT) + (size_t)jl * 1024 * 1024, nullptr, 1024, 1024, 0, fb); }
}
__device__ __forceinline__ void prep_rest(const Params& p, LAS unsigned char* lds, int l) {
    unsigned char* ws = WSP(p); const int jl = l >> 1;
    if (l & 1) prep_mat(lds, (bf16_t*)(ws + WS_WGLU), 512, 512, PIN(I_GLUW) + (size_t)jl * 512 * 512, nullptr, 512, 512, 0);
    prep_mat(lds, (bf16_t*)(ws + WS_WGU), 5632, 1024, PIN(I_FG) + (size_t)l * 1024 * 2816, PIN(I_FU) + (size_t)l * 1024 * 2816, 2816, 0, 1);
    prep_mat(lds, (bf16_t*)(ws + WS_WDN), 1024, 2816, PIN(I_FD) + (size_t)l * 2816 * 1024, nullptr, 1024, 1024, 0);
}
__device__ __forceinline__ void phase0(const Params& p, LAS unsigned char* lds) {
    const int tid = otid(), G = gridDim.x;
    {
        LAS float* sc = (LAS float*)lds;
        LAS float* red = (LAS float*)(lds + 16384);
        for (int i = tid; i < 3072; i += 512) { const int cv = i >> 10, k = i & 1023; const float c = cv == 0 ? PIN(I_CCTX)[k] : PIN(I_C)[(cv - 1) * 1024 + k]; sc[i] = siluf_(c); }
        __syncthreads();
        const int w = tid >> 6, lane = tid & 63;
        for (int item = obid(); item < 384; item += G) {
            const int l = item / 96, col = (item % 96) * 64 + lane;
            const float* wp = PIN(I_WMOD) + (size_t)l * 1024 * 6144 + (size_t)(w * 128) * 6144 + col;
            float a0 = 0.f, a1 = 0.f, a2 = 0.f;
#pragma unroll 8
            for (int k = 0; k < 128; ++k) { const float wv = wp[(size_t)k * 6144]; const int kk = w * 128 + k; a0 += sc[kk] * wv; a1 += sc[1024 + kk] * wv; a2 += sc[2048 + kk] * wv; }
            red[(w * 3 + 0) * 64 + lane] = a0; red[(w * 3 + 1) * 64 + lane] = a1; red[(w * 3 + 2) * 64 + lane] = a2;
            __syncthreads();
            if (tid < 192) { const int cv = tid >> 6, ln = tid & 63, c2 = (item % 96) * 64 + ln; float s = PIN(I_BMOD)[l * 6144 + c2];
#pragma unroll
                for (int ww = 0; ww < 8; ++ww) s += red[(ww * 3 + cv) * 64 + ln];
                ((float*)(WSP(p) + WS_MOD))[(l * 3 + cv) * 6144 + c2] = s; }
            __syncthreads();
        }
    }
    {
        float4* X = (float4*)(WSP(p) + WS_X);
        const float4* xp = (const float4*)PIN(I_XP); const float4* xs = (const float4*)PIN(I_XS);
        for (size_t i = (size_t)obid() * 512 + tid; i < (size_t)NT * 256; i += (size_t)G * 512) {
            const int t = (int)(i >> 8), d4 = (int)(i & 255) * 4;
            float4 v;
            if (t < 4096) v = xp[i];
            else { v = xs[i - (size_t)4096 * 256]; const int tt = (t - 4096) & 4095; const float row = (float)(tt >> 6), colf = (float)(tt & 63);
                float pe[4];
#pragma unroll
                for (int j = 0; j < 4; ++j) { const int d = d4 + j, q = d >> 8, fi = d & 255; const float fr = __expf(-9.210340371976184f * (float)fi / 256.0f);
                    const float arg = (q < 2 ? row : colf) * fr; pe[j] = (q & 1) ? cosf(arg) : sinf(arg); }
                v.x += pe[0]; v.y += pe[1]; v.z += pe[2]; v.w += pe[3]; }
            X[i] = v;
        }
    }
    prep_in_out(p, lds, 0, 0); prep_rest(p, lds, 0);
}

template <bool FINAL>
__device__ __forceinline__ void norm_phase(const float* X, const float* w, const float* shift, const float* scale, bf16_t* hn, float* yout) {
    const int lane = otid() & 63, gw = obid() * 8 + (otid() >> 6), nw = gridDim.x * 8;
    float4 vn[4];
    if (gw < NT) { const float4* xr = (const float4*)(X + (size_t)gw * 1024);
#pragma unroll
        for (int i = 0; i < 4; ++i) vn[i] = xr[i * 64 + lane]; }
    for (int row = gw; row < NT; row += nw) {
        float4 v[4]; float ss = 0.f;
#pragma unroll
        for (int i = 0; i < 4; ++i) v[i] = vn[i];
        if (row + nw < NT) { const float4* xr = (const float4*)(X + (size_t)(row + nw) * 1024);
#pragma unroll
            for (int i = 0; i < 4; ++i) vn[i] = xr[i * 64 + lane]; }
#pragma unroll
        for (int i = 0; i < 4; ++i) ss += v[i].x * v[i].x + v[i].y * v[i].y + v[i].z * v[i].z + v[i].w * v[i].w;
        ss = wave_sum(ss);
        const float rs = rsqrtf(ss * (1.0f / 1024.0f) + EPS);
        const int cv = cv_of_tok(row);
#pragma unroll
        for (int i = 0; i < 4; ++i) { const int c = i * 256 + lane * 4; const float4 wv = *(const float4*)(w + c);
            if (FINAL) { float4 o; o.x = v[i].x * rs * wv.x; o.y = v[i].y * rs * wv.y; o.z = v[i].z * rs * wv.z; o.w = v[i].w * rs * wv.w; *(float4*)(yout + (size_t)row * 1024 + c) = o; }
            else { const float4 sh = *(const float4*)(shift + cv * 6144 + c), sl = *(const float4*)(scale + cv * 6144 + c);
                u32x2 o; o.x = pk2(v[i].x * rs * wv.x * (1.f + sl.x) + sh.x, v[i].y * rs * wv.y * (1.f + sl.y) + sh.y);
                o.y = pk2(v[i].z * rs * wv.z * (1.f + sl.z) + sh.z, v[i].w * rs * wv.w * (1.f + sl.w) + sh.w);
                *(u32x2*)(hn + (size_t)row * 1024 + c) = o; } }
    }
}
__device__ __forceinline__ void zero_osum(const Params& p, int fb) {
    float4* o = (float4*)(WSP(p) + WS_YS); float zz = 0.f; asm volatile("" : "+v"(zz)); const float4 z = {zz, zz, zz, zz};
    for (size_t i = (size_t)(obid() - fb) * 512 + otid(); i < (size_t)NT * 128; i += (size_t)(gridDim.x - fb) * 512) o[i] = z;
}

__device__ __forceinline__ void chain_combine(const Params& p, const float* nw, int gate_col, int mix_col, int fb = 0) {
    const int lane = otid() & 63, gw = (obid() - fb) * 8 + (otid() >> 6), nwv = (gridDim.x - fb) * 8;
    const bf16_t* proj = (const bf16_t*)(WSP(p) + WS_PROJ); const float* oa = (const float*)(WSP(p) + WS_OSUM); const float* ob = (const float*)(WSP(p) + WS_OB); bf16_t* mixed = (bf16_t*)(WSP(p) + WS_HN);
    for (int tg = gw; tg < NT / 4; tg += nwv) {
#pragma unroll
        for (int hd = 0; hd < 4; ++hd) { const int c = hd * 128 + 2 * lane; const size_t o = ((size_t)tg * 512 + c) * 4;
            const f32x4 a0 = *(const f32x4*)(oa + o) + *(const f32x4*)(ob + o), a1 = *(const f32x4*)(oa + o + 4) + *(const f32x4*)(ob + o + 4);
            const float2 nw2 = *(const float2*)(nw + 2 * lane);
#pragma unroll
            for (int k = 0; k < 4; ++k) { const float ss = wave_sum(a0[k] * a0[k] + a1[k] * a1[k]); const float rs = rsqrtf(ss * (1.0f / 128.0f) + EPS); const int t = tg * 4 + k;
                const unsigned g = *(const unsigned*)(proj + (size_t)t * PLD + gate_col + c);
                *(unsigned*)(mixed + (size_t)t * 1024 + mix_col + c) = pk2(a0[k] * rs * nw2.x * siluf_(bflo(g)), a1[k] * rs * nw2.y * siluf_(bfhi(g))); } }
    }
}
__device__ __forceinline__ void ab_combine(const Params& p, int jl) { chain_combine(p, PIN(I_GLANW) + jl * 128, 1024, 0); }

__device__ __forceinline__ void lds_barrier() { asm volatile("s_waitcnt lgkmcnt(0)" ::: "memory"); __builtin_amdgcn_s_barrier(); asm volatile("" ::: "memory"); }
typedef short bf16x8_t __attribute__((ext_vector_type(8)));
__device__ __forceinline__ unsigned cvtpk(float lo, float hi) { return pk2(lo, hi); }

typedef float f32x16 __attribute__((ext_vector_type(16)));
constexpr int IMG_W = 0, IMG_QD = 17408, IMG_QK = 34816, IMG_KE = 44032, IMG_UT = 62464  , IMG_GE = 79872, IMG_STAGE = 79888, IMG_BYTES = 79888;
__device__ __forceinline__ int kact16(int j, int hh) { return j < 4 ? 4 * hh + j : 8 + 4 * hh + (j - 4); }

__device__ __forceinline__ void dn_pre(const Params& p, LAS unsigned char* lds, int jl, int which, int fb) {
    const int tid = otid(), lane = tid & 63, wave = __builtin_amdgcn_readfirstlane(tid >> 6);
    const bf16_t* proj = (const bf16_t*)(WSP(p) + WS_PROJ);
    LAS unsigned char* Qs = lds; LAS unsigned char* Ks = lds + 17408; LAS unsigned char* Vs = lds + 34816;
    LAS float* KKs = (LAS float*)(lds + 52224); LAS float* QKs = (LAS float*)(lds + 68864);
    LAS float* As = (LAS float*)(lds + 85504);
    LAS float* las = (LAS float*)(lds + 118272); LAS float* bes = las + 128; LAS float* gs = las + 256;
    LAS float* scl = las + 384;
    for (int it = obid() - fb; it < (which ? 256 : 512); it += gridDim.x - fb) {
        const int c = (which ? 0 : 64) + (it >> 2), head = it & 3, t0 = c * 64; int lo, hi; seq_bounds(t0, lo, hi);
        { const int i = tid >> 3, part = tid & 7;
          u32x4 xin[3][4][2];
#pragma unroll
          for (int ten = 0; ten < 3; ++ten)
#pragma unroll
            for (int tap = 0; tap < 4; ++tap) { const int tt = t0 + i + tap - 1; const bool ok = tt >= lo && tt < hi; const bf16_t* px = proj + (size_t)(ok ? tt : t0) * PLD + 512 + ten * 512 + head * 128 + part * 16;
                const u32x4 z4 = {0u, 0u, 0u, 0u}; xin[ten][tap][0] = ok ? *(const u32x4*)px : z4; xin[ten][tap][1] = ok ? *(const u32x4*)(px + 8) : z4; }
#pragma unroll
          for (int ten = 0; ten < 3; ++ten) { const int cb = ten * 512 + head * 128 + part * 16; float acc[16];
#pragma unroll
            for (int e = 0; e < 16; ++e) acc[e] = 0.f;
#pragma unroll
            for (int tap = 0; tap < 4; ++tap) { const u32x4 x0 = xin[ten][tap][0], x1 = xin[ten][tap][1];
                    const float* wp = PIN(I_DNCW) + (size_t)(jl * 4 + tap) * 1536 + cb; const f32x4 w0 = *(const f32x4*)wp, w1 = *(const f32x4*)(wp + 4), w2 = *(const f32x4*)(wp + 8), w3 = *(const f32x4*)(wp + 12);
                    acc[0] += w0[0] * bflo(x0.x); acc[1] += w0[1] * bfhi(x0.x); acc[2] += w0[2] * bflo(x0.y); acc[3] += w0[3] * bfhi(x0.y);
                    acc[4] += w1[0] * bflo(x0.z); acc[5] += w1[1] * bfhi(x0.z); acc[6] += w1[2] * bflo(x0.w); acc[7] += w1[3] * bfhi(x0.w);
                    acc[8] += w2[0] * bflo(x1.x); acc[9] += w2[1] * bfhi(x1.x); acc[10] += w2[2] * bflo(x1.y); acc[11] += w2[3] * bfhi(x1.y);
                    acc[12] += w3[0] * bflo(x1.z); acc[13] += w3[1] * bfhi(x1.z); acc[14] += w3[2] * bflo(x1.w); acc[15] += w3[3] * bfhi(x1.w); }
            float ss = 0.f;
#pragma unroll
            for (int e = 0; e < 16; ++e) { acc[e] = siluf_(acc[e]); ss += acc[e] * acc[e]; }
            if (ten < 2) { ss += __shfl_xor(ss, 1); ss += __shfl_xor(ss, 2); ss += __shfl_xor(ss, 4); float rs = rsqrtf(ss + 1e-6f); if (ten == 0) rs *= 0.08838834764831845f;
#pragma unroll
                for (int e = 0; e < 16; ++e) acc[e] *= rs; }
            u32x4 o0, o1; o0.x = pk2(acc[0], acc[1]); o0.y = pk2(acc[2], acc[3]); o0.z = pk2(acc[4], acc[5]); o0.w = pk2(acc[6], acc[7]);
            o1.x = pk2(acc[8], acc[9]); o1.y = pk2(acc[10], acc[11]); o1.z = pk2(acc[12], acc[13]); o1.w = pk2(acc[14], acc[15]);
            LAS unsigned char* dst = lds + ten * 17408 + i * 272 + part * 32;
            *(LAS u32x4*)dst = o0; *(LAS u32x4*)(dst + 16) = o1; }
          if (tid < 128) { const int dir = tid >> 6, ii = tid & 63; const bf16_t* pr = proj + (size_t)(t0 + ii) * PLD;
            const float ai = bf2f(pr[2560 + dir * 4 + head]), bi = bf2f(pr[2568 + dir * 4 + head]);
            las[dir * 64 + ii] = -__expf(PIN(I_ALOG)[(jl * 2 + dir) * 4 + head]) * softplusf_(ai + PIN(I_DTB)[(jl * 2 + dir) * 4 + head]);
            bes[dir * 64 + ii] = sigmoidf_(bi); } }
        __syncthreads();
        if (wave < 2) { const int dir = wave; float x = las[dir * 64 + (dir ? 63 - lane : lane)];
#pragma unroll
            for (int off = 1; off < 64; off <<= 1) { const float y = __shfl_up(x, off); if (lane >= off) x += y; }
            gs[dir * 64 + lane] = x; }
        { const int which = wave >> 2, mb = (wave >> 1) & 1, nb = wave & 1, r = lane & 31, hh = lane >> 5;
          const LAS unsigned char* Ab = (which ? Qs : Ks) + (32 * mb + r) * 272 + hh * 16; const LAS unsigned char* Bb = Ks + (32 * nb + r) * 272 + hh * 16;
          f32x16 acc;
#pragma unroll
          for (int e = 0; e < 16; ++e) acc[e] = 0.f;
#pragma unroll
          for (int ks = 0; ks < 8; ++ks) { const bf16x8_t a = *(const LAS bf16x8_t*)(Ab + ks * 32), b = *(const LAS bf16x8_t*)(Bb + ks * 32); acc = __builtin_amdgcn_mfma_f32_32x32x16_bf16(a, b, acc, 0, 0, 0); }
          LAS float* dst = which ? QKs : KKs;
#pragma unroll
          for (int e = 0; e < 16; ++e) dst[(32 * mb + (e & 3) + 8 * (e >> 2) + 4 * hh) * 65 + 32 * nb + r] = acc[e]; }
        __syncthreads();
        for (int e = tid; e < 8192; e += 512) { const int dir = e >> 12, i = (e >> 6) & 63, j = e & 63; const int pi = dir ? 63 - i : i, pj = dir ? 63 - j : j;
            As[e] = j < i ? bes[dir * 64 + pi] * KKs[pi * 65 + pj] * __expf(gs[dir * 64 + i] - gs[dir * 64 + j]) : 0.f; }
        for (int u = tid; u < 2048; u += 512) {
            const int hh = u & 1, ks = (u >> 1) & 7, i = (u >> 4) & 63, dir = u >> 10, pi = dir ? 63 - i : i; const float eg = __expf(gs[dir * 64 + i]);
            const u32x2 q0 = *(const LAS u32x2*)(Qs + pi * 272 + (16 * ks + 4 * hh) * 2), q1 = *(const LAS u32x2*)(Qs + pi * 272 + (16 * ks + 8 + 4 * hh) * 2);
            u32x4 o; o.x = pk2(bflo(q0.x) * eg, bfhi(q0.x) * eg); o.y = pk2(bflo(q0.y) * eg, bfhi(q0.y) * eg); o.z = pk2(bflo(q1.x) * eg, bfhi(q1.x) * eg); o.w = pk2(bflo(q1.y) * eg, bfhi(q1.y) * eg);
            *(u32x4*)(WSP(p) + WS_IMG + (size_t)((c * 4 + head) * 2 + dir) * IMG_BYTES + IMG_QD + i * 272 + (16 * ks + 8 * hh) * 2) = o; }
        for (int u = tid; u < 1024; u += 512) {
            const int hh = u & 1, ks = (u >> 1) & 3, i = (u >> 3) & 63, dir = u >> 9, pi = dir ? 63 - i : i; const float gi = gs[dir * 64 + i]; float v[8];
#pragma unroll
            for (int j = 0; j < 8; ++j) { const int ja = 16 * ks + kact16(j, hh), pj = dir ? 63 - ja : ja; v[j] = ja <= i ? QKs[pi * 65 + pj] * __expf(gi - gs[dir * 64 + ja]) : 0.f; }
            u32x4 o; o.x = pk2(v[0], v[1]); o.y = pk2(v[2], v[3]); o.z = pk2(v[4], v[5]); o.w = pk2(v[6], v[7]);
            *(u32x4*)(WSP(p) + WS_IMG + (size_t)((c * 4 + head) * 2 + dir) * IMG_BYTES + IMG_QK + i * 144 + (16 * ks + 8 * hh) * 2) = o; }
        for (int u = tid; u < 2048; u += 512) {
            const int k = u & 127, hh = (u >> 7) & 1, ks = (u >> 8) & 3, dir = u >> 10; const float ge = gs[dir * 64 + 63]; float v[8];
#pragma unroll
            for (int j = 0; j < 8; ++j) { const int ja = 16 * ks + kact16(j, hh), pj = dir ? 63 - ja : ja; v[j] = bf2f(*(const LAS bf16_t*)(Ks + pj * 272 + k * 2)) * __expf(ge - gs[dir * 64 + ja]); }
            u32x4 o; o.x = pk2(v[0], v[1]); o.y = pk2(v[2], v[3]); o.z = pk2(v[4], v[5]); o.w = pk2(v[6], v[7]);
            *(u32x4*)(WSP(p) + WS_IMG + (size_t)((c * 4 + head) * 2 + dir) * IMG_BYTES + IMG_KE + k * 144 + (16 * ks + 8 * hh) * 2) = o; }
        if (tid < 2) *(float*)(WSP(p) + WS_IMG + (size_t)((c * 4 + head) * 2 + tid) * IMG_BYTES + IMG_GE) = __expf(gs[tid * 64 + 63]);
        if (tid < 256) { const int i = tid & 63, w = (tid >> 6) & 1, dir = tid >> 7; const float b = bes[dir * 64 + (dir ? 63 - i : i)]; scl[tid] = w ? b * __expf(gs[dir * 64 + i]) : b; }
        __syncthreads();
        { int dir = wave >> 2; asm volatile("" : "+s"(dir)); const int part = wave & 3, isW = part >> 1, cc = (part & 1) * 64 + lane;
          const LAS float* Ad = As + dir * 4096; const LAS float* sp = scl + (dir * 2 + isW) * 64;
          const LAS unsigned char* srcp = (isW ? Ks : Vs) + cc * 2 + (dir ? 63 * 272 : 0); const int sstep = dir ? -272 : 272;
          float x[64];
#pragma unroll
          for (int i = 0; i < 64; ++i) { asm volatile("" : "+v"(srcp) :: "memory");
              float a0 = sp[i] * bf2f(*(const LAS bf16_t*)srcp), a1 = 0.f; srcp += sstep;
#pragma unroll
              for (int j4 = 0; j4 < i; j4 += 4) { const f32x4 av = *(const LAS f32x4*)(Ad + i * 64 + j4);
                  a0 -= av[0] * x[j4]; if (j4 + 1 < i) a1 -= av[1] * x[j4 + 1]; if (j4 + 2 < i) a0 -= av[2] * x[j4 + 2]; if (j4 + 3 < i) a1 -= av[3] * x[j4 + 3]; }
              x[i] = a0 + a1; }
          unsigned char* img = WSP(p) + WS_IMG + (size_t)((c * 4 + head) * 2 + dir) * IMG_BYTES;
          if (!isW) { unsigned char* ut = img + IMG_UT + cc * 136;
#pragma unroll
              for (int i = 0; i < 64; i += 4) { u32x2 o; o.x = pk2(x[i], x[i + 1]); o.y = pk2(x[i + 2], x[i + 3]); *(u32x2*)(ut + i * 2) = o; } }
          else { const int o16 = cc & 15, hh = (o16 >> 2) & 1, j = (o16 & 3) + ((o16 >> 3) << 2), pp = (cc & ~15) + 8 * hh + j; bf16_t* wp = (bf16_t*)(img + IMG_W) + pp;
#pragma unroll
              for (int i = 0; i < 64; ++i) wp[i * 136] = (bf16_t)f2bf(-x[i]); } }
        __syncthreads();
    }
}

template <int NCH, int STAGE, int BYTES, int D>
__device__ __forceinline__ void chain_loader(LAS unsigned char* lds, const unsigned char* imgbase, int c0, int cstep, int head, int dir, int lt) {
    constexpr int NCH16 = STAGE / 16, NL = (NCH16 + 255) / 256;
    asm volatile("" : "+s"(c0), "+s"(head));
    u32x4 ring[D][NL];
#pragma unroll
    for (int d = 1; d <= D; ++d) if (d < NCH) { const unsigned char* img = imgbase + (size_t)(((c0 + cstep * d) * 4 + head) * 2 + dir) * BYTES;
        const __attribute__((address_space(1))) unsigned char* gp = (const __attribute__((address_space(1))) unsigned char*)(img + lt * 16);
#pragma unroll
        for (int q = 0; q < NL; ++q) { asm volatile("" : "+v"(gp)); if ((q + 1) * 256 <= NCH16 || lt + q * 256 < NCH16) ring[d % D][q] = *(const __attribute__((address_space(1))) u32x4*)gp; gp += 4096; } }
    __syncthreads();
#pragma unroll
    for (int s = 0; s < NCH; ++s) {
        if (s + 1 < NCH) { LAS unsigned char* nb = lds + ((s + 1) & 1) * STAGE;
#pragma unroll
            for (int q = 0; q < NL; ++q) if ((q + 1) * 256 <= NCH16 || lt + q * 256 < NCH16) *(LAS u32x4*)(nb + (lt + q * 256) * 16) = ring[(s + 1) % D][q]; }
        if (s + 1 + D < NCH) { const unsigned char* img = imgbase + (size_t)(((c0 + cstep * (s + 1 + D)) * 4 + head) * 2 + dir) * BYTES;
            const __attribute__((address_space(1))) unsigned char* gp = (const __attribute__((address_space(1))) unsigned char*)(img + lt * 16);
#pragma unroll
            for (int q = 0; q < NL; ++q) { asm volatile("" : "+v"(gp)); if ((q + 1) * 256 <= NCH16 || lt + q * 256 < NCH16) ring[(s + 1) % D][q] = *(const __attribute__((address_space(1))) u32x4*)gp; gp += 4096; } }
        lds_barrier(); }
}
#define SBF(ks) __builtin_bit_cast(bf16x8_t, (u32x4){cvtpk(S[(ks) >> 1][((ks) & 1) * 8 + 0], S[(ks) >> 1][((ks) & 1) * 8 + 1]), cvtpk(S[(ks) >> 1][((ks) & 1) * 8 + 2], S[(ks) >> 1][((ks) & 1) * 8 + 3]), cvtpk(S[(ks) >> 1][((ks) & 1) * 8 + 4], S[(ks) >> 1][((ks) & 1) * 8 + 5]), cvtpk(S[(ks) >> 1][((ks) & 1) * 8 + 6], S[(ks) >> 1][((ks) & 1) * 8 + 7])})
__device__ __forceinline__ void dn_chain(const Params& p, LAS unsigned char* lds, int jl, int cfirst, int nch, int dir, int head, const float* s_init, float* s_out) {
    const int tid = otid(), lane = tid & 63, wave = __builtin_amdgcn_readfirstlane(tid >> 6), r = lane & 31, hh = lane >> 5;
    const unsigned char* imgbase = WSP(p) + WS_IMG; float* obuf = (float*)(WSP(p) + (dir ? WS_OB : WS_OSUM));
    const int cstep = dir ? -1 : 1, c0 = dir ? cfirst + nch - 1 : cfirst;
    { const unsigned char* img = imgbase + (size_t)((c0 * 4 + head) * 2 + dir) * IMG_BYTES;
      for (int q = tid; q < IMG_STAGE / 16; q += 512) *(LAS u32x4*)(lds + q * 16) = *(const u32x4*)(img + q * 16); }
    if (wave >= 4) {
        if (nch == 64) chain_loader<64, IMG_STAGE, IMG_BYTES, 2>(lds, imgbase, c0, cstep, head, dir, tid - 256); else chain_loader<4, IMG_STAGE, IMG_BYTES, 2>(lds, imgbase, c0, cstep, head, dir, tid - 256);
    } else {
        f32x16 S[4];
        const int col = wave * 32 + r;
        { const float* sp = s_init ? s_init + (4 * hh) * 128 + col : nullptr;
#pragma unroll
          for (int mb = 0; mb < 4; ++mb)
#pragma unroll
            for (int m = 0; m < 4; ++m) { asm volatile("" : "+v"(sp));
#pragma unroll
                for (int rr = 0; rr < 4; ++rr) S[mb][4 * m + rr] = sp ? sp[rr * 128] : 0.f;
                if (sp) sp += 8 * 128; } }
        __syncthreads();
        for (int s = 0; s < nch; ++s) {
            { const int cidx = c0 + cstep * s;
                LAS unsigned char* buf = lds + (s & 1) * IMG_STAGE;
                bf16x8_t sb[8];
#pragma unroll
                for (int ks = 0; ks < 8; ++ks) sb[ks] = SBF(ks);
                f32x16 Wn[2];
#pragma unroll
                for (int mb = 0; mb < 2; ++mb)
#pragma unroll
                    for (int m = 0; m < 4; ++m) { const u32x2 uv = *(const LAS u32x2*)(buf + IMG_UT + col * 136 + (32 * mb + 8 * m + 4 * hh) * 2);
                        Wn[mb][4 * m + 0] = bflo(uv.x); Wn[mb][4 * m + 1] = bfhi(uv.x); Wn[mb][4 * m + 2] = bflo(uv.y); Wn[mb][4 * m + 3] = bfhi(uv.y); }
                const float ge = *(const LAS float*)(buf + IMG_GE);
                asm volatile("" ::: "memory");
#pragma unroll
                for (int mb = 0; mb < 2; ++mb) { bf16x8_t af[8];
#pragma unroll
                    for (int ks = 0; ks < 8; ++ks) af[ks] = *(const LAS bf16x8_t*)(buf + IMG_W + (32 * mb + r) * 272 + (16 * ks + 8 * hh) * 2);
#pragma unroll
                    for (int ks = 0; ks < 8; ++ks) Wn[mb] = __builtin_amdgcn_mfma_f32_32x32x16_bf16(af[ks], sb[ks], Wn[mb], 0, 0, 0);
                    asm volatile("" ::: "memory"); }
                bf16x8_t wb[4];
#pragma unroll
                for (int ks = 0; ks < 4; ++ks) { u32x4 w; const int mb = ks >> 1, h8 = (ks & 1) * 8;
                    w.x = cvtpk(Wn[mb][h8 + 0], Wn[mb][h8 + 1]); w.y = cvtpk(Wn[mb][h8 + 2], Wn[mb][h8 + 3]); w.z = cvtpk(Wn[mb][h8 + 4], Wn[mb][h8 + 5]); w.w = cvtpk(Wn[mb][h8 + 6], Wn[mb][h8 + 7]); wb[ks] = __builtin_bit_cast(bf16x8_t, w); }
#pragma unroll
                for (int mb = 0; mb < 2; ++mb) { f32x16 O; asm volatile("" ::: "memory");
                    bf16x8_t af[8], ag[4];
#pragma unroll
                    for (int ks = 0; ks < 8; ++ks) af[ks] = *(const LAS bf16x8_t*)(buf + IMG_QD + (32 * mb + r) * 272 + (16 * ks + 8 * hh) * 2);
#pragma unroll
                    for (int ks = 0; ks < 4; ++ks) ag[ks] = *(const LAS bf16x8_t*)(buf + IMG_QK + (32 * mb + r) * 144 + (16 * ks + 8 * hh) * 2);
#pragma unroll
                    for (int e = 0; e < 16; ++e) O[e] = 0.f;
#pragma unroll
                    for (int ks = 0; ks < 8; ++ks) O = __builtin_amdgcn_mfma_f32_32x32x16_bf16(af[ks], sb[ks], O, 0, 0, 0);
#pragma unroll
                    for (int ks = 0; ks < 4; ++ks) O = __builtin_amdgcn_mfma_f32_32x32x16_bf16(ag[ks], wb[ks], O, 0, 0, 0);
#pragma unroll
                for (int m = 0; m < 4; ++m) { const int g4 = 8 * mb + 2 * m + hh, tg = cidx * 16 + (dir ? 15 - g4 : g4);
                    f32x4 ov; if (dir) { ov[0] = O[4 * m + 3]; ov[1] = O[4 * m + 2]; ov[2] = O[4 * m + 1]; ov[3] = O[4 * m + 0]; } else { ov[0] = O[4 * m + 0]; ov[1] = O[4 * m + 1]; ov[2] = O[4 * m + 2]; ov[3] = O[4 * m + 3]; }
                    *(f32x4*)(obuf + ((size_t)tg * 512 + head * 128 + col) * 4) = ov; } }
#pragma unroll
                for (int mp = 0; mp < 2; ++mp) { asm volatile("" ::: "memory"); bf16x8_t af[8];
#pragma unroll
                    for (int q = 0; q < 8; ++q) af[q] = *(const LAS bf16x8_t*)(buf + IMG_KE + (32 * (2 * mp + (q >> 2)) + r) * 144 + (16 * (q & 3) + 8 * hh) * 2);
#pragma unroll
                    for (int q = 0; q < 2; ++q) { const int mb = 2 * mp + q;
#pragma unroll
                        for (int e = 0; e < 16; ++e) S[mb][e] *= ge;
#pragma unroll
                        for (int ks = 0; ks < 4; ++ks) S[mb] = __builtin_amdgcn_mfma_f32_32x32x16_bf16(af[4 * q + ks], wb[ks], S[mb], 0, 0, 0); } }
                lds_barrier(); } }
        if (s_out) {
            float* sp = s_out + (4 * hh) * 128 + col;
#pragma unroll
            for (int mb = 0; mb < 4; ++mb)
#pragma unroll
                for (int m = 0; m < 4; ++m) { asm volatile("" : "+v"(sp));
#pragma unroll
                    for (int rr = 0; rr < 4; ++rr) sp[rr * 128] = S[mb][4 * m + rr];
                    sp += 8 * 128; }
        }
    }
}

template <bool PASSB>
__device__ __forceinline__ void s5_task(const Params& p, LAS unsigned char* lds, int jl, int seg, int dir, int g) {
    const int lane = otid() & 63, wave = __builtin_amdgcn_readfirstlane(otid() >> 6), r = lane & 31, hh = lane >> 5;
    const bf16_t* proj = (const bf16_t*)(WSP(p) + WS_PROJ); float* osum = (float*)(WSP(p) + WS_YS);
    LAS unsigned char* Us = lds + wave * 19456;
    LAS unsigned char* Ht = Us + 2048;
    LAS unsigned char* Cms = Us + 2048 + 9216;
    const float dtv = __expf(PIN(I_LOGDT)[(jl * 2 + dir) * 32 + g]);
    float a1r[2], a1i[2], a4r[2], a4i[2], hcr[2], hci[2];
    bf16x8_t bbr[2], bbi[2];
#pragma unroll
    for (int sh = 0; sh < 2; ++sh) { const int st = 32 * sh + r, pi = ((jl * 2 + dir) * 32 + g) * 64 + st;
        const float lre = PIN(I_LAMRE)[pi], lim = PIN(I_LAMIM)[pi]; const float xr = lre * dtv, xi = lim * dtv; float sn, cs; sincosf(xi, &sn, &cs);
        const float ea = __expf(xr), ar = ea * cs, ai = ea * sn;
        const float sh2 = sinf(0.5f * xi); const float nr = expm1f(xr) * cs - 2.0f * sh2 * sh2, ni = ai;
        const float den = 1.0f / (lre * lre + lim * lim); const float cr = (nr * lre + ni * lim) * den, ci = (ni * lre - nr * lim) * den;
        a1r[sh] = ar; a1i[sh] = ai; { const float b2r = ar * ar - ai * ai, b2i = 2.f * ar * ai; a4r[sh] = b2r * b2r - b2i * b2i; a4i[sh] = 2.f * b2r * b2i; }
        { const float* bre = PIN(I_BRE) + (size_t)pi * 16 + 8 * hh; const float* bim = PIN(I_BIM) + (size_t)pi * 16 + 8 * hh; float vr[8], vi[8];
#pragma unroll
          for (int j = 0; j < 8; ++j) { vr[j] = cr * bre[j] - ci * bim[j]; vi[j] = cr * bim[j] + ci * bre[j]; }
          u32x4 w; w.x = pk2(vr[0], vr[1]); w.y = pk2(vr[2], vr[3]); w.z = pk2(vr[4], vr[5]); w.w = pk2(vr[6], vr[7]); bbr[sh] = __builtin_bit_cast(bf16x8_t, w);
          w.x = pk2(vi[0], vi[1]); w.y = pk2(vi[2], vi[3]); w.z = pk2(vi[4], vi[5]); w.w = pk2(vi[6], vi[7]); bbi[sh] = __builtin_bit_cast(bf16x8_t, w); }
        hcr[sh] = 0.f; hci[sh] = 0.f;
        if (PASSB && seg >= 16) { const int sseg = seg - 16, b = sseg >> 4, j = sseg & 15;
            const float er = __expf(256.0f * xr); double ph = 256.0 * ((double)lim * (double)dtv); ph -= 6.283185307179586 * rint(ph * 0.15915494309189535);
            float s2, c2; sincosf((float)ph, &s2, &c2); const float a2r_ = er * c2, a2i_ = er * s2;
            const float2 s0 = *(const float2*)(PIN(I_SS5) + ((size_t)(((b * 2 + jl) * 2 + dir) * 32 + g) * 64 + st) * 2); float hr = s0.x, hi = s0.y;
            const int nst = dir ? 15 - j : j; float2 ev[15];
#pragma unroll
            for (int q = 0; q < 15; ++q) { const int sj = b * 16 + (dir ? 15 - q : q); ev[q] = q < nst ? ((const float2*)(WSP(p) + WS_C2E))[((sj * 2 + dir) * 32 + g) * 64 + st] : make_float2(0.f, 0.f); }
#pragma unroll
            for (int q = 0; q < 15; ++q) if (q < nst) { const float nhr = a2r_ * hr - a2i_ * hi + ev[q].x, nhi = a2r_ * hi + a2i_ * hr + ev[q].y; hr = nhr; hi = nhi; }
            hcr[sh] = hr; hci[sh] = hi; } }
    if (PASSB) {
        asm volatile("s_waitcnt lgkmcnt(0)" ::: "memory"); __builtin_amdgcn_wave_barrier();
#pragma unroll
        for (int sh = 0; sh < 2; ++sh)
#pragma unroll
            for (int ks = 0; ks < 4; ++ks) { float v[8];
                const float* src = PIN((ks >> 1) ? I_CIM : I_CRE) + ((size_t)((jl * 2 + dir) * 32 + g) * 16 + (r & 15)) * 64 + 32 * sh + ((16 * ks + 8 * hh) & 31); const float sg = (ks >> 1) ? -1.f : 1.f;
                const f32x4 s0 = *(const f32x4*)src, s1 = *(const f32x4*)(src + 4);
                v[0] = s0[0]; v[1] = s0[1]; v[2] = s0[2]; v[3] = s0[3]; v[4] = s1[0]; v[5] = s1[1]; v[6] = s1[2]; v[7] = s1[3];
#pragma unroll
                for (int j = 0; j < 8; ++j) v[j] = r < 16 ? sg * v[j] : 0.f;
                u32x4 w; w.x = pk2(v[0], v[1]); w.y = pk2(v[2], v[3]); w.z = pk2(v[4], v[5]); w.w = pk2(v[6], v[7]);
                *(LAS u32x4*)(Cms + ((sh * 4 + ks) * 64 + lane) * 16) = w; }
    }
    const int base = seg * SEG;
    u32x4 nu0, nu1; { const int t = dir ? base + SEG - 1 - lane : base + lane; const bf16_t* pu = proj + (size_t)t * PLD + g * 16; nu0 = *(const u32x4*)pu; nu1 = *(const u32x4*)(pu + 8); }
#pragma unroll 1
    for (int c = 0; c < 4; ++c) {
        asm volatile("s_waitcnt lgkmcnt(0)" ::: "memory"); __builtin_amdgcn_wave_barrier();
        *(LAS u32x4*)(Us + lane * 32) = nu0; *(LAS u32x4*)(Us + lane * 32 + 16) = nu1;
        if (c + 1 < 4) { const int i = 64 * (c + 1) + lane, t = dir ? base + SEG - 1 - i : base + i; const bf16_t* pu = proj + (size_t)t * PLD + g * 16; nu0 = *(const u32x4*)pu; nu1 = *(const u32x4*)(pu + 8); }
        asm volatile("s_waitcnt lgkmcnt(0)" ::: "memory"); __builtin_amdgcn_wave_barrier();
        const bf16x8_t ua0 = *(const LAS bf16x8_t*)(Us + r * 32 + hh * 16), ua1 = *(const LAS bf16x8_t*)(Us + (32 + r) * 32 + hh * 16);
        f32x16 Y[2];
        if (PASSB) {
#pragma unroll
            for (int e = 0; e < 16; ++e) { Y[0][e] = 0.f; Y[1][e] = 0.f; } }
#pragma unroll
        for (int sh = 0; sh < 2; ++sh) {
            f32x16 Xr[2], Xi[2];
#pragma unroll
            for (int e = 0; e < 16; ++e) { Xr[0][e] = 0.f; Xr[1][e] = 0.f; Xi[0][e] = 0.f; Xi[1][e] = 0.f; }
            Xr[0] = __builtin_amdgcn_mfma_f32_32x32x16_bf16(ua0, bbr[sh], Xr[0], 0, 0, 0); Xr[1] = __builtin_amdgcn_mfma_f32_32x32x16_bf16(ua1, bbr[sh], Xr[1], 0, 0, 0);
            Xi[0] = __builtin_amdgcn_mfma_f32_32x32x16_bf16(ua0, bbi[sh], Xi[0], 0, 0, 0); Xi[1] = __builtin_amdgcn_mfma_f32_32x32x16_bf16(ua1, bbi[sh], Xi[1], 0, 0, 0);
            const float ar = a1r[sh], ai = a1i[sh];
            float eor[8], eoi[8];
#pragma unroll
            for (int q = 0; q < 8; ++q) { const int mb = q >> 2, e0 = 4 * (q & 3);
#pragma unroll
                for (int k = 1; k < 4; ++k) { const float pr_ = Xr[mb][e0 + k - 1], pi_ = Xi[mb][e0 + k - 1]; Xr[mb][e0 + k] += ar * pr_ - ai * pi_; Xi[mb][e0 + k] += ar * pi_ + ai * pr_; }
                eor[q] = Xr[mb][e0 + 3]; eoi[q] = Xi[mb][e0 + 3]; }
            float cwr[8], cwi[8]; float cr_ = hcr[sh], ci_ = hci[sh]; const float qr = a4r[sh], qi = a4i[sh];
#pragma unroll
            for (int q = 0; q < 8; ++q) { const float epr = __shfl_xor(eor[q], 32), epi = __shfl_xor(eoi[q], 32);
                const float ear = hh ? epr : eor[q], eai = hh ? epi : eoi[q], ebr = hh ? eor[q] : epr, ebi = hh ? eoi[q] : epi;
                const float odr = qr * cr_ - qi * ci_ + ear, odi = qr * ci_ + qi * cr_ + eai;
                cwr[q] = hh ? odr : cr_; cwi[q] = hh ? odi : ci_;
                const float nr_ = qr * odr - qi * odi + ebr, ni_ = qr * odi + qi * odr + ebi; cr_ = nr_; ci_ = ni_; }
            hcr[sh] = cr_; hci[sh] = ci_;
            if (PASSB) {
                const float a2r_s = ar * ar - ai * ai, a2i_s = 2.f * ar * ai, a3r_s = a2r_s * ar - a2i_s * ai, a3i_s = a2r_s * ai + a2i_s * ar;
#pragma unroll
                for (int q = 0; q < 8; ++q) { const int mb = q >> 2, m = q & 3, e0 = 4 * m; const float wr = cwr[q], wi = cwi[q];
                    const float h0r = Xr[mb][e0 + 0] + (a1r[sh] * wr - a1i[sh] * wi), h0i = Xi[mb][e0 + 0] + (a1r[sh] * wi + a1i[sh] * wr);
                    const float h1r = Xr[mb][e0 + 1] + (a2r_s * wr - a2i_s * wi), h1i = Xi[mb][e0 + 1] + (a2r_s * wi + a2i_s * wr);
                    const float h2r = Xr[mb][e0 + 2] + (a3r_s * wr - a3i_s * wi), h2i = Xi[mb][e0 + 2] + (a3r_s * wi + a3i_s * wr);
                    const float h3r = Xr[mb][e0 + 3] + (a4r[sh] * wr - a4i[sh] * wi), h3i = Xi[mb][e0 + 3] + (a4r[sh] * wi + a4i[sh] * wr);
                    LAS unsigned char* hp = Ht + (32 * mb + 8 * m + 4 * hh) * 144 + r * 2;
                    *(LAS bf16_t*)(hp) = (bf16_t)f2bf(h0r); *(LAS bf16_t*)(hp + 64) = (bf16_t)f2bf(h0i);
                    *(LAS bf16_t*)(hp + 144) = (bf16_t)f2bf(h1r); *(LAS bf16_t*)(hp + 144 + 64) = (bf16_t)f2bf(h1i);
                    *(LAS bf16_t*)(hp + 288) = (bf16_t)f2bf(h2r); *(LAS bf16_t*)(hp + 288 + 64) = (bf16_t)f2bf(h2i);
                    *(LAS bf16_t*)(hp + 432) = (bf16_t)f2bf(h3r); *(LAS bf16_t*)(hp + 432 + 64) = (bf16_t)f2bf(h3i); }
                asm volatile("s_waitcnt lgkmcnt(0)" ::: "memory"); __builtin_amdgcn_wave_barrier();
#pragma unroll
                for (int ks = 0; ks < 4; ++ks) { const bf16x8_t cmk = *(const LAS bf16x8_t*)(Cms + ((sh * 4 + ks) * 64 + lane) * 16);
#pragma unroll
                    for (int nb = 0; nb < 2; ++nb) { const bf16x8_t b = *(const LAS bf16x8_t*)(Ht + (32 * nb + r) * 144 + (16 * ks + 8 * hh) * 2); Y[nb] = __builtin_amdgcn_mfma_f32_32x32x16_bf16(cmk, b, Y[nb], 0, 0, 0); } }
                asm volatile("s_waitcnt lgkmcnt(0)" ::: "memory"); __builtin_amdgcn_wave_barrier();
            }
        }
        if (PASSB) {
            LAS float* Ys = (LAS float*)Ht;
#pragma unroll
            for (int nb = 0; nb < 2; ++nb)
#pragma unroll
                for (int e = 0; e < 8; ++e) Ys[(32 * nb + r) * 17 + (e & 3) + 8 * (e >> 2) + 4 * hh] = Y[nb][e];
            asm volatile("s_waitcnt lgkmcnt(0)" ::: "memory"); __builtin_amdgcn_wave_barrier();
            const int jj = lane & 15, ts = lane >> 4;
#pragma unroll
            for (int q = 0; q < 16; ++q) { const int i = 64 * c + 4 * q + ts, t = dir ? base + SEG - 1 - i : base + i;
                gatomic_add(osum + (size_t)t * 512 + g * 16 + jj, Ys[(4 * q + ts) * 17 + jj]); }
        }
    }
    if (hh == 0) {
#pragma unroll
        for (int sh = 0; sh < 2; ++sh) { const int st = 32 * sh + r; float2 e; e.x = hcr[sh]; e.y = hci[sh];
            if (!PASSB) ((float2*)(WSP(p) + WS_C2E))[(((seg - 16) * 2 + dir) * 32 + g) * 64 + st] = e;
            else if (seg < 16) ((float2*)(POUT() + OUT_S5))[(((seg * 2 + jl) * 2 + dir) * 32 + g) * 64 + st] = e; } }
}

constexpr int G_QD = 0, G_ATT = 9216, G_KE = 18432, G_DEC = 27648, G_VT = 27904, G_STAGE = 49152, G_BYTES = 49152;
__device__ __forceinline__ int pinv16(int x) { const int o = x & 15; return (x & ~15) + 8 * ((o >> 2) & 1) + (o & 3) + ((o >> 3) << 2); }

__device__ __forceinline__ void gla_pre(const Params& p, LAS unsigned char* lds, int jl, int which, int fb) {
    const int tid = otid(), lane = tid & 63, wave = __builtin_amdgcn_readfirstlane(tid >> 6);
    const bf16_t* proj = (const bf16_t*)(WSP(p) + WS_PROJ);
    LAS unsigned char* Qs = lds; LAS unsigned char* Ks = lds + 9216; LAS unsigned char* Vs = lds + 18432;
    LAS float* bs = (LAS float*)(lds + 35840);
    LAS unsigned char* QDs = lds + 69120;
    LAS unsigned char* KIs = lds + 87552;
    LAS float* wgs = (LAS float*)(lds + 105984);
    const int head = obid() & 3;
    for (int e = tid; e < 2048; e += 512) { const int dir = e >> 10, r = (e >> 6) & 15, k = e & 63; wgs[e] = PIN(I_WG2)[((size_t)(jl * 2 + dir) * 16 + r) * 256 + head * 64 + k]; }
    if (tid < 128) wgs[2048 + tid] = PIN(I_BG)[(jl * 2 + (tid >> 6)) * 256 + head * 64 + (tid & 63)];
    __syncthreads();
    for (int it = obid() - fb; it < (which ? 256 : 512); it += gridDim.x - fb) {
        const int c = (which ? 0 : 64) + (it >> 2), t0 = c * 64;
        { const int i = tid >> 3, part = tid & 7; const bf16_t* pr = proj + (size_t)(t0 + i) * PLD;
          const u32x4 qv = *(const u32x4*)(pr + head * 64 + part * 8), kv = *(const u32x4*)(pr + 256 + head * 64 + part * 8);
          const u32x4 v0 = *(const u32x4*)(pr + 512 + head * 128 + part * 16), v1 = *(const u32x4*)(pr + 512 + head * 128 + part * 16 + 8);
          *(LAS u32x4*)(Qs + i * 144 + part * 16) = qv; *(LAS u32x4*)(Ks + i * 144 + part * 16) = kv;
          *(LAS u32x4*)(Vs + i * 272 + part * 32) = v0; *(LAS u32x4*)(Vs + i * 272 + part * 32 + 16) = v1;
#pragma unroll
          for (int dir = 0; dir < 2; ++dir) { const u32x4 l0 = *(const u32x4*)(pr + 1536 + dir * 16), l1 = *(const u32x4*)(pr + 1536 + dir * 16 + 8);
              float lr[16]; lr[0] = bflo(l0.x); lr[1] = bfhi(l0.x); lr[2] = bflo(l0.y); lr[3] = bfhi(l0.y); lr[4] = bflo(l0.z); lr[5] = bfhi(l0.z); lr[6] = bflo(l0.w); lr[7] = bfhi(l0.w);
              lr[8] = bflo(l1.x); lr[9] = bfhi(l1.x); lr[10] = bflo(l1.y); lr[11] = bfhi(l1.y); lr[12] = bflo(l1.z); lr[13] = bfhi(l1.z); lr[14] = bflo(l1.w); lr[15] = bfhi(l1.w);
              const int il = dir ? 63 - i : i;
#pragma unroll
              for (int kk = 0; kk < 8; ++kk) { const int k = part * 8 + kk; float pre = wgs[2048 + dir * 64 + k];
#pragma unroll
                  for (int r = 0; r < 16; ++r) pre += lr[r] * wgs[(dir * 16 + r) * 64 + k];
                  bs[(dir * 64 + il) * 65 + k] = (fminf(pre, 0.f) - __logf(1.0f + __expf(-fabsf(pre)))) * (1.0f / 16.0f); } } }
        __syncthreads();
#pragma unroll 1
        for (int s = 0; s < 16; ++s) { const int dk = wave * 16 + s, dir = dk >> 6, k = dk & 63; float x = bs[(dir * 64 + lane) * 65 + k];
#pragma unroll
            for (int off = 1; off < 64; off <<= 1) { const float y = __shfl_up(x, off); if (lane >= off) x += y; }
            bs[(dir * 64 + lane) * 65 + k] = x; }
        __syncthreads();
        for (int u = tid; u < 1024; u += 512) { const int k8 = u & 7, i = (u >> 3) & 63, dir = u >> 9, pi = dir ? 63 - i : i;
            const u32x4 qv = *(const LAS u32x4*)(Qs + pi * 144 + k8 * 16), kv = *(const LAS u32x4*)(Ks + pi * 144 + k8 * 16); const LAS float* bp = bs + (dir * 64 + i) * 65 + k8 * 8;
            float e[8];
#pragma unroll
            for (int j = 0; j < 8; ++j) e[j] = __expf(bp[j]);
            u32x4 o; o.x = pk2(bflo(qv.x) * 0.125f * e[0], bfhi(qv.x) * 0.125f * e[1]); o.y = pk2(bflo(qv.y) * 0.125f * e[2], bfhi(qv.y) * 0.125f * e[3]);
            o.z = pk2(bflo(qv.z) * 0.125f * e[4], bfhi(qv.z) * 0.125f * e[5]); o.w = pk2(bflo(qv.w) * 0.125f * e[6], bfhi(qv.w) * 0.125f * e[7]);
            *(LAS u32x4*)(QDs + dir * 9216 + i * 144 + k8 * 16) = o;
            o.x = pk2(bflo(kv.x) / e[0], bfhi(kv.x) / e[1]); o.y = pk2(bflo(kv.y) / e[2], bfhi(kv.y) / e[3]); o.z = pk2(bflo(kv.z) / e[4], bfhi(kv.z) / e[5]); o.w = pk2(bflo(kv.w) / e[6], bfhi(kv.w) / e[7]);
            *(LAS u32x4*)(KIs + dir * 9216 + i * 144 + k8 * 16) = o; }
        __syncthreads();
        { const int dir = wave >> 2, mb = (wave >> 1) & 1, nb = wave & 1, r = lane & 31, hh = lane >> 5;
          f32x16 acc;
#pragma unroll
          for (int e = 0; e < 16; ++e) acc[e] = 0.f;
          if (nb <= mb) {
#pragma unroll
              for (int ks = 0; ks < 4; ++ks) { const bf16x8_t a = *(const LAS bf16x8_t*)(QDs + dir * 9216 + (32 * mb + r) * 144 + (16 * ks + 8 * hh) * 2), b = *(const LAS bf16x8_t*)(KIs + dir * 9216 + (32 * nb + r) * 144 + (16 * ks + 8 * hh) * 2);
                  acc = __builtin_amdgcn_mfma_f32_32x32x16_bf16(a, b, acc, 0, 0, 0); } }
          unsigned char* img = WSP(p) + WS_IMG + (size_t)((c * 4 + head) * 2 + dir) * G_BYTES; const int j = 32 * nb + r; bf16_t* ap = (bf16_t*)(img + G_ATT) + pinv16(j);
#pragma unroll
          for (int e = 0; e < 16; ++e) { const int i = 32 * mb + (e & 3) + 8 * (e >> 2) + 4 * hh; ap[i * 72] = (bf16_t)f2bf(j <= i ? acc[e] : 0.f); } }
        for (int u = tid; u < 1024; u += 512) {
            const int hh = u & 1, ks = (u >> 1) & 3, i = (u >> 3) & 63, dir = u >> 9;
            const u32x2 a = *(const LAS u32x2*)(QDs + dir * 9216 + i * 144 + (16 * ks + 4 * hh) * 2), b = *(const LAS u32x2*)(QDs + dir * 9216 + i * 144 + (16 * ks + 8 + 4 * hh) * 2);
            u32x4 o; o.x = a.x; o.y = a.y; o.z = b.x; o.w = b.y;
            *(u32x4*)(WSP(p) + WS_IMG + (size_t)((c * 4 + head) * 2 + dir) * G_BYTES + G_QD + i * 144 + (16 * ks + 8 * hh) * 2) = o; }
        for (int u = tid; u < 1024; u += 512) {
            const int k = u & 63, hh = (u >> 6) & 1, ks = (u >> 7) & 3, dir = u >> 9; const float be = bs[(dir * 64 + 63) * 65 + k]; float v[8];
#pragma unroll
            for (int j = 0; j < 8; ++j) { const int ja = 16 * ks + kact16(j, hh), pj = dir ? 63 - ja : ja; v[j] = bf2f(*(const LAS bf16_t*)(Ks + pj * 144 + k * 2)) * __expf(be - bs[(dir * 64 + ja) * 65 + k]); }
            u32x4 o; o.x = pk2(v[0], v[1]); o.y = pk2(v[2], v[3]); o.z = pk2(v[4], v[5]); o.w = pk2(v[6], v[7]);
            *(u32x4*)(WSP(p) + WS_IMG + (size_t)((c * 4 + head) * 2 + dir) * G_BYTES + G_KE + k * 144 + (16 * ks + 8 * hh) * 2) = o; }
        for (int u = tid; u < 2048; u += 512) {
            const int n = u & 127, hh = (u >> 7) & 1, ks = (u >> 8) & 3, dir = u >> 10; unsigned short v[8];
#pragma unroll
            for (int j = 0; j < 8; ++j) { const int ja = 16 * ks + kact16(j, hh), pj = dir ? 63 - ja : ja; v[j] = *(const LAS bf16_t*)(Vs + pj * 272 + n * 2); }
            u32x4 o; o.x = v[0] | ((unsigned)v[1] << 16); o.y = v[2] | ((unsigned)v[3] << 16); o.z = v[4] | ((unsigned)v[5] << 16); o.w = v[6] | ((unsigned)v[7] << 16);
            *(u32x4*)(WSP(p) + WS_IMG + (size_t)((c * 4 + head) * 2 + dir) * G_BYTES + G_VT + n * 144 + (16 * ks + 8 * hh) * 2) = o; }
        if (tid < 128) { const int dir = tid >> 6, k = tid & 63; *(float*)(WSP(p) + WS_IMG + (size_t)((c * 4 + head) * 2 + dir) * G_BYTES + G_DEC + k * 4) = __expf(bs[(dir * 64 + 63) * 65 + k]); }
        __syncthreads();
    }
}

__device__ __forceinline__ void gla_chain(const Params& p, LAS unsigned char* lds, int cfirst, int nch, int dir, int head, const float* s_init, float* s_out) {
    const int tid = otid(), lane = tid & 63, wave = __builtin_amdgcn_readfirstlane(tid >> 6), r = lane & 31, hh = lane >> 5;
    const unsigned char* imgbase = WSP(p) + WS_IMG; float* obuf = (float*)(WSP(p) + (dir ? WS_OB : WS_OSUM));
    const int cstep = dir ? -1 : 1, c0 = dir ? cfirst + nch - 1 : cfirst;
    { const unsigned char* img = imgbase + (size_t)((c0 * 4 + head) * 2 + dir) * G_BYTES;
      for (int q = tid; q < G_STAGE / 16; q += 512) *(LAS u32x4*)(lds + q * 16) = *(const u32x4*)(img + q * 16); }
    if (wave >= 4) {
        if (nch == 64) chain_loader<64, G_STAGE, G_BYTES, 4>(lds, imgbase, c0, cstep, head, dir, tid - 256); else chain_loader<4, G_STAGE, G_BYTES, 4>(lds, imgbase, c0, cstep, head, dir, tid - 256);
    } else {
        f32x16 S[2];
        const int col = wave * 32 + r;
        { const float* sp = s_init ? s_init + (4 * hh) * 128 + col : nullptr;
#pragma unroll
          for (int mb = 0; mb < 2; ++mb)
#pragma unroll
            for (int m = 0; m < 4; ++m) { asm volatile("" : "+v"(sp));
#pragma unroll
                for (int rr = 0; rr < 4; ++rr) S[mb][4 * m + rr] = sp ? sp[rr * 128] : 0.f;
                if (sp) sp += 8 * 128; } }
        __syncthreads();
        for (int s = 0; s < nch; ++s) {
            const int cidx = c0 + cstep * s;
            LAS unsigned char* buf = lds + (s & 1) * G_STAGE;
            bf16x8_t vb[4];
#pragma unroll
            for (int ks = 0; ks < 4; ++ks) vb[ks] = *(const LAS bf16x8_t*)(buf + G_VT + col * 144 + (16 * ks + 8 * hh) * 2);
#pragma unroll
            for (int mb = 0; mb < 2; ++mb) { f32x16 O; asm volatile("" ::: "memory");
                bf16x8_t af[8];
#pragma unroll
                for (int ks = 0; ks < 4; ++ks) { af[ks] = *(const LAS bf16x8_t*)(buf + G_QD + (32 * mb + r) * 144 + (16 * ks + 8 * hh) * 2); af[4 + ks] = *(const LAS bf16x8_t*)(buf + G_ATT + (32 * mb + r) * 144 + (16 * ks + 8 * hh) * 2); }
#pragma unroll
                for (int e = 0; e < 16; ++e) O[e] = 0.f;
#pragma unroll
                for (int ks = 0; ks < 4; ++ks) O = __builtin_amdgcn_mfma_f32_32x32x16_bf16(af[ks], SBF(ks), O, 0, 0, 0);
#pragma unroll
                for (int ks = 0; ks < 4; ++ks) O = __builtin_amdgcn_mfma_f32_32x32x16_bf16(af[4 + ks], vb[ks], O, 0, 0, 0);
#pragma unroll
                for (int m = 0; m < 4; ++m) { const int g4 = 8 * mb + 2 * m + hh, tg = cidx * 16 + (dir ? 15 - g4 : g4);
                    f32x4 ov; if (dir) { ov[0] = O[4 * m + 3]; ov[1] = O[4 * m + 2]; ov[2] = O[4 * m + 1]; ov[3] = O[4 * m + 0]; } else { ov[0] = O[4 * m + 0]; ov[1] = O[4 * m + 1]; ov[2] = O[4 * m + 2]; ov[3] = O[4 * m + 3]; }
                    *(f32x4*)(obuf + ((size_t)tg * 512 + head * 128 + col) * 4) = ov; } }
            { asm volatile("" ::: "memory");
              bf16x8_t af[8]; f32x4 dv[8];
#pragma unroll
              for (int mb = 0; mb < 2; ++mb)
#pragma unroll
                for (int ks = 0; ks < 4; ++ks) { af[4 * mb + ks] = *(const LAS bf16x8_t*)(buf + G_KE + (32 * mb + r) * 144 + (16 * ks + 8 * hh) * 2); dv[4 * mb + ks] = *(const LAS f32x4*)(buf + G_DEC + (32 * mb + 8 * ks + 4 * hh) * 4); }
#pragma unroll
              for (int mb = 0; mb < 2; ++mb) {
#pragma unroll
                for (int m = 0; m < 4; ++m)
#pragma unroll
                    for (int rr = 0; rr < 4; ++rr) S[mb][4 * m + rr] *= dv[4 * mb + m][rr];
#pragma unroll
                for (int ks = 0; ks < 4; ++ks) S[mb] = __builtin_amdgcn_mfma_f32_32x32x16_bf16(af[4 * mb + ks], vb[ks], S[mb], 0, 0, 0); } }
            lds_barrier();
        }
        if (s_out) {
            float* sp = s_out + (4 * hh) * 128 + col;
#pragma unroll
            for (int mb = 0; mb < 2; ++mb)
#pragma unroll
                for (int m = 0; m < 4; ++m) { asm volatile("" : "+v"(sp));
#pragma unroll
                    for (int rr = 0; rr < 4; ++rr) sp[rr * 128] = S[mb][4 * m + rr];
                    sp += 8 * 128; }
        }
    }
}
constexpr size_t WS_RGAB = WS_IMG + (size_t)1536 * 49152;
__device__ __forceinline__ void rg_pre(const Params& p, LAS unsigned char* lds, int jl, int which, int fb) {
    const int tid = otid(), lane = tid & 63, wave = __builtin_amdgcn_readfirstlane(tid >> 6), r = lane & 31, hh = lane >> 5;
    const bf16_t* proj = (const bf16_t*)(WSP(p) + WS_PROJ);
    LAS unsigned char* xcs = lds;
    LAS float* xcf = (LAS float*)(lds + 9216);
    LAS unsigned char* wts = lds + 9216 + 16640;
    LAS float* prm = (LAS float*)(lds + 9216 + 16640 + 36864);
    const int n = obid() & 7;
    for (int e = tid; e < 4 * 4096; e += 512) { const int m = e >> 12, j = (e >> 6) & 63, c = e & 63, dir = m >> 1, gate = m & 1;
        const float w = PIN(gate ? I_RGWX : I_RGWA)[((size_t)((jl * 2 + dir) * 8 + n) * 64 + j) * 64 + c];
        *(LAS bf16_t*)(wts + m * 9216 + c * 144 + j * 2) = (bf16_t)f2bf(w); }
    if (tid < 128) { const int dir = tid >> 6, c = tid & 63, ch = n * 64 + c; prm[(dir * 3 + 0) * 64 + c] = PIN(I_RGBA)[(jl * 2 + dir) * 512 + ch]; prm[(dir * 3 + 1) * 64 + c] = PIN(I_RGBX)[(jl * 2 + dir) * 512 + ch];
        prm[(dir * 3 + 2) * 64 + c] = softplusf_(-PIN(I_RGLAM)[(jl * 2 + dir) * 512 + ch]); }
    __syncthreads();
    unsigned* AB = (unsigned*)(WSP(p) + WS_RGAB);
    for (int it = obid() - fb; it < (which ? 512 : 1024); it += gridDim.x - fb) {
        const int c64 = (which ? 0 : 64) + (it >> 3), t0 = c64 * 64; int lo, hi; seq_bounds(t0, lo, hi);
        { const int i = tid >> 3, part = tid & 7, ch = n * 64 + part * 8; float acc[8];
          const f32x4 b0 = *(const f32x4*)(PIN(I_RGCB) + jl * 512 + ch), b1 = *(const f32x4*)(PIN(I_RGCB) + jl * 512 + ch + 4);
          acc[0] = b0[0]; acc[1] = b0[1]; acc[2] = b0[2]; acc[3] = b0[3]; acc[4] = b1[0]; acc[5] = b1[1]; acc[6] = b1[2]; acc[7] = b1[3];
#pragma unroll
          for (int tap = 0; tap < 4; ++tap) { const int tt = t0 + i + tap - 1;
              if (tt >= lo && tt < hi) { const u32x4 x = *(const u32x4*)(proj + (size_t)tt * PLD + 1568 + ch); const float* wp = PIN(I_RGCW) + (jl * 4 + tap) * 512 + ch; const f32x4 w0 = *(const f32x4*)wp, w1 = *(const f32x4*)(wp + 4);
                  acc[0] += w0[0] * bflo(x.x); acc[1] += w0[1] * bfhi(x.x); acc[2] += w0[2] * bflo(x.y); acc[3] += w0[3] * bfhi(x.y); acc[4] += w1[0] * bflo(x.z); acc[5] += w1[1] * bfhi(x.z); acc[6] += w1[2] * bflo(x.w); acc[7] += w1[3] * bfhi(x.w); } }
          u32x4 o; o.x = pk2(acc[0], acc[1]); o.y = pk2(acc[2], acc[3]); o.z = pk2(acc[4], acc[5]); o.w = pk2(acc[6], acc[7]);
          *(LAS u32x4*)(xcs + i * 144 + part * 16) = o;
#pragma unroll
          for (int q = 0; q < 8; ++q) xcf[i * 65 + part * 8 + q] = acc[q]; }
        __syncthreads();
        { const int dir = wave >> 2, mb = (wave >> 1) & 1, nb = wave & 1; f32x16 ar, ai;
#pragma unroll
          for (int e = 0; e < 16; ++e) { ar[e] = 0.f; ai[e] = 0.f; }
#pragma unroll
          for (int ks = 0; ks < 4; ++ks) { const bf16x8_t a = *(const LAS bf16x8_t*)(xcs + (32 * mb + r) * 144 + (16 * ks + 8 * hh) * 2);
              const bf16x8_t br = *(const LAS bf16x8_t*)(wts + (dir * 2 + 0) * 9216 + (32 * nb + r) * 144 + (16 * ks + 8 * hh) * 2), bi = *(const LAS bf16x8_t*)(wts + (dir * 2 + 1) * 9216 + (32 * nb + r) * 144 + (16 * ks + 8 * hh) * 2);
              ar = __builtin_amdgcn_mfma_f32_32x32x16_bf16(a, br, ar, 0, 0, 0); ai = __builtin_amdgcn_mfma_f32_32x32x16_bf16(a, bi, ai, 0, 0, 0); }
          const int c = 32 * nb + r; const float ba = prm[(dir * 3 + 0) * 64 + c], bx = prm[(dir * 3 + 1) * 64 + c], sp = prm[(dir * 3 + 2) * 64 + c];
          unsigned* dst = AB + ((size_t)dir * NT + t0) * 512 + n * 64 + c;
#pragma unroll
          for (int e = 0; e < 16; ++e) { const int i = 32 * mb + (e & 3) + 8 * (e >> 2) + 4 * hh;
              const float rr = sigmoidf_(ar[e] + ba), ig = sigmoidf_(ai[e] + bx), la = -8.0f * rr * sp;
              const float a_ = __expf(la); dst[(size_t)i * 512] = pk2(1.0f - a_, __builtin_amdgcn_sqrtf(1.0f - a_ * a_) * (ig * xcf[i * 65 + c])); } }
        __syncthreads();
    }
}
template <bool STORE_TMP, bool FINAL, int NB>
__device__ __forceinline__ float rg_scan256(const unsigned* ab, int dir, int base, float h, float& dprod, float* tmp, const bf16_t* gatep, bf16_t* mixp) {
#pragma unroll 1
    for (int i0 = 0; i0 < SEG; i0 += NB) { unsigned u[NB]; float tv[NB]; unsigned short gv[NB];
#pragma unroll
        for (int q = 0; q < NB; ++q) { const int t = dir ? base + SEG - 1 - (i0 + q) : base + i0 + q; u[q] = ab[(size_t)t * 512]; if (FINAL) { tv[q] = tmp[(size_t)t * 512]; gv[q] = gatep[(size_t)t * PLD]; } }
#pragma unroll
        for (int q = 0; q < NB; ++q) { const int t = dir ? base + SEG - 1 - (i0 + q) : base + i0 + q; const float a = 1.0f - bflo(u[q]); h = a * h + bfhi(u[q]); dprod *= a;
            if (STORE_TMP) tmp[(size_t)t * 512] = h;
            if (FINAL) mixp[(size_t)t * 1024] = (bf16_t)f2bf(geluf_(bf2f(gv[q])) * (tv[q] + h)); } }
    return h;
}
__device__ __forceinline__ float rg_carry(const Params& p, int jl, int seg, int dir, int chn) {
    const int sseg = seg - 16, b = sseg >> 4, j = sseg & 15, nst = dir ? 15 - j : j; float h = PIN(I_SRG)[((b * 2 + jl) * 2 + dir) * 512 + chn];
    float dv[15], ev[15];
#pragma unroll
    for (int q = 0; q < 15; ++q) { const int sj = b * 16 + (dir ? 15 - q : q), o = (sj * 2 + dir) * 512 + chn; dv[q] = q < nst ? ((const float*)(WSP(p) + WS_C2D))[o] : 1.f; ev[q] = q < nst ? ((const float*)(WSP(p) + WS_C2E))[o] : 0.f; }
#pragma unroll
    for (int q = 0; q < 15; ++q) h = dv[q] * h + ev[q];
    return h;
}
__device__ __forceinline__ void rg_passA(const Params& p, int seg, int dir, int n) {
    const int lane = otid() & 63, chn = n * 64 + lane, sseg = seg - 16; float dprod = 1.f;
    const unsigned* ab = (const unsigned*)(WSP(p) + WS_RGAB) + (size_t)dir * NT * 512 + chn;
    const float h = rg_scan256<false, false, 32>(ab, dir, seg * SEG, 0.f, dprod, nullptr, nullptr, nullptr);
    ((float*)(WSP(p) + WS_C2E))[(sseg * 2 + dir) * 512 + chn] = h; ((float*)(WSP(p) + WS_C2D))[(sseg * 2 + dir) * 512 + chn] = dprod;
}
__device__ __forceinline__ void rg_passB(const Params& p, int jl, int seg, int n) {
    const int lane = otid() & 63, chn = n * 64 + lane; float dprod = 1.f;
    const unsigned* ab = (const unsigned*)(WSP(p) + WS_RGAB) + chn; float* tmp = (float*)(WSP(p) + WS_YS) + chn;
    const bf16_t* gatep = (const bf16_t*)(WSP(p) + WS_PROJ) + 2080 + chn; bf16_t* mixp = (bf16_t*)(WSP(p) + WS_HN) + 512 + chn;
    const float hf0 = seg >= 16 ? rg_carry(p, jl, seg, 0, chn) : 0.f, hb0 = seg >= 16 ? rg_carry(p, jl, seg, 1, chn) : 0.f;
    const float hf = rg_scan256<true, false, 32>(ab, 0, seg * SEG, hf0, dprod, tmp, nullptr, nullptr);
    const float hb = rg_scan256<false, true, 16>(ab + (size_t)NT * 512, 1, seg * SEG, hb0, dprod, tmp, gatep, mixp);
    if (seg < 16) { POUT()[OUT_RG + ((seg * 2 + jl) * 2 + 0) * 512 + chn] = hf; POUT()[OUT_RG + ((seg * 2 + jl) * 2 + 1) * 512 + chn] = hb; }
}

__device__ __forceinline__ void inproj_tail(const Params& p, int first_blk) {
    const int lane = otid() & 63, wave = __builtin_amdgcn_readfirstlane(otid() >> 6), r = lane & 31, hh = lane >> 5;
    const int nblk = gridDim.x - first_blk;
    const bf16_t* hn = (const bf16_t*)(WSP(p) + WS_HN); const bf16_t* wt = (const bf16_t*)(WSP(p) + WS_WIN) + (size_t)(2560 + r) * 1024 + 8 * hh; bf16_t* proj = (bf16_t*)(WSP(p) + WS_PROJ);
    for (int tile = (obid() - first_blk) * 8 + wave; tile < NT / 32; tile += nblk * 8) {
        const bf16_t* ap = hn + (size_t)(tile * 32 + r) * 1024 + 8 * hh;
        f32x16 acc;
#pragma unroll
        for (int e = 0; e < 16; ++e) acc[e] = 0.f;
#pragma unroll 1
        for (int k0 = 0; k0 < 64; k0 += 8) { bf16x8_t a[8], b[8];
#pragma unroll
            for (int q = 0; q < 8; ++q) { a[q] = *(const bf16x8_t*)(ap + (k0 + q) * 16); b[q] = *(const bf16x8_t*)(wt + (k0 + q) * 16); }
#pragma unroll
            for (int q = 0; q < 8; ++q) acc = __builtin_amdgcn_mfma_f32_32x32x16_bf16(a[q], b[q], acc, 0, 0, 0); }
        bf16_t* op = proj + (size_t)(tile * 32) * PLD + 2560 + r;
#pragma unroll
        for (int e = 0; e < 16; ++e) op[(size_t)((e & 3) + 8 * (e >> 2) + 4 * hh) * PLD] = (bf16_t)f2bf(acc[e]);
    }
}
__device__ __forceinline__ void ab_pre(const Params& p, LAS unsigned char* lds, int jl) {
    gla_pre(p, lds, jl, 0, 0);
    rg_pre(p, lds, jl, 0, 0);
}
__device__ __forceinline__ void ab_chain(const Params& p, LAS unsigned char* lds, int jl, const XcdBarrier& sub) {
    const int bid = obid();
    if (bid >= 16) { gla_pre(p, lds, jl, 1, 16); rg_pre(p, lds, jl, 1, 16); xcd_barrier(sub); }
    if (bid < 144) { const bool smp = bid < 16; const int q = smp ? bid : bid - 16, b = q >> 3, dir = (q >> 2) & 1, head = q & 3;
        const size_t so = (size_t)(((b * 2 + jl) * 2 + dir) * 4 + head) * 8192;
        gla_chain(p, lds, smp ? 64 + 64 * b : 4 * b, smp ? 64 : 4, dir, head, smp ? PIN(I_SGLA) + so : nullptr, smp ? nullptr : POUT() + OUT_GLA + so); }
    if (bid >= 16) { const int wave = __builtin_amdgcn_readfirstlane(otid() >> 6);
        for (int idx = (bid - 16) * 8 + wave; idx < NSSEG * 16; idx += (gridDim.x - 16) * 8) { const int seg = 16 + idx / 16, r = idx % 16; rg_passA(p, seg, r >> 3, r & 7); } }
    if (bid >= 144) inproj_tail(p, 144);
}
__device__ __forceinline__ void ab_fin(const Params& p, int jl) {
    { const int wave = __builtin_amdgcn_readfirstlane(otid() >> 6), G = gridDim.x;
      for (int idx = wave * G + obid(); idx < NSEG * 8; idx += 8 * G) rg_passB(p, jl, idx >> 3, idx & 7); }
    ab_combine(p, jl);
}
__device__ __forceinline__ void cd_pre(const Params& p, LAS unsigned char* lds, int jl) {
    dn_pre(p, lds, jl, 0, 0);
    const int wave = __builtin_amdgcn_readfirstlane(otid() >> 6), G = gridDim.x;
    for (int idx = wave * G + obid(); idx < NSSEG * 64; idx += 8 * G) { const int seg = 16 + idx / 64, r = idx % 64; s5_task<false>(p, lds, jl, seg, r >> 5, r & 31); }
}
__device__ __forceinline__ void cd_chain(const Params& p, LAS unsigned char* lds, int jl, const XcdBarrier& sub) {
    const int bid = obid();
    if (bid >= 16) { dn_pre(p, lds, jl, 1, 16); xcd_barrier(sub); }
    if (bid < 144) { const bool smp = bid < 16; const int q = smp ? bid : bid - 16, b = q >> 3, dir = (q >> 2) & 1, head = q & 3;
        const size_t so = (size_t)(((b * 2 + jl) * 2 + dir) * 4 + head) * 16384;
        dn_chain(p, lds, jl, smp ? 64 + 64 * b : 4 * b, smp ? 64 : 4, dir, head, smp ? PIN(I_SDN) + so : nullptr, smp ? nullptr : POUT() + OUT_DN + so); }
    if (bid >= 16) { const int wave = __builtin_amdgcn_readfirstlane(otid() >> 6);
        for (int idx = (bid - 16) * 8 + wave; idx < NSEG * 64; idx += (gridDim.x - 16) * 8) { const int seg = idx / 64, r = idx % 64; s5_task<true>(p, lds, jl, seg, r >> 5, r & 31); } }
}
__device__ __forceinline__ void cd_combine(const Params& p, int jl) {
    const int lane = otid() & 63, gw = obid() * 8 + (otid() >> 6), nw = gridDim.x * 8;
    const bf16_t* proj = (const bf16_t*)(WSP(p) + WS_PROJ); const float* ys = (const float*)(WSP(p) + WS_YS); bf16_t* zg = (bf16_t*)(WSP(p) + WS_ZG);
    for (int t = gw; t < NT; t += nw) {
        const bf16_t* pr = proj + (size_t)t * PLD; const float* os = ys + (size_t)t * 512;
#pragma unroll
        for (int i = 0; i < 4; ++i) { const int c = i * 128 + 2 * lane; const float2 y = *(const float2*)(os + c); const unsigned u = *(const unsigned*)(pr + c); const float2 d = *(const float2*)(PIN(I_S5D) + jl * 512 + c);
            *(unsigned*)(zg + (size_t)t * 512 + c) = pk2(geluf_(y.x + d.x * bflo(u)), geluf_(y.y + d.y * bfhi(u))); }
    }
}

__global__ void __launch_bounds__(512) fwd_mega(Params p) {
    extern __shared__ __attribute__((aligned(16))) unsigned char lds_raw[];
    LAS unsigned char* lds = (LAS unsigned char*)lds_raw;
    cg::grid_group grid = cg::this_grid();
    const int G = gridDim.x, bid = obid();
    unsigned char* ws = WSP(p);
    float* X = (float*)(ws + WS_X); bf16_t* HN = (bf16_t*)(ws + WS_HN); bf16_t* PROJ = (bf16_t*)(ws + WS_PROJ);
    const float* MOD = (const float*)(ws + WS_MOD);

    if (otid() < 8) ((LAS unsigned*)(lds + LDS_BAR))[otid()] = 0u;
    __syncthreads();
    const XcdBarrier xbar = xcd_barrier_post((unsigned*)(ws + WS_BAR), (volatile LAS unsigned*)(lds + LDS_BAR), gridDim.x);
    XcdBarrier xsub = xbar; if (bid >= 16) xsub = xcd_barrier_post((unsigned*)(ws + WS_BAR + 16384), (volatile LAS unsigned*)(lds + LDS_BAR + 16), gridDim.x - 16);
#define GSYNC() xcd_barrier(xbar)
    phase0(p, lds);
    grid.sync();
#pragma unroll 1
    for (int l = 0; l < 4; ++l) {
        const int jl = l >> 1; const bool isAB = (l & 1) == 0;
        const float* mod = MOD + (size_t)l * 3 * 6144;
        if (l > 0) prep_rest(p, lds, l);

        norm_phase<false>(X, PIN(I_N1W) + l * 1024, mod + 0, mod + 1024, HN, nullptr);
        GSYNC();
        { const int n1 = isAB ? 2560 : 2816;
          pg8::Gemm g{HN, (const bf16_t*)(ws + WS_WIN), NT, n1, 1024}; pg8::StaticOrder S; S.init(NT, n1, G, bid); EpiProj E{PROJ, PLD};
          pg8::gemm_phase<EpiProj, pg8::StaticOrder>(lds, g, S, E, nullptr); }
        GSYNC();
        if (isAB) {
            ab_pre(p, lds, jl); GSYNC();
            ab_chain(p, lds, jl, xsub); GSYNC();
            ab_fin(p, jl); GSYNC();
        } else {
            cd_pre(p, lds, jl); GSYNC();
            cd_chain(p, lds, jl, xsub); GSYNC();
            cd_combine(p, jl); GSYNC();
            { pg8::Gemm g{(const bf16_t*)(ws + WS_ZG), (const bf16_t*)(ws + WS_WGLU), NT, 512, 512}; pg8::StaticOrder S; S.init(NT, 512, G, bid);
              EpiGLU E{HN, (const bf16_t*)(ws + WS_ZG), PIN(I_GLUB) + jl * 512};
              pg8::gemm_phase<EpiGLU, pg8::StaticOrder>(lds, g, S, E, nullptr);
              if (bid >= 96) chain_combine(p, PIN(I_DNNW) + jl * 128, 2048, 512, 96); }
            GSYNC();
        }
        { pg8::Gemm g{HN, (const bf16_t*)(ws + WS_WOUT), NT, 1024, 1024}; pg8::StaticOrder S; S.init(NT, 1024, G, bid); EpiResid E{X, mod + 2048};
          pg8::gemm_phase<EpiResid, pg8::StaticOrder>(lds, g, S, E, nullptr); }
        GSYNC();
        norm_phase<false>(X, PIN(I_N2W) + l * 1024, mod + 3072, mod + 4096, HN, nullptr);
        GSYNC();
        { pg8::Gemm g{HN, (const bf16_t*)(ws + WS_WGU), NT, 5632, 1024}; pg8::StaticOrder S; S.init(NT, 5632, G, bid); EpiSwiGLU E{PROJ};
          pg8::gemm_phase<EpiSwiGLU, pg8::StaticOrder>(lds, g, S, E, nullptr); }
        GSYNC();
        { pg8::Gemm g{PROJ, (const bf16_t*)(ws + WS_WDN), NT, 1024, 2816}; pg8::StaticOrder S; S.init(NT, 1024, G, bid); EpiResid E{X, mod + 5120};
          pg8::gemm_phase<EpiResid, pg8::StaticOrder>(lds, g, S, E, nullptr);
          if (bid >= 192 && l < 3) { prep_in_out(p, lds, l + 1, 192); if ((l & 1) == 0) zero_osum(p, 192); } }
        GSYNC();
    }
    norm_phase<true>(X, PIN(I_FNW), nullptr, nullptr, nullptr, POUT() + OUT_Y);
}

extern "C" void kernel_launch(void* const* d_in, const int* in_sizes, int n_in, void* d_out, int out_size, void* d_ws, size_t ws_size, hipStream_t stream) {
    static int grid_blocks = 0;
    if (grid_blocks == 0) {
        if (n_in != 44 || ws_size < WS_END) { fprintf(stderr, "kernel_launch: need 44 inputs and %zu bytes of workspace; got %d, %zu\n", (size_t)WS_END, n_in, ws_size); grid_blocks = -1; return; }
        int dev = 0, cus = 0, per_cu = 0;
        (void)hipGetDevice(&dev); (void)hipDeviceGetAttribute(&cus, hipDeviceAttributeMultiprocessorCount, dev);
        if (hipFuncSetAttribute((const void*)fwd_mega, hipFuncAttributeMaxDynamicSharedMemorySize, LDS_BYTES) != hipSuccess) { fprintf(stderr, "kernel_launch: hipFuncSetAttribute failed\n"); grid_blocks = -1; return; }
        if (hipOccupancyMaxActiveBlocksPerMultiprocessor(&per_cu, (const void*)fwd_mega, 512, LDS_BYTES) != hipSuccess || per_cu < 1) { fprintf(stderr, "kernel_launch: occupancy query gave %d\n", per_cu); per_cu = 1; }
        (void)hipGetLastError();
        grid_blocks = cus;
    }
    if (grid_blocks < 0) return;
    if (hipMemsetAsync((char*)d_ws + WS_BAR, 0, 32768, stream) != hipSuccess) { fprintf(stderr, "kernel_launch: memset failed\n"); return; }
    Params p{};
    for (int i = 0; i < 44; ++i) p.in[i] = (const float*)d_in[i];
    p.out = (float*)d_out; p.ws = (unsigned char*)d_ws;
    void* args[] = {&p};
    hipError_t e = hipLaunchCooperativeKernel((const void*)fwd_mega, dim3(grid_blocks), dim3(512), args, LDS_BYTES, stream);
    if (e != hipSuccess) fprintf(stderr, "cooperative launch failed: %s (grid %d)\n", hipGetErrorString(e), grid_blocks);
}
```

```cpp
#include <hip/hip_runtime.h>
#include <hip/hip_cooperative_groups.h>
#include <cstdio>
namespace cg = cooperative_groups;
__device__ __forceinline__ int otid() { int t = threadIdx.x; asm volatile("" : "+v"(t)); return t; }
__device__ __forceinline__ int obid() { int b = blockIdx.x; asm volatile("" : "+s"(b)); return b; }
namespace pg8 {
#define PG8_LAS __attribute__((address_space(3)))
typedef unsigned short bf16_t;
typedef short bf16x8 __attribute__((ext_vector_type(8)));
typedef float f32x4 __attribute__((ext_vector_type(4)));
typedef unsigned u32x4 __attribute__((ext_vector_type(4)));
constexpr int BM = 256, BK = 64, HALF = 128, HTB = HALF * BK * 2  , STAGE_BYTES = 8 * HTB, NXCD = 8, WGM = 8;

__host__ __device__ __forceinline__ int lds_byte(int r, int c) { const int st = (r >> 4) * 2 + (c >> 5), rr = r & 15, cc = c & 31, ob = rr * 64 + cc * 2; return st * 1024 + (ob ^ (((ob >> 9) & 1) << 5)); }
__host__ __device__ __forceinline__ void stage_rc(int b, int& R, int& C) { const int st = b / 1024, sb = b % 1024, swz = sb ^ (((sb >> 9) & 1) << 5); R = (st >> 1) * 16 + swz / 64; C = (st & 1) * 32 + (swz % 64) / 2; }
__host__ __device__ __forceinline__ int perm32(int rho) { const int n = rho >> 4, i = rho & 15; return 8 * (i >> 2) + 4 * n + (i & 3); }

struct Unit { int pm, pn; };
struct Gemm { const bf16_t* A; const bf16_t* Bt; int M, N, K; };

struct StaticOrder {
    int nM, nN, nwg, G, c;
    __host__ __device__ void init(int M, int N, int G_, int c_) { nM = M / BM; nN = N / BM; nwg = nM * nN; G = G_; c = c_; }
    __host__ __device__ bool next(int i, Unit& u) const {
        const long L = (long)i * G + c; if (L >= nwg) return false;
        int wgid = (int)L; { const int q = nwg / NXCD, r = nwg % NXCD, xcd = wgid % NXCD, off = wgid / NXCD; wgid = (xcd < r ? xcd * (q + 1) : r * (q + 1) + (xcd - r) * q) + off; }
        const int nig = WGM * nN, gid = wgid / nig, fm = gid * WGM, gsz = (nM - fm) < WGM ? (nM - fm) : WGM;
        u.pm = fm + ((wgid % nig) % gsz); u.pn = (wgid % nig) / gsz; return true;
    }
    __device__ __forceinline__ void a_ready(const Unit&) const {}
    __device__ __forceinline__ void done(const Unit&) const {}
};
__device__ __forceinline__ unsigned cvt_pk_bf16(float lo, float hi) { unsigned r; asm volatile("v_cvt_pk_bf16_f32 %0, %1, %2" : "=v"(r) : "v"(lo), "v"(hi)); return r; }
typedef float f32x2 __attribute__((ext_vector_type(2)));
template <class Epi, class Sched, bool STAMP = false>
__device__ __forceinline__ void gemm_phase(PG8_LAS unsigned char* lds, const Gemm g, const Sched& S, const Epi& E, unsigned long long* stamps) {
    const int tid = otid(), wid = __builtin_amdgcn_readfirstlane(tid >> 6), lane = tid & 63, wr = wid >> 2, wc = wid & 3, fr = lane & 15, fq = lane >> 4;
    const int K = g.K, nt = K / BK;
    int ts_lo = 0, ts_hi = 0, nts = 0; const unsigned long long rt_entry = STAMP ? (unsigned long long)wall_clock64() : 0ull;
#define PG8_STAMP() do { if (STAMP && wid == 0 && nts < 64) { const unsigned long long _c = (unsigned long long)clock64(); \
        ts_lo = (lane == nts) ? (int)(unsigned)_c : ts_lo; ts_hi = (lane == nts) ? (int)(unsigned)(_c >> 32) : ts_hi; ++nts; } } while (0)
    PG8_STAMP();
    unsigned voffA[2], voffB[2];
#pragma unroll
    for (int i = 0; i < 2; ++i) { int R, C; stage_rc(tid * 16 + i * 8192, R, C); const int Rb = Epi::PERM ? ((R & ~31) + perm32(R & 31)) : R;
        voffA[i] = (unsigned)(R * K + C) * 2u; voffB[i] = (unsigned)(Rb * K + C) * 2u; }
    const size_t kstep = (size_t)(BK * 2);
    const size_t hstep = (size_t)HALF * K * 2;
    const size_t tstep = 2 * hstep;
    const unsigned ldsw = (unsigned)wid * 1024u;
    const int aoff = lds_byte(wr * 64 + fr, fq * 8), boff = lds_byte(wc * 32 + fr, fq * 8);
#define PG8_SA(b, h) (((b) * 2 + (h)) * HTB)
#define PG8_SB(b, h) ((4 + (b) * 2 + (h)) * HTB)
#define PG8_STAGE(bufoff, gbase, voff) do { _Pragma("unroll") for (int _i = 0; _i < 2; ++_i) \
        __builtin_amdgcn_global_load_lds((const unsigned*)((const char*)(gbase) + (voff)[_i]), (PG8_LAS unsigned*)(lds + (bufoff) + ldsw + _i * 8192), 16, 0, 0); } while (0)
#define PG8_LDA(dst, b, h) do { _Pragma("unroll") for (int m = 0; m < 4; ++m) _Pragma("unroll") for (int k = 0; k < 2; ++k) dst[m][k] = *(const PG8_LAS bf16x8*)(lds + PG8_SA(b, h) + aoff + m * 2048 + k * 1024); } while (0)
#define PG8_LDB(dst, b, h) do { _Pragma("unroll") for (int n = 0; n < 2; ++n) _Pragma("unroll") for (int k = 0; k < 2; ++k) dst[n][k] = *(const PG8_LAS bf16x8*)(lds + PG8_SB(b, h) + boff + n * 2048 + k * 1024); } while (0)
#define PG8_MMA(ai, bj, At, Bt) do { __builtin_amdgcn_s_setprio(1); _Pragma("unroll") for (int m = 0; m < 4; ++m) _Pragma("unroll") for (int n = 0; n < 2; ++n) _Pragma("unroll") for (int k = 0; k < 2; ++k) \
        acc[ai][bj][m][n] = __builtin_amdgcn_mfma_f32_16x16x32_bf16(Bt[n][k], At[m][k], acc[ai][bj][m][n], 0, 0, 0); __builtin_amdgcn_s_setprio(0); } while (0)
#define PG8_WAIT_V(n) asm volatile("s_waitcnt vmcnt(" #n ")" ::: "memory")
#define PG8_WAIT_L(n) asm volatile("s_waitcnt lgkmcnt(" #n ")" ::: "memory")
#define PG8_BAR __builtin_amdgcn_s_barrier()
#define PG8_SCHED __builtin_amdgcn_sched_barrier(0)
    Unit cur, nxt; int ui = 0;
    if (!S.next(0, cur)) return;
    f32x4 acc[2][2][4][2];
#pragma unroll
    for (int a = 0; a < 2; ++a)
#pragma unroll
        for (int b = 0; b < 2; ++b)
#pragma unroll
            for (int m = 0; m < 4; ++m)
#pragma unroll
                for (int n = 0; n < 2; ++n) acc[a][b][m][n] = (f32x4){0.f, 0.f, 0.f, 0.f};
    bf16x8 At[4][2], B0[2][2], B1[2][2];
    const char* cA = (const char*)g.A + (size_t)cur.pm * tstep; const char* cB = (const char*)g.Bt + (size_t)cur.pn * tstep;
    S.a_ready(cur);
    PG8_STAGE(PG8_SB(0, 0), cB, voffB); PG8_STAGE(PG8_SA(0, 0), cA, voffA); PG8_STAGE(PG8_SB(0, 1), cB + hstep, voffB); PG8_STAGE(PG8_SA(0, 1), cA + hstep, voffA);
    if (wr == 1) PG8_BAR;
    PG8_WAIT_V(4); PG8_BAR;
    PG8_STAGE(PG8_SB(1, 0), cB + kstep, voffB); PG8_STAGE(PG8_SA(1, 0), cA + kstep, voffA); PG8_STAGE(PG8_SB(1, 1), cB + hstep + kstep, voffB);
    PG8_WAIT_V(6); PG8_BAR;
    PG8_STAMP();
    for (;;) {
        const bool has_next = S.next(ui + 1, nxt);
        const char* nA = has_next ? (const char*)g.A + (size_t)nxt.pm * tstep : cA; const char* nB = has_next ? (const char*)g.Bt + (size_t)nxt.pn * tstep : cB;
        for (int t = 0; t < nt; t += 2) {
            const bool last = (t == nt - 2);
            const char* a1 = cA + (size_t)(t + 1) * kstep;
            const char* a2 = last ? nA : cA + (size_t)(t + 2) * kstep; const char* b2 = last ? nB : cB + (size_t)(t + 2) * kstep;
            const char* a3 = a2 + kstep; const char* b3 = b2 + kstep;
            if (last && has_next) S.a_ready(nxt);
            PG8_LDB(B0, 0, 0); PG8_SCHED; PG8_LDA(At, 0, 0); PG8_STAGE(PG8_SA(1, 1), a1 + hstep, voffA);
            PG8_WAIT_L(8); PG8_BAR; PG8_WAIT_L(0); PG8_MMA(0, 0, At, B0); PG8_BAR; PG8_SCHED;
            PG8_LDB(B1, 0, 1); PG8_STAGE(PG8_SB(0, 0), b2, voffB);
            PG8_BAR; PG8_WAIT_L(0); PG8_MMA(0, 1, At, B1); PG8_BAR;
            PG8_LDA(At, 0, 1); PG8_STAGE(PG8_SA(0, 0), a2, voffA);
            PG8_BAR; PG8_WAIT_L(0); PG8_MMA(1, 0, At, B0); PG8_BAR; PG8_SCHED;
            PG8_STAGE(PG8_SB(0, 1), b2 + hstep, voffB);
            PG8_WAIT_V(6); PG8_BAR; PG8_MMA(1, 1, At, B1); PG8_BAR;
            PG8_LDB(B0, 1, 0); PG8_SCHED; PG8_LDA(At, 1, 0); PG8_STAGE(PG8_SA(0, 1), a2 + hstep, voffA);
            PG8_WAIT_L(8); PG8_BAR; PG8_WAIT_L(0); PG8_MMA(0, 0, At, B0); PG8_BAR; PG8_SCHED;
            PG8_LDB(B1, 1, 1); PG8_STAGE(PG8_SB(1, 0), b3, voffB);
            PG8_BAR; PG8_WAIT_L(0); PG8_MMA(0, 1, At, B1); PG8_BAR;
            PG8_LDA(At, 1, 1); PG8_STAGE(PG8_SA(1, 0), a3, voffA);
            PG8_BAR; PG8_WAIT_L(0); PG8_MMA(1, 0, At, B0); PG8_BAR; PG8_SCHED;
            PG8_STAGE(PG8_SB(1, 1), b3 + hstep, voffB);
            PG8_WAIT_V(6); PG8_BAR; PG8_MMA(1, 1, At, B1); PG8_BAR;
        }
        PG8_STAMP();
        if constexpr (!Epi::AFTER_DRAIN) { E(acc, cur, wr, wc, fr, fq); S.done(cur); }
        PG8_STAMP();
        if (!has_next) break;
#pragma unroll
        for (int a = 0; a < 2; ++a)
#pragma unroll
            for (int b = 0; b < 2; ++b)
#pragma unroll
                for (int m = 0; m < 4; ++m)
#pragma unroll
                    for (int n = 0; n < 2; ++n) acc[a][b][m][n] = (f32x4){0.f, 0.f, 0.f, 0.f};
        cur = nxt; cA = nA; cB = nB; ++ui;
    }
    PG8_WAIT_V(0);
    if (wr == 0) PG8_BAR;
    PG8_BAR;
    if constexpr (Epi::AFTER_DRAIN) { E.fused(acc, cur, wr, wc, fr, fq, lds, wid, lane); S.done(cur); }
    PG8_STAMP();
    if (STAMP && wid == 0) { stamps[lane] = lane < nts ? (((unsigned long long)(unsigned)ts_hi << 32) | (unsigned)ts_lo) : 0ull;
        if (lane == 62) stamps[62] = rt_entry; if (lane == 63) stamps[63] = (unsigned long long)wall_clock64(); }
#undef PG8_STAMP
#undef PG8_SA
#undef PG8_SB
#undef PG8_STAGE
#undef PG8_LDA
#undef PG8_LDB
#undef PG8_MMA
#undef PG8_WAIT_V
#undef PG8_WAIT_L
#undef PG8_BAR
#undef PG8_SCHED
}
}

using pg8::bf16_t; using pg8::f32x4; using pg8::u32x4; using pg8::Unit;
#define LAS __attribute__((address_space(3)))
typedef unsigned u32x2 __attribute__((ext_vector_type(2)));
typedef float f32x2 __attribute__((ext_vector_type(2)));

constexpr int NT = 12288, DM = 1024, SEG = 256, NSEG = 48, NSSEG = 32, PLD = 2816, DFF = 2816;
constexpr float EPS = 1e-6f;
constexpr int LDS_BAR = 159776, LDS_BYTES = LDS_BAR + 256;

constexpr size_t WS_X     = 0;
constexpr size_t WS_HN    = WS_X + (size_t)NT * DM * 4;
constexpr size_t WS_PROJ  = WS_HN + (size_t)NT * DM * 2;
constexpr size_t WS_WIN   = WS_PROJ + (size_t)NT * PLD * 2;
constexpr size_t WS_WOUT  = WS_WIN + (size_t)2816 * 1024 * 2;
constexpr size_t WS_WGU   = WS_WOUT + (size_t)1024 * 1024 * 2;
constexpr size_t WS_WDN   = WS_WGU + (size_t)5632 * 1024 * 2;
constexpr size_t WS_WGLU  = WS_WDN + (size_t)1024 * 2816 * 2;
constexpr size_t WS_MOD   = WS_WGLU + (size_t)512 * 512 * 2;
constexpr size_t WS_OSUM  = WS_MOD + (size_t)4 * 3 * 6144 * 4;
constexpr size_t WS_YS    = WS_OSUM + (size_t)NT * 512 * 4;
constexpr size_t WS_IMG   = WS_OSUM + (size_t)NT * 1024 * 4;
constexpr size_t WS_ZG    = WS_IMG + (size_t)1536 * 81984;
constexpr size_t WS_CE    = WS_ZG + (size_t)NT * 512 * 2;
constexpr size_t CARRY_SZ = (size_t)NSSEG * 2 * 4 * 64 * 128 * 4;
constexpr size_t WS_OB    = WS_CE;
constexpr size_t WS_CP    = WS_CE + CARRY_SZ;
constexpr size_t WS_CS    = WS_CP + CARRY_SZ;
constexpr size_t WS_C2E   = WS_CS + CARRY_SZ;
constexpr size_t C2_SZ    = (size_t)NSSEG * 2 * 32 * 64 * 2 * 4;
constexpr size_t WS_C2D   = WS_C2E + C2_SZ;
constexpr size_t WS_C2S   = WS_C2D + C2_SZ;
constexpr size_t WS_BAR   = WS_C2S + C2_SZ;
constexpr size_t WS_END   = WS_BAR + 32768;

constexpr size_t OUT_Y   = 0;
constexpr size_t OUT_GLA = (size_t)NT * 1024;
constexpr size_t OUT_RG  = OUT_GLA + (size_t)16 * 2 * 2 * 4 * 64 * 128;
constexpr size_t OUT_S5  = OUT_RG + (size_t)16 * 2 * 2 * 512;
constexpr size_t OUT_DN  = OUT_S5 + (size_t)16 * 2 * 2 * 32 * 64 * 2;

struct Params { const float* in[44]; float* out; unsigned char* ws; };

typedef const __attribute__((address_space(4))) char* kptr_t;
__device__ __forceinline__ kptr_t KARG() { kptr_t k = (kptr_t)__builtin_amdgcn_kernarg_segment_ptr(); asm volatile("" : "+s"(k)); return k; }
#define AS1 __attribute__((address_space(1)))
__device__ __forceinline__ const float* PIN(int i) { const float* q = *(const float* const __attribute__((address_space(4)))*)(KARG() + i * 8); return (const float*)(const AS1 float*)q; }
__device__ __forceinline__ float* POUT() { float* q = *(float* const __attribute__((address_space(4)))*)(KARG() + 44 * 8); return (float*)(AS1 float*)q; }
__device__ __forceinline__ unsigned char* WSP(const Params& p) { unsigned char* w = *(unsigned char* const __attribute__((address_space(4)))*)(KARG() + 45 * 8); asm volatile("" : "+s"(w)); return (unsigned char*)(AS1 unsigned char*)w; }
__device__ __forceinline__ void gatomic_add(float* q, float v) { (void)__builtin_amdgcn_global_atomic_fadd_f32((AS1 float*)q, v); }
enum { I_XP = 0, I_XS, I_SGLA, I_SRG, I_SS5, I_SDN, I_C, I_CCTX, I_N1W, I_N2W, I_WMOD, I_BMOD, I_ABIN, I_ABOUT, I_WG2, I_BG, I_GLANW,
       I_RGCW, I_RGCB, I_RGWA, I_RGBA, I_RGWX, I_RGBX, I_RGLAM, I_CDIN, I_CDOUT, I_LAMRE, I_LAMIM, I_LOGDT, I_BRE, I_BIM, I_CRE, I_CIM,
       I_S5D, I_GLUW, I_GLUB, I_DNCW, I_ALOG, I_DTB, I_DNNW, I_FG, I_FU, I_FD, I_FNW };

__device__ __forceinline__ float bf2f(bf16_t b) { return __uint_as_float(((unsigned)b) << 16); }
__device__ __forceinline__ float bflo(unsigned w) { return __uint_as_float(w << 16); }
__device__ __forceinline__ float bfhi(unsigned w) { return __uint_as_float(w & 0xffff0000u); }
typedef __bf16 bf16x2_t __attribute__((ext_vector_type(2)));
__device__ __forceinline__ unsigned pk2(float lo, float hi) { f32x2 f = {lo, hi}; bf16x2_t r = __builtin_convertvector(f, bf16x2_t); return __builtin_bit_cast(unsigned, r); }
__device__ __forceinline__ unsigned f2bf(float f) { return pk2(f, 0.f) & 0xffffu; }
__device__ __forceinline__ float rdl(float v, int l) { return __int_as_float(__builtin_amdgcn_readlane(__float_as_int(v), l)); }
__device__ __forceinline__ float sigmoidf_(float x) { return __builtin_amdgcn_rcpf(1.0f + __expf(-x)); }
__device__ __forceinline__ float siluf_(float x) { return x * __builtin_amdgcn_rcpf(1.0f + __expf(-x)); }
__device__ __forceinline__ float softplusf_(float x) { return fmaxf(x, 0.f) + __logf(1.0f + __expf(-fabsf(x))); }
__device__ __forceinline__ float geluf_(float x) { return x * sigmoidf_(1.5957691216057308f * (x + 0.044715f * x * x * x)); }
__device__ __forceinline__ float wave_sum(float v) {
#pragma unroll
    for (int o = 32; o >= 1; o >>= 1) v += __shfl_xor(v, o);
    return v;
}
__device__ __forceinline__ int cv_of_tok(int t) { return t < 4096 ? 0 : 1 + ((t - 4096) >> 12); }
__device__ __forceinline__ void seq_bounds(int t, int& lo, int& hi) { if (t < 4096) { lo = t & ~255; hi = lo + 256; } else { lo = 4096 + ((t - 4096) & ~4095); hi = lo + 4096; } }

#define XB_TMO      128
#define XB_XCNT(j)  (256  + 64 * (j))
#define XB_XSUB(j)  (1280 + 64 * (j))
#define XB_XGEN(j)  (2304 + 64 * (j))
#define XB_TOP      3328
#define XB_TOPGEN   3392
#define XCD_BAR_WORDS 3456
#define XB_SPIN_CAP (1u << 18)

__device__ __forceinline__ unsigned xb_ld(unsigned* p)              { return __hip_atomic_load(p, __ATOMIC_RELAXED, __HIP_MEMORY_SCOPE_AGENT); }
__device__ __forceinline__ unsigned xb_add(unsigned* p, unsigned v) { return __hip_atomic_fetch_add(p, v, __ATOMIC_RELAXED, __HIP_MEMORY_SCOPE_AGENT); }
__device__ __forceinline__ unsigned xb_xcc_id() { return (unsigned)__builtin_amdgcn_s_getreg((3 << 11) | 20) & 0xFu; }
#define XB_SPIN(cond, bar) do { unsigned _sp = 0; while (cond) { __builtin_amdgcn_s_sleep(1); \
    if ((++_sp & 255u) == 0u) { if (xb_ld(&(bar)[XB_TMO])) break; if (_sp > XB_SPIN_CAP) { atomicAdd(&(bar)[XB_TMO], 1u); break; } } } } while (0)
struct XcdBarrier {
    unsigned* bar; unsigned x; unsigned G;
    volatile LAS unsigned* st;
};

__device__ __forceinline__ XcdBarrier xcd_barrier_post(unsigned* bar, volatile LAS unsigned* st, unsigned G) {
    XcdBarrier b; b.bar = bar; b.x = xb_xcc_id(); b.st = st; b.G = G;
    if (threadIdx.x == 0) (void)xb_add(&bar[XB_XCNT(b.x)], 1u);
    return b;
}
__device__ __forceinline__ void xcd_barrier_complete(unsigned* bar, unsigned x, unsigned G, unsigned& nloc, unsigned& nx) {
    unsigned sum, cnt, mine, sp = 0u;
    for (;;) {
        sum = 0u; cnt = 0u; mine = 0u;
#pragma unroll
        for (unsigned j = 0; j < 16; ++j) { const unsigned c = xb_ld(&bar[XB_XCNT(j)]); sum += c; cnt += (c > 0u) ? 1u : 0u; mine = (j == x) ? c : mine; }
        if (sum == G) break;
        __builtin_amdgcn_s_sleep(1);
        if ((++sp & 255u) == 0u) { if (xb_ld(&bar[XB_TMO])) break; if (sp > XB_SPIN_CAP) { atomicAdd(&bar[XB_TMO], 1u); break; } }
    }
    nloc = mine > 0u ? mine : 1u; nx = cnt > 0u ? cnt : 1u;
}

__device__ __forceinline__ void xcd_barrier(const XcdBarrier& b) {
    asm volatile("s_waitcnt vmcnt(0)" ::: "memory");
    __syncthreads();
    if (threadIdx.x == 0) {
        unsigned* bar = b.bar;
        __builtin_amdgcn_s_waitcnt(0);
        unsigned nloc = b.st[0], nx = b.st[1];
        if (nloc == 0u) { xcd_barrier_complete(bar, b.x, b.G, nloc, nx); b.st[0] = nloc; b.st[1] = nx; }
        const unsigned old = xb_add(&bar[XB_XSUB(b.x)], 1u);
        const unsigned gen = old / nloc;
        if (old + 1u == (gen + 1u) * nloc) {
            __builtin_amdgcn_fence(__ATOMIC_RELEASE, "agent");
            asm volatile("s_waitcnt vmcnt(0)" ::: "memory");
            const unsigned og = xb_add(&bar[XB_TOP], 1u);
            const unsigned tg = og / nx;
            if (og + 1u == (tg + 1u) * nx) xb_add(&bar[XB_TOPGEN], 1u);
            else XB_SPIN(xb_ld(&bar[XB_TOPGEN]) == tg, bar);
            __builtin_amdgcn_fence(__ATOMIC_ACQUIRE, "agent");
            xb_add(&bar[XB_XGEN(b.x)], 1u);
            asm volatile("s_waitcnt vmcnt(0)" ::: "memory");
        } else {
            XB_SPIN(xb_ld(&bar[XB_XGEN(b.x)]) == gen, bar);
            __builtin_amdgcn_fence(__ATOMIC_ACQUIRE, "agent");
            asm volatile("s_waitcnt vmcnt(0)" ::: "memory");
        }
    }
    __syncthreads();
}

struct EpiProj {
    static constexpr bool PERM = true, AFTER_DRAIN = false;
    bf16_t* O; int ldc;
    __device__ __forceinline__ void operator()(const f32x4 (&acc)[2][2][4][2], const Unit& u, int wr, int wc, int fr, int fq) const {
        const int row0 = u.pm * 256 + wr * 64 + fr, col0 = u.pn * 256 + wc * 32 + 8 * fq;
#pragma unroll
        for (int ai = 0; ai < 2; ++ai)
#pragma unroll
            for (int m = 0; m < 4; ++m) { bf16_t* rowp = O + (size_t)(row0 + ai * 128 + m * 16) * ldc + col0;
#pragma unroll
                for (int bj = 0; bj < 2; ++bj) { const f32x4 v0 = acc[ai][bj][m][0], v1 = acc[ai][bj][m][1];
                    u32x4 w; w.x = pk2(v0[0], v0[1]); w.y = pk2(v0[2], v0[3]); w.z = pk2(v1[0], v1[1]); w.w = pk2(v1[2], v1[3]);
                    *(u32x4*)(rowp + bj * 128) = w; } }
    }
};
struct EpiResid {
    static constexpr bool PERM = false, AFTER_DRAIN = false;
    float* X; const float* gate;
    __device__ __forceinline__ void operator()(const f32x4 (&acc)[2][2][4][2], const Unit& u, int wr, int wc, int fr, int fq) const {
        const int row0 = u.pm * 256 + wr * 64 + fr, col0 = u.pn * 256 + wc * 32 + 4 * fq;
        const int cv = u.pm < 16 ? 0 : 1 + ((u.pm - 16) >> 4);
        const float* gp = gate + cv * 6144 + col0;
        f32x4 gv[2][2];
#pragma unroll
        for (int bj = 0; bj < 2; ++bj)
#pragma unroll
            for (int n = 0; n < 2; ++n) gv[bj][n] = *(const f32x4*)(gp + bj * 128 + n * 16);
#pragma unroll
        for (int ai = 0; ai < 2; ++ai)
#pragma unroll
            for (int m = 0; m < 4; ++m) { float* rowp = X + (size_t)(row0 + ai * 128 + m * 16) * 1024 + col0;
#pragma unroll
                for (int bj = 0; bj < 2; ++bj)
#pragma unroll
                    for (int n = 0; n < 2; ++n) { f32x4* q = (f32x4*)(rowp + bj * 128 + n * 16); *q = *q + gv[bj][n] * acc[ai][bj][m][n]; } }
    }
};
struct EpiSwiGLU {
    static constexpr bool PERM = true, AFTER_DRAIN = false;
    bf16_t* O;
    __device__ __forceinline__ void operator()(const f32x4 (&acc)[2][2][4][2], const Unit& u, int wr, int wc, int fr, int fq) const {
        const int row0 = u.pm * 256 + wr * 64 + fr, col0 = u.pn * 128 + wc * 32 + 8 * fq;
#pragma unroll
        for (int ai = 0; ai < 2; ++ai)
#pragma unroll
            for (int m = 0; m < 4; ++m) { bf16_t* rowp = O + (size_t)(row0 + ai * 128 + m * 16) * DFF + col0;
                float r[8];
#pragma unroll
                for (int n = 0; n < 2; ++n)
#pragma unroll
                    for (int j = 0; j < 4; ++j) { const float g = acc[ai][0][m][n][j], up = acc[ai][1][m][n][j]; r[n * 4 + j] = g * __builtin_amdgcn_rcpf(1.0f + __expf(-g)) * up; }
                u32x4 w; w.x = pk2(r[0], r[1]); w.y = pk2(r[2], r[3]); w.z = pk2(r[4], r[5]); w.w = pk2(r[6], r[7]);
                *(u32x4*)rowp = w; }
    }
};
struct EpiGLU {
    static constexpr bool PERM = true, AFTER_DRAIN = false;
    bf16_t* O; const bf16_t* ZG; const float* bias;
    __device__ __forceinline__ void operator()(const f32x4 (&acc)[2][2][4][2], const Unit& u, int wr, int wc, int fr, int fq) const {
        const int row0 = u.pm * 256 + wr * 64 + fr, col0 = u.pn * 256 + wc * 32 + 8 * fq;
#pragma unroll
        for (int ai = 0; ai < 2; ++ai)
#pragma unroll
            for (int m = 0; m < 4; ++m) { const int row = row0 + ai * 128 + m * 16;
#pragma unroll
                for (int bj = 0; bj < 2; ++bj) { const int c = col0 + bj * 128;
                    const u32x4 z = *(const u32x4*)(ZG + (size_t)row * 512 + c);
                    const f32x4 b0 = *(const f32x4*)(bias + c), b1 = *(const f32x4*)(bias + c + 4);
                    const f32x4 v0 = acc[ai][bj][m][0] + b0, v1 = acc[ai][bj][m][1] + b1;
                    float r[8];
                    r[0] = bflo(z.x) * sigmoidf_(v0[0]); r[1] = bfhi(z.x) * sigmoidf_(v0[1]); r[2] = bflo(z.y) * sigmoidf_(v0[2]); r[3] = bfhi(z.y) * sigmoidf_(v0[3]);
                    r[4] = bflo(z.z) * sigmoidf_(v1[0]); r[5] = bfhi(z.z) * sigmoidf_(v1[1]); r[6] = bflo(z.w) * sigmoidf_(v1[2]); r[7] = bfhi(z.w) * sigmoidf_(v1[3]);
                    u32x4 w; w.x = pk2(r[0], r[1]); w.y = pk2(r[2], r[3]); w.z = pk2(r[4], r[5]); w.w = pk2(r[6], r[7]);
                    *(u32x4*)(O + (size_t)row * 1024 + c) = w; } }
    }
};

__device__ __forceinline__ void prep_mat(LAS unsigned char* lds, bf16_t* dst, int NR, int K, const float* src0, const float* src1, int ldsrc, int nvalid, int mode, int fb = 0) {
    LAS float* tl = (LAS float*)lds;
    const int tid = otid(), ntn = NR >> 6, ntk = K >> 7, ntile = ntn * ntk;
    for (int tile = obid() - fb; tile < ntile; tile += gridDim.x - fb) {
        const int n0 = (tile % ntn) * 64, k0 = (tile / ntn) * 128;
        { const int nl = tid & 63, kl0 = tid >> 6, n = n0 + nl; const float* sp = src0; int col;
          if (mode == 0) col = n < nvalid ? n : -1; else { col = ((n >> 8) << 7) + (n & 127); if ((n >> 7) & 1) sp = src1; }
          float v[16];
#pragma unroll
          for (int i = 0; i < 16; ++i) v[i] = col >= 0 ? sp[(size_t)(k0 + kl0 + 8 * i) * ldsrc + col] : 0.f;
#pragma unroll
          for (int i = 0; i < 16; ++i) tl[(kl0 + 8 * i) * 65 + nl] = v[i]; }
        __syncthreads();
        { const int nl = tid >> 3, ks = tid & 7;
#pragma unroll
          for (int h = 0; h < 2; ++h) { float v[8];
#pragma unroll
            for (int jq = 0; jq < 8; ++jq) v[jq] = tl[(h * 64 + ks * 8 + jq) * 65 + nl];
            u32x4 w; w.x = pk2(v[0], v[1]); w.y = pk2(v[2], v[3]); w.z = pk2(v[4], v[5]); w.w = pk2(v[6], v[7]);
            *(u32x4*)(dst + (size_t)(n0 + nl) * K + k0 + h * 64 + ks * 8) = w; } }
        __syncthreads();
    }
}
__device__ __forceinline__ void prep_in_out(const Params& p, LAS unsigned char* lds, int l, int fb) {
    unsigned char* ws = WSP(p); const int jl = l >> 1;
    if ((l & 1) == 0) { prep_mat(lds, (bf16_t*)(ws + WS_WIN), 2816, 1024, PIN(I_ABIN) + (size_t)jl * 1024 * 2592, nullptr, 2592, 2592, 0, fb);
                        prep_mat(lds, (bf16_t*)(ws + WS_WOUT), 1024, 1024, PIN(I_ABOUT) + (size_t)jl * 1024 * 1024, nullptr, 1024, 1024, 0, fb); }
    else { prep_mat(lds, (bf16_t*)(ws + WS_WIN), 2816, 1024, PIN(I_CDIN) + (size_t)jl * 1024 * 2576, nullptr, 2576, 2576, 0, fb);
           prep_mat(lds, (bf16_t*)(ws + WS_WOUT), 1024, 1024, PIN(I_CDOUT) + (size_t)jl * 1024 * 1024, nullptr, 1024, 1024, 0, fb); }
}
__device__ __forceinline__ void prep_rest(const Params& p, LAS unsigned char* lds, int l) {
    unsigned char* ws = WSP(p); const int jl = l >> 1;
    if (l & 1) prep_mat(lds, (bf16_t*)(ws + WS_WGLU), 512, 512, PIN(I_GLUW) + (size_t)jl * 512 * 512, nullptr, 512, 512, 0);
    prep_mat(lds, (bf16_t*)(ws + WS_WGU), 5632, 1024, PIN(I_FG) + (size_t)l * 1024 * 2816, PIN(I_FU) + (size_t)l * 1024 * 2816, 2816, 0, 1);
    prep_mat(lds, (bf16_t*)(ws + WS_WDN), 1024, 2816, PIN(I_FD) + (size_t)l * 2816 * 1024, nullptr, 1024, 1024, 0);
}
__device__ __forceinline__ void phase0(const Params& p, LAS unsigned char* lds) {
    const int tid = otid(), G = gridDim.x;
    {
        LAS float* sc = (LAS float*)lds;
        LAS float* red = (LAS float*)(lds + 16384);
        for (int i = tid; i < 3072; i += 512) { const int cv = i >> 10, k = i & 1023; const float c = cv == 0 ? PIN(I_CCTX)[k] : PIN(I_C)[(cv - 1) * 1024 + k]; sc[i] = siluf_(c); }
        __syncthreads();
        const int w = tid >> 6, lane = tid & 63;
        for (int item = obid(); item < 384; item += G) {
            const int l = item / 96, col = (item % 96) * 64 + lane;
            const float* wp = PIN(I_WMOD) + (size_t)l * 1024 * 6144 + (size_t)(w * 128) * 6144 + col;
            float a0 = 0.f, a1 = 0.f, a2 = 0.f;
#pragma unroll 8
            for (int k = 0; k < 128; ++k) { const float wv = wp[(size_t)k * 6144]; const int kk = w * 128 + k; a0 += sc[kk] * wv; a1 += sc[1024 + kk] * wv; a2 += sc[2048 + kk] * wv; }
            red[(w * 3 + 0) * 64 + lane] = a0; red[(w * 3 + 1) * 64 + lane] = a1; red[(w * 3 + 2) * 64 + lane] = a2;
            __syncthreads();
            if (tid < 192) { const int cv = tid >> 6, ln = tid & 63, c2 = (item % 96) * 64 + ln; float s = PIN(I_BMOD)[l * 6144 + c2];
#pragma unroll
                for (int ww = 0; ww < 8; ++ww) s += red[(ww * 3 + cv) * 64 + ln];
                ((float*)(WSP(p) + WS_MOD))[(l * 3 + cv) * 6144 + c2] = s; }
            __syncthreads();
        }
    }
    {
        float4* X = (float4*)(WSP(p) + WS_X);
        const float4* xp = (const float4*)PIN(I_XP); const float4* xs = (const float4*)PIN(I_XS);
        for (size_t i = (size_t)obid() * 512 + tid; i < (size_t)NT * 256; i += (size_t)G * 512) {
            const int t = (int)(i >> 8), d4 = (int)(i & 255) * 4;
            float4 v;
            if (t < 4096) v = xp[i];
            else { v = xs[i - (size_t)4096 * 256]; const int tt = (t - 4096) & 4095; const float row = (float)(tt >> 6), colf = (float)(tt & 63);
                float pe[4];
#pragma unroll
                for (int j = 0; j < 4; ++j) { const int d = d4 + j, q = d >> 8, fi = d & 255; const float fr = __expf(-9.210340371976184f * (float)fi / 256.0f);
                    const float arg = (q < 2 ? row : colf) * fr; pe[j] = (q & 1) ? cosf(arg) : sinf(arg); }
                v.x += pe[0]; v.y += pe[1]; v.z += pe[2]; v.w += pe[3]; }
            X[i] = v;
        }
    }
    prep_in_out(p, lds, 0, 0); prep_rest(p, lds, 0);
}

template <bool FINAL>
__device__ __forceinline__ void norm_phase(const float* X, const float* w, const float* shift, const float* scale, bf16_t* hn, float* yout) {
    const int lane = otid() & 63, gw = obid() * 8 + (otid() >> 6), nw = gridDim.x * 8;
    float4 vn[4];
    if (gw < NT) { const float4* xr = (const float4*)(X + (size_t)gw * 1024);
#pragma unroll
        for (int i = 0; i < 4; ++i) vn[i] = xr[i * 64 + lane]; }
    for (int row = gw; row < NT; row += nw) {
        float4 v[4]; float ss = 0.f;
#pragma unroll
        for (int i = 0; i < 4; ++i) v[i] = vn[i];
        if (row + nw < NT) { const float4* xr = (const float4*)(X + (size_t)(row + nw) * 1024);
#pragma unroll
            for (int i = 0; i < 4; ++i) vn[i] = xr[i * 64 + lane]; }
#pragma unroll
        for (int i = 0; i < 4; ++i) ss += v[i].x * v[i].x + v[i].y * v[i].y + v[i].z * v[i].z + v[i].w * v[i].w;
        ss = wave_sum(ss);
        const float rs = rsqrtf(ss * (1.0f / 1024.0f) + EPS);
        const int cv = cv_of_tok(row);
#pragma unroll
        for (int i = 0; i < 4; ++i) { const int c = i * 256 + lane * 4; const float4 wv = *(const float4*)(w + c);
            if (FINAL) { float4 o; o.x = v[i].x * rs * wv.x; o.y = v[i].y * rs * wv.y; o.z = v[i].z * rs * wv.z; o.w = v[i].w * rs * wv.w; *(float4*)(yout + (size_t)row * 1024 + c) = o; }
            else { const float4 sh = *(const float4*)(shift + cv * 6144 + c), sl = *(const float4*)(scale + cv * 6144 + c);
                u32x2 o; o.x = pk2(v[i].x * rs * wv.x * (1.f + sl.x) + sh.x, v[i].y * rs * wv.y * (1.f + sl.y) + sh.y);
                o.y = pk2(v[i].z * rs * wv.z * (1.f + sl.z) + sh.z, v[i].w * rs * wv.w * (1.f + sl.w) + sh.w);
                *(u32x2*)(hn + (size_t)row * 1024 + c) = o; } }
    }
}
__device__ __forceinline__ void zero_osum(const Params& p) {
    float4* o = (float4*)(WSP(p) + WS_YS); float zz = 0.f; asm volatile("" : "+v"(zz)); const float4 z = {zz, zz, zz, zz};
    for (size_t i = (size_t)obid() * 512 + otid(); i < (size_t)NT * 128; i += (size_t)gridDim.x * 512) o[i] = z;
}

__device__ __forceinline__ void chain_combine(const Params& p, const float* nw, int gate_col, int mix_col, int fb = 0) {
    const int lane = otid() & 63, gw = (obid() - fb) * 8 + (otid() >> 6), nwv = (gridDim.x - fb) * 8;
    const bf16_t* proj = (const bf16_t*)(WSP(p) + WS_PROJ); const float* oa = (const float*)(WSP(p) + WS_OSUM); const float* ob = (const float*)(WSP(p) + WS_OB); bf16_t* mixed = (bf16_t*)(WSP(p) + WS_HN);
    for (int tg = gw; tg < NT / 4; tg += nwv) {
#pragma unroll
        for (int hd = 0; hd < 4; ++hd) { const int c = hd * 128 + 2 * lane; const size_t o = ((size_t)tg * 512 + c) * 4;
            const f32x4 a0 = *(const f32x4*)(oa + o) + *(const f32x4*)(ob + o), a1 = *(const f32x4*)(oa + o + 4) + *(const f32x4*)(ob + o + 4);
            const float2 nw2 = *(const float2*)(nw + 2 * lane);
#pragma unroll
            for (int k = 0; k < 4; ++k) { const float ss = wave_sum(a0[k] * a0[k] + a1[k] * a1[k]); const float rs = rsqrtf(ss * (1.0f / 128.0f) + EPS); const int t = tg * 4 + k;
                const unsigned g = *(const unsigned*)(proj + (size_t)t * PLD + gate_col + c);
                *(unsigned*)(mixed + (size_t)t * 1024 + mix_col + c) = pk2(a0[k] * rs * nw2.x * siluf_(bflo(g)), a1[k] * rs * nw2.y * siluf_(bfhi(g))); } }
    }
}
__device__ __forceinline__ void ab_combine(const Params& p, int jl) { chain_combine(p, PIN(I_GLANW) + jl * 128, 1024, 0); }

__device__ __forceinline__ void lds_barrier() { asm volatile("s_waitcnt lgkmcnt(0)" ::: "memory"); __builtin_amdgcn_s_barrier(); asm volatile("" ::: "memory"); }
typedef short bf16x8_t __attribute__((ext_vector_type(8)));
__device__ __forceinline__ unsigned cvtpk(float lo, float hi) { return pk2(lo, hi); }

typedef float f32x16 __attribute__((ext_vector_type(16)));
constexpr int IMG_W = 0, IMG_QD = 17408, IMG_QK = 34816, IMG_KE = 44032, IMG_UT = 62464  , IMG_GE = 79872, IMG_STAGE = 79888, IMG_BYTES = 79888;
__device__ __forceinline__ int kact16(int j, int hh) { return j < 4 ? 4 * hh + j : 8 + 4 * hh + (j - 4); }

__device__ __forceinline__ void dn_pre(const Params& p, LAS unsigned char* lds, int jl, int which, int fb) {
    const int tid = otid(), lane = tid & 63, wave = __builtin_amdgcn_readfirstlane(tid >> 6);
    const bf16_t* proj = (const bf16_t*)(WSP(p) + WS_PROJ);
    LAS unsigned char* Qs = lds; LAS unsigned char* Ks = lds + 17408; LAS unsigned char* Vs = lds + 34816;
    LAS float* KKs = (LAS float*)(lds + 52224); LAS float* QKs = (LAS float*)(lds + 68864);
    LAS float* As = (LAS float*)(lds + 85504);
    LAS float* las = (LAS float*)(lds + 118272); LAS float* bes = las + 128; LAS float* gs = las + 256;
    LAS float* scl = las + 384;
    for (int it = obid() - fb; it < (which ? 256 : 512); it += gridDim.x - fb) {
        const int c = (which ? 0 : 64) + (it >> 2), head = it & 3, t0 = c * 64; int lo, hi; seq_bounds(t0, lo, hi);
        { const int i = tid >> 3, part = tid & 7;
          u32x4 xin[3][4][2];
#pragma unroll
          for (int ten = 0; ten < 3; ++ten)
#pragma unroll
            for (int tap = 0; tap < 4; ++tap) { const int tt = t0 + i + tap - 1; const bool ok = tt >= lo && tt < hi; const bf16_t* px = proj + (size_t)(ok ? tt : t0) * PLD + 512 + ten * 512 + head * 128 + part * 16;
                const u32x4 z4 = {0u, 0u, 0u, 0u}; xin[ten][tap][0] = ok ? *(const u32x4*)px : z4; xin[ten][tap][1] = ok ? *(const u32x4*)(px + 8) : z4; }
#pragma unroll
          for (int ten = 0; ten < 3; ++ten) { const int cb = ten * 512 + head * 128 + part * 16; float acc[16];
#pragma unroll
            for (int e = 0; e < 16; ++e) acc[e] = 0.f;
#pragma unroll
            for (int tap = 0; tap < 4; ++tap) { const u32x4 x0 = xin[ten][tap][0], x1 = xin[ten][tap][1];
                    const float* wp = PIN(I_DNCW) + (size_t)(jl * 4 + tap) * 1536 + cb; const f32x4 w0 = *(const f32x4*)wp, w1 = *(const f32x4*)(wp + 4), w2 = *(const f32x4*)(wp + 8), w3 = *(const f32x4*)(wp + 12);
                    acc[0] += w0[0] * bflo(x0.x); acc[1] += w0[1] * bfhi(x0.x); acc[2] += w0[2] * bflo(x0.y); acc[3] += w0[3] * bfhi(x0.y);
                    acc[4] += w1[0] * bflo(x0.z); acc[5] += w1[1] * bfhi(x0.z); acc[6] += w1[2] * bflo(x0.w); acc[7] += w1[3] * bfhi(x0.w);
                    acc[8] += w2[0] * bflo(x1.x); acc[9] += w2[1] * bfhi(x1.x); acc[10] += w2[2] * bflo(x1.y); acc[11] += w2[3] * bfhi(x1.y);
                    acc[12] += w3[0] * bflo(x1.z); acc[13] += w3[1] * bfhi(x1.z); acc[14] += w3[2] * bflo(x1.w); acc[15] += w3[3] * bfhi(x1.w); }
            float ss = 0.f;
#pragma unroll
            for (int e = 0; e < 16; ++e) { acc[e] = siluf_(acc[e]); ss += acc[e] * acc[e]; }
            if (ten < 2) { ss += __shfl_xor(ss, 1); ss += __shfl_xor(ss, 2); ss += __shfl_xor(ss, 4); float rs = rsqrtf(ss + 1e-6f); if (ten == 0) rs *= 0.08838834764831845f;
#pragma unroll
                for (int e = 0; e < 16; ++e) acc[e] *= rs; }
            u32x4 o0, o1; o0.x = pk2(acc[0], acc[1]); o0.y = pk2(acc[2], acc[3]); o0.z = pk2(acc[4], acc[5]); o0.w = pk2(acc[6], acc[7]);
            o1.x = pk2(acc[8], acc[9]); o1.y = pk2(acc[10], acc[11]); o1.z = pk2(acc[12], acc[13]); o1.w = pk2(acc[14], acc[15]);
            LAS unsigned char* dst = lds + ten * 17408 + i * 272 + part * 32;
            *(LAS u32x4*)dst = o0; *(LAS u32x4*)(dst + 16) = o1; }
          if (tid < 128) { const int dir = tid >> 6, ii = tid & 63; const bf16_t* pr = proj + (size_t)(t0 + ii) * PLD;
            const float ai = bf2f(pr[2560 + dir * 4 + head]), bi = bf2f(pr[2568 + dir * 4 + head]);
            las[dir * 64 + ii] = -__expf(PIN(I_ALOG)[(jl * 2 + dir) * 4 + head]) * softplusf_(ai + PIN(I_DTB)[(jl * 2 + dir) * 4 + head]);
            bes[dir * 64 + ii] = sigmoidf_(bi); } }
        __syncthreads();
        if (wave < 2) { const int dir = wave; float x = las[dir * 64 + (dir ? 63 - lane : lane)];
#pragma unroll
            for (int off = 1; off < 64; off <<= 1) { const float y = __shfl_up(x, off); if (lane >= off) x += y; }
            gs[dir * 64 + lane] = x; }
        { const int which = wave >> 2, mb = (wave >> 1) & 1, nb = wave & 1, r = lane & 31, hh = lane >> 5;
          const LAS unsigned char* Ab = (which ? Qs : Ks) + (32 * mb + r) * 272 + hh * 16; const LAS unsigned char* Bb = Ks + (32 * nb + r) * 272 + hh * 16;
          f32x16 acc;
#pragma unroll
          for (int e = 0; e < 16; ++e) acc[e] = 0.f;
#pragma unroll
          for (int ks = 0; ks < 8; ++ks) { const bf16x8_t a = *(const LAS bf16x8_t*)(Ab + ks * 32), b = *(const LAS bf16x8_t*)(Bb + ks * 32); acc = __builtin_amdgcn_mfma_f32_32x32x16_bf16(a, b, acc, 0, 0, 0); }
          LAS float* dst = which ? QKs : KKs;
#pragma unroll
          for (int e = 0; e < 16; ++e) dst[(32 * mb + (e & 3) + 8 * (e >> 2) + 4 * hh) * 65 + 32 * nb + r] = acc[e]; }
        __syncthreads();
        for (int e = tid; e < 8192; e += 512) { const int dir = e >> 12, i = (e >> 6) & 63, j = e & 63; const int pi = dir ? 63 - i : i, pj = dir ? 63 - j : j;
            As[e] = j < i ? bes[dir * 64 + pi] * KKs[pi * 65 + pj] * __expf(gs[dir * 64 + i] - gs[dir * 64 + j]) : 0.f; }
        for (int u = tid; u < 2048; u += 512) {
            const int hh = u & 1, ks = (u >> 1) & 7, i = (u >> 4) & 63, dir = u >> 10, pi = dir ? 63 - i : i; const float eg = __expf(gs[dir * 64 + i]);
            const u32x2 q0 = *(const LAS u32x2*)(Qs + pi * 272 + (16 * ks + 4 * hh) * 2), q1 = *(const LAS u32x2*)(Qs + pi * 272 + (16 * ks + 8 + 4 * hh) * 2);
            u32x4 o; o.x = pk2(bflo(q0.x) * eg, bfhi(q0.x) * eg); o.y = pk2(bflo(q0.y) * eg, bfhi(q0.y) * eg); o.z = pk2(bflo(q1.x) * eg, bfhi(q1.x) * eg); o.w = pk2(bflo(q1.y) * eg, bfhi(q1.y) * eg);
            *(u32x4*)(WSP(p) + WS_IMG + (size_t)((c * 4 + head) * 2 + dir) * IMG_BYTES + IMG_QD + i * 272 + (16 * ks + 8 * hh) * 2) = o; }
        for (int u = tid; u < 1024; u += 512) {
            const int hh = u & 1, ks = (u >> 1) & 3, i = (u >> 3) & 63, dir = u >> 9, pi = dir ? 63 - i : i; const float gi = gs[dir * 64 + i]; float v[8];
#pragma unroll
            for (int j = 0; j < 8; ++j) { const int ja = 16 * ks + kact16(j, hh), pj = dir ? 63 - ja : ja; v[j] = ja <= i ? QKs[pi * 65 + pj] * __expf(gi - gs[dir * 64 + ja]) : 0.f; }
            u32x4 o; o.x = pk2(v[0], v[1]); o.y = pk2(v[2], v[3]); o.z = pk2(v[4], v[5]); o.w = pk2(v[6], v[7]);
            *(u32x4*)(WSP(p) + WS_IMG + (size_t)((c * 4 + head) * 2 + dir) * IMG_BYTES + IMG_QK + i * 144 + (16 * ks + 8 * hh) * 2) = o; }
        for (int u = tid; u < 2048; u += 512) {
            const int k = u & 127, hh = (u >> 7) & 1, ks = (u >> 8) & 3, dir = u >> 10; const float ge = gs[dir * 64 + 63]; float v[8];
#pragma unroll
            for (int j = 0; j < 8; ++j) { const int ja = 16 * ks + kact16(j, hh), pj = dir ? 63 - ja : ja; v[j] = bf2f(*(const LAS bf16_t*)(Ks + pj * 272 + k * 2)) * __expf(ge - gs[dir * 64 + ja]); }
            u32x4 o; o.x = pk2(v[0], v[1]); o.y = pk2(v[2], v[3]); o.z = pk2(v[4], v[5]); o.w = pk2(v[6], v[7]);
            *(u32x4*)(WSP(p) + WS_IMG + (size_t)((c * 4 + head) * 2 + dir) * IMG_BYTES + IMG_KE + k * 144 + (16 * ks + 8 * hh) * 2) = o; }
        if (tid < 2) *(float*)(WSP(p) + WS_IMG + (size_t)((c * 4 + head) * 2 + tid) * IMG_BYTES + IMG_GE) = __expf(gs[tid * 64 + 63]);
        if (tid < 256) { const int i = tid & 63, w = (tid >> 6) & 1, dir = tid >> 7; const float b = bes[dir * 64 + (dir ? 63 - i : i)]; scl[tid] = w ? b * __expf(gs[dir * 64 + i]) : b; }
        __syncthreads();
        { int dir = wave >> 2; asm volatile("" : "+s"(dir)); const int part = wave & 3, isW = part >> 1, cc = (part & 1) * 64 + lane;
          const LAS float* Ad = As + dir * 4096; const LAS float* sp = scl + (dir * 2 + isW) * 64;
          const LAS unsigned char* srcp = (isW ? Ks : Vs) + cc * 2 + (dir ? 63 * 272 : 0); const int sstep = dir ? -272 : 272;
          float x[64];
#pragma unroll
          for (int i = 0; i < 64; ++i) { asm volatile("" : "+v"(srcp) :: "memory");
              float a0 = sp[i] * bf2f(*(const LAS bf16_t*)srcp), a1 = 0.f; srcp += sstep;
#pragma unroll
              for (int j4 = 0; j4 < i; j4 += 4) { const f32x4 av = *(const LAS f32x4*)(Ad + i * 64 + j4);
                  a0 -= av[0] * x[j4]; if (j4 + 1 < i) a1 -= av[1] * x[j4 + 1]; if (j4 + 2 < i) a0 -= av[2] * x[j4 + 2]; if (j4 + 3 < i) a1 -= av[3] * x[j4 + 3]; }
              x[i] = a0 + a1; }
          unsigned char* img = WSP(p) + WS_IMG + (size_t)((c * 4 + head) * 2 + dir) * IMG_BYTES;
          if (!isW) { unsigned char* ut = img + IMG_UT + cc * 136;
#pragma unroll
              for (int i = 0; i < 64; i += 4) { u32x2 o; o.x = pk2(x[i], x[i + 1]); o.y = pk2(x[i + 2], x[i + 3]); *(u32x2*)(ut + i * 2) = o; } }
          else { const int o16 = cc & 15, hh = (o16 >> 2) & 1, j = (o16 & 3) + ((o16 >> 3) << 2), pp = (cc & ~15) + 8 * hh + j; bf16_t* wp = (bf16_t*)(img + IMG_W) + pp;
#pragma unroll
              for (int i = 0; i < 64; ++i) wp[i * 136] = (bf16_t)f2bf(-x[i]); } }
        __syncthreads();
    }
}

template <int NCH, int STAGE, int BYTES, int D>
__device__ __forceinline__ void chain_loader(LAS unsigned char* lds, const unsigned char* imgbase, int c0, int cstep, int head, int dir, int lt) {
    constexpr int NCH16 = STAGE / 16, NL = (NCH16 + 255) / 256;
    asm volatile("" : "+s"(c0), "+s"(head));
    u32x4 ring[D][NL];
#pragma unroll
    for (int d = 1; d <= D; ++d) if (d < NCH) { const unsigned char* img = imgbase + (size_t)(((c0 + cstep * d) * 4 + head) * 2 + dir) * BYTES;
        const __attribute__((address_space(1))) unsigned char* gp = (const __attribute__((address_space(1))) unsigned char*)(img + lt * 16);
#pragma unroll
        for (int q = 0; q < NL; ++q) { asm volatile("" : "+v"(gp)); if ((q + 1) * 256 <= NCH16 || lt + q * 256 < NCH16) ring[d % D][q] = *(const __attribute__((address_space(1))) u32x4*)gp; gp += 4096; } }
    __syncthreads();
#pragma unroll
    for (int s = 0; s < NCH; ++s) {
        if (s + 1 < NCH) { LAS unsigned char* nb = lds + ((s + 1) & 1) * STAGE;
#pragma unroll
            for (int q = 0; q < NL; ++q) if ((q + 1) * 256 <= NCH16 || lt + q * 256 < NCH16) *(LAS u32x4*)(nb + (lt + q * 256) * 16) = ring[(s + 1) % D][q]; }
        if (s + 1 + D < NCH) { const unsigned char* img = imgbase + (size_t)(((c0 + cstep * (s + 1 + D)) * 4 + head) * 2 + dir) * BYTES;
            const __attribute__((address_space(1))) unsigned char* gp = (const __attribute__((address_space(1))) unsigned char*)(img + lt * 16);
#pragma unroll
            for (int q = 0; q < NL; ++q) { asm volatile("" : "+v"(gp)); if ((q + 1) * 256 <= NCH16 || lt + q * 256 < NCH16) ring[(s + 1) % D][q] = *(const __attribute__((address_space(1))) u32x4*)gp; gp += 4096; } }
        lds_barrier(); }
}
#define SBF(ks) __builtin_bit_cast(bf16x8_t, (u32x4){cvtpk(S[(ks) >> 1][((ks) & 1) * 8 + 0], S[(ks) >> 1][((ks) & 1) * 8 + 1]), cvtpk(S[(ks) >> 1][((ks) & 1) * 8 + 2], S[(ks) >> 1][((ks) & 1) * 8 + 3]), cvtpk(S[(ks) >> 1][((ks) & 1) * 8 + 4], S[(ks) >> 1][((ks) & 1) * 8 + 5]), cvtpk(S[(ks) >> 1][((ks) & 1) * 8 + 6], S[(ks) >> 1][((ks) & 1) * 8 + 7])})
__device__ __forceinline__ void dn_chain(const Params& p, LAS unsigned char* lds, int jl, int cfirst, int nch, int dir, int head, const float* s_init, float* s_out) {
    const int tid = otid(), lane = tid & 63, wave = __builtin_amdgcn_readfirstlane(tid >> 6), r = lane & 31, hh = lane >> 5;
    const unsigned char* imgbase = WSP(p) + WS_IMG; float* obuf = (float*)(WSP(p) + (dir ? WS_OB : WS_OSUM));
    const int cstep = dir ? -1 : 1, c0 = dir ? cfirst + nch - 1 : cfirst;
    { const unsigned char* img = imgbase + (size_t)((c0 * 4 + head) * 2 + dir) * IMG_BYTES;
      for (int q = tid; q < IMG_STAGE / 16; q += 512) *(LAS u32x4*)(lds + q * 16) = *(const u32x4*)(img + q * 16); }
    if (wave >= 4) {
        if (nch == 64) chain_loader<64, IMG_STAGE, IMG_BYTES, 2>(lds, imgbase, c0, cstep, head, dir, tid - 256); else chain_loader<4, IMG_STAGE, IMG_BYTES, 2>(lds, imgbase, c0, cstep, head, dir, tid - 256);
    } else {
        f32x16 S[4];
        const int col = wave * 32 + r;
        { const float* sp = s_init ? s_init + (4 * hh) * 128 + col : nullptr;
#pragma unroll
          for (int mb = 0; mb < 4; ++mb)
#pragma unroll
            for (int m = 0; m < 4; ++m) { asm volatile("" : "+v"(sp));
#pragma unroll
                for (int rr = 0; rr < 4; ++rr) S[mb][4 * m + rr] = sp ? sp[rr * 128] : 0.f;
                if (sp) sp += 8 * 128; } }
        __syncthreads();
        for (int s = 0; s < nch; ++s) {
            { const int cidx = c0 + cstep * s;
                LAS unsigned char* buf = lds + (s & 1) * IMG_STAGE;
                bf16x8_t sb[8];
#pragma unroll
                for (int ks = 0; ks < 8; ++ks) sb[ks] = SBF(ks);
                f32x16 Wn[2];
#pragma unroll
                for (int mb = 0; mb < 2; ++mb)
#pragma unroll
                    for (int m = 0; m < 4; ++m) { const u32x2 uv = *(const LAS u32x2*)(buf + IMG_UT + col * 136 + (32 * mb + 8 * m + 4 * hh) * 2);
                        Wn[mb][4 * m + 0] = bflo(uv.x); Wn[mb][4 * m + 1] = bfhi(uv.x); Wn[mb][4 * m + 2] = bflo(uv.y); Wn[mb][4 * m + 3] = bfhi(uv.y); }
                const float ge = *(const LAS float*)(buf + IMG_GE);
                asm volatile("" ::: "memory");
#pragma unroll
                for (int mb = 0; mb < 2; ++mb) { bf16x8_t af[8];
#pragma unroll
                    for (int ks = 0; ks < 8; ++ks) af[ks] = *(const LAS bf16x8_t*)(buf + IMG_W + (32 * mb + r) * 272 + (16 * ks + 8 * hh) * 2);
#pragma unroll
                    for (int ks = 0; ks < 8; ++ks) Wn[mb] = __builtin_amdgcn_mfma_f32_32x32x16_bf16(af[ks], sb[ks], Wn[mb], 0, 0, 0);
                    asm volatile("" ::: "memory"); }
                bf16x8_t wb[4];
#pragma unroll
                for (int ks = 0; ks < 4; ++ks) { u32x4 w; const int mb = ks >> 1, h8 = (ks & 1) * 8;
                    w.x = cvtpk(Wn[mb][h8 + 0], Wn[mb][h8 + 1]); w.y = cvtpk(Wn[mb][h8 + 2], Wn[mb][h8 + 3]); w.z = cvtpk(Wn[mb][h8 + 4], Wn[mb][h8 + 5]); w.w = cvtpk(Wn[mb][h8 + 6], Wn[mb][h8 + 7]); wb[ks] = __builtin_bit_cast(bf16x8_t, w); }
#pragma unroll
                for (int mb = 0; mb < 2; ++mb) { f32x16 O; asm volatile("" ::: "memory");
                    bf16x8_t af[8], ag[4];
#pragma unroll
                    for (int ks = 0; ks < 8; ++ks) af[ks] = *(const LAS bf16x8_t*)(buf + IMG_QD + (32 * mb + r) * 272 + (16 * ks + 8 * hh) * 2);
#pragma unroll
                    for (int ks = 0; ks < 4; ++ks) ag[ks] = *(const LAS bf16x8_t*)(buf + IMG_QK + (32 * mb + r) * 144 + (16 * ks + 8 * hh) * 2);
#pragma unroll
                    for (int e = 0; e < 16; ++e) O[e] = 0.f;
#pragma unroll
                    for (int ks = 0; ks < 8; ++ks) O = __builtin_amdgcn_mfma_f32_32x32x16_bf16(af[ks], sb[ks], O, 0, 0, 0);
#pragma unroll
                    for (int ks = 0; ks < 4; ++ks) O = __builtin_amdgcn_mfma_f32_32x32x16_bf16(ag[ks], wb[ks], O, 0, 0, 0);
#pragma unroll
                for (int m = 0; m < 4; ++m) { const int g4 = 8 * mb + 2 * m + hh, tg = cidx * 16 + (dir ? 15 - g4 : g4);
                    f32x4 ov; if (dir) { ov[0] = O[4 * m + 3]; ov[1] = O[4 * m + 2]; ov[2] = O[4 * m + 1]; ov[3] = O[4 * m + 0]; } else { ov[0] = O[4 * m + 0]; ov[1] = O[4 * m + 1]; ov[2] = O[4 * m + 2]; ov[3] = O[4 * m + 3]; }
                    *(f32x4*)(obuf + ((size_t)tg * 512 + head * 128 + col) * 4) = ov; } }
#pragma unroll
                for (int mp = 0; mp < 2; ++mp) { asm volatile("" ::: "memory"); bf16x8_t af[8];
#pragma unroll
                    for (int q = 0; q < 8; ++q) af[q] = *(const LAS bf16x8_t*)(buf + IMG_KE + (32 * (2 * mp + (q >> 2)) + r) * 144 + (16 * (q & 3) + 8 * hh) * 2);
#pragma unroll
                    for (int q = 0; q < 2; ++q) { const int mb = 2 * mp + q;
#pragma unroll
                        for (int e = 0; e < 16; ++e) S[mb][e] *= ge;
#pragma unroll
                        for (int ks = 0; ks < 4; ++ks) S[mb] = __builtin_amdgcn_mfma_f32_32x32x16_bf16(af[4 * q + ks], wb[ks], S[mb], 0, 0, 0); } }
                lds_barrier(); } }
        if (s_out) {
            float* sp = s_out + (4 * hh) * 128 + col;
#pragma unroll
            for (int mb = 0; mb < 4; ++mb)
#pragma unroll
                for (int m = 0; m < 4; ++m) { asm volatile("" : "+v"(sp));
#pragma unroll
                    for (int rr = 0; rr < 4; ++rr) sp[rr * 128] = S[mb][4 * m + rr];
                    sp += 8 * 128; }
        }
    }
}

template <bool PASSB>
__device__ __forceinline__ void s5_task(const Params& p, LAS unsigned char* lds, int jl, int seg, int dir, int g) {
    const int lane = otid() & 63, wave = __builtin_amdgcn_readfirstlane(otid() >> 6), r = lane & 31, hh = lane >> 5;
    const bf16_t* proj = (const bf16_t*)(WSP(p) + WS_PROJ); float* osum = (float*)(WSP(p) + WS_YS);
    LAS unsigned char* Us = lds + wave * 19456;
    LAS unsigned char* Ht = Us + 2048;
    LAS unsigned char* Cms = Us + 2048 + 9216;
    const float dtv = __expf(PIN(I_LOGDT)[(jl * 2 + dir) * 32 + g]);
    float a1r[2], a1i[2], a4r[2], a4i[2], hcr[2], hci[2];
    bf16x8_t bbr[2], bbi[2];
#pragma unroll
    for (int sh = 0; sh < 2; ++sh) { const int st = 32 * sh + r, pi = ((jl * 2 + dir) * 32 + g) * 64 + st;
        const float lre = PIN(I_LAMRE)[pi], lim = PIN(I_LAMIM)[pi]; const float xr = lre * dtv, xi = lim * dtv; float sn, cs; sincosf(xi, &sn, &cs);
        const float ea = __expf(xr), ar = ea * cs, ai = ea * sn;
        const float sh2 = sinf(0.5f * xi); const float nr = expm1f(xr) * cs - 2.0f * sh2 * sh2, ni = ai;
        const float den = 1.0f / (lre * lre + lim * lim); const float cr = (nr * lre + ni * lim) * den, ci = (ni * lre - nr * lim) * den;
        a1r[sh] = ar; a1i[sh] = ai; { const float b2r = ar * ar - ai * ai, b2i = 2.f * ar * ai; a4r[sh] = b2r * b2r - b2i * b2i; a4i[sh] = 2.f * b2r * b2i; }
        { const float* bre = PIN(I_BRE) + (size_t)pi * 16 + 8 * hh; const float* bim = PIN(I_BIM) + (size_t)pi * 16 + 8 * hh; float vr[8], vi[8];
#pragma unroll
          for (int j = 0; j < 8; ++j) { vr[j] = cr * bre[j] - ci * bim[j]; vi[j] = cr * bim[j] + ci * bre[j]; }
          u32x4 w; w.x = pk2(vr[0], vr[1]); w.y = pk2(vr[2], vr[3]); w.z = pk2(vr[4], vr[5]); w.w = pk2(vr[6], vr[7]); bbr[sh] = __builtin_bit_cast(bf16x8_t, w);
          w.x = pk2(vi[0], vi[1]); w.y = pk2(vi[2], vi[3]); w.z = pk2(vi[4], vi[5]); w.w = pk2(vi[6], vi[7]); bbi[sh] = __builtin_bit_cast(bf16x8_t, w); }
        hcr[sh] = 0.f; hci[sh] = 0.f;
        if (PASSB && seg >= 16) { const int sseg = seg - 16, b = sseg >> 4, j = sseg & 15;
            const float er = __expf(256.0f * xr); double ph = 256.0 * ((double)lim * (double)dtv); ph -= 6.283185307179586 * rint(ph * 0.15915494309189535);
            float s2, c2; sincosf((float)ph, &s2, &c2); const float a2r_ = er * c2, a2i_ = er * s2;
            const float2 s0 = *(const float2*)(PIN(I_SS5) + ((size_t)(((b * 2 + jl) * 2 + dir) * 32 + g) * 64 + st) * 2); float hr = s0.x, hi = s0.y;
            const int nst = dir ? 15 - j : j; float2 ev[15];
#pragma unroll
            for (int q = 0; q < 15; ++q) { const int sj = b * 16 + (dir ? 15 - q : q); ev[q] = q < nst ? ((const float2*)(WSP(p) + WS_C2E))[((sj * 2 + dir) * 32 + g) * 64 + st] : make_float2(0.f, 0.f); }
#pragma unroll
            for (int q = 0; q < 15; ++q) if (q < nst) { const float nhr = a2r_ * hr - a2i_ * hi + ev[q].x, nhi = a2r_ * hi + a2i_ * hr + ev[q].y; hr = nhr; hi = nhi; }
            hcr[sh] = hr; hci[sh] = hi; } }
    if (PASSB) {
        asm volatile("s_waitcnt lgkmcnt(0)" ::: "memory"); __builtin_amdgcn_wave_barrier();
#pragma unroll
        for (int sh = 0; sh < 2; ++sh)
#pragma unroll
            for (int ks = 0; ks < 4; ++ks) { float v[8];
                const float* src = PIN((ks >> 1) ? I_CIM : I_CRE) + ((size_t)((jl * 2 + dir) * 32 + g) * 16 + (r & 15)) * 64 + 32 * sh + ((16 * ks + 8 * hh) & 31); const float sg = (ks >> 1) ? -1.f : 1.f;
                const f32x4 s0 = *(const f32x4*)src, s1 = *(const f32x4*)(src + 4);
                v[0] = s0[0]; v[1] = s0[1]; v[2] = s0[2]; v[3] = s0[3]; v[4] = s1[0]; v[5] = s1[1]; v[6] = s1[2]; v[7] = s1[3];
#pragma unroll
                for (int j = 0; j < 8; ++j) v[j] = r < 16 ? sg * v[j] : 0.f;
                u32x4 w; w.x = pk2(v[0], v[1]); w.y = pk2(v[2], v[3]); w.z = pk2(v[4], v[5]); w.w = pk2(v[6], v[7]);
                *(LAS u32x4*)(Cms + ((sh * 4 + ks) * 64 + lane) * 16) = w; }
    }
    const int base = seg * SEG;
    u32x4 nu0, nu1; { const int t = dir ? base + SEG - 1 - lane : base + lane; const bf16_t* pu = proj + (size_t)t * PLD + g * 16; nu0 = *(const u32x4*)pu; nu1 = *(const u32x4*)(pu + 8); }
#pragma unroll 1
    for (int c = 0; c < 4; ++c) {
        asm volatile("s_waitcnt lgkmcnt(0)" ::: "memory"); __builtin_amdgcn_wave_barrier();
        *(LAS u32x4*)(Us + lane * 32) = nu0; *(LAS u32x4*)(Us + lane * 32 + 16) = nu1;
        if (c + 1 < 4) { const int i = 64 * (c + 1) + lane, t = dir ? base + SEG - 1 - i : base + i; const bf16_t* pu = proj + (size_t)t * PLD + g * 16; nu0 = *(const u32x4*)pu; nu1 = *(const u32x4*)(pu + 8); }
        asm volatile("s_waitcnt lgkmcnt(0)" ::: "memory"); __builtin_amdgcn_wave_barrier();
        const bf16x8_t ua0 = *(const LAS bf16x8_t*)(Us + r * 32 + hh * 16), ua1 = *(const LAS bf16x8_t*)(Us + (32 + r) * 32 + hh * 16);
        f32x16 Y[2];
        if (PASSB) {
#pragma unroll
            for (int e = 0; e < 16; ++e) { Y[0][e] = 0.f; Y[1][e] = 0.f; } }
#pragma unroll
        for (int sh = 0; sh < 2; ++sh) {
            f32x16 Xr[2], Xi[2];
#pragma unroll
            for (int e = 0; e < 16; ++e) { Xr[0][e] = 0.f; Xr[1][e] = 0.f; Xi[0][e] = 0.f; Xi[1][e] = 0.f; }
            Xr[0] = __builtin_amdgcn_mfma_f32_32x32x16_bf16(ua0, bbr[sh], Xr[0], 0, 0, 0); Xr[1] = __builtin_amdgcn_mfma_f32_32x32x16_bf16(ua1, bbr[sh], Xr[1], 0, 0, 0);
            Xi[0] = __builtin_amdgcn_mfma_f32_32x32x16_bf16(ua0, bbi[sh], Xi[0], 0, 0, 0); Xi[1] = __builtin_amdgcn_mfma_f32_32x32x16_bf16(ua1, bbi[sh], Xi[1], 0, 0, 0);
            const float ar = a1r[sh], ai = a1i[sh];
            float eor[8], eoi[8];
#pragma unroll
            for (int q = 0; q < 8; ++q) { const int mb = q >> 2, e0 = 4 * (q & 3);
#pragma unroll
                for (int k = 1; k < 4; ++k) { const float pr_ = Xr[mb][e0 + k - 1], pi_ = Xi[mb][e0 + k - 1]; Xr[mb][e0 + k] += ar * pr_ - ai * pi_; Xi[mb][e0 + k] += ar * pi_ + ai * pr_; }
                eor[q] = Xr[mb][e0 + 3]; eoi[q] = Xi[mb][e0 + 3]; }
            float cwr[8], cwi[8]; float cr_ = hcr[sh], ci_ = hci[sh]; const float qr = a4r[sh], qi = a4i[sh];
#pragma unroll
            for (int q = 0; q < 8; ++q) { const float epr = __shfl_xor(eor[q], 32), epi = __shfl_xor(eoi[q], 32);
                const float ear = hh ? epr : eor[q], eai = hh ? epi : eoi[q], ebr = hh ? eor[q] : epr, ebi = hh ? eoi[q] : epi;
                const float odr = qr * cr_ - qi * ci_ + ear, odi = qr * ci_ + qi * cr_ + eai;
                cwr[q] = hh ? odr : cr_; cwi[q] = hh ? odi : ci_;
                const float nr_ = qr * odr - qi * odi + ebr, ni_ = qr * odi + qi * odr + ebi; cr_ = nr_; ci_ = ni_; }
            hcr[sh] = cr_; hci[sh] = ci_;
            if (PASSB) {
                const float a2r_s = ar * ar - ai * ai, a2i_s = 2.f * ar * ai, a3r_s = a2r_s * ar - a2i_s * ai, a3i_s = a2r_s * ai + a2i_s * ar;
#pragma unroll
                for (int q = 0; q < 8; ++q) { const int mb = q >> 2, m = q & 3, e0 = 4 * m; const float wr = cwr[q], wi = cwi[q];
                    const float h0r = Xr[mb][e0 + 0] + (a1r[sh] * wr - a1i[sh] * wi), h0i = Xi[mb][e0 + 0] + (a1r[sh] * wi + a1i[sh] * wr);
                    const float h1r = Xr[mb][e0 + 1] + (a2r_s * wr - a2i_s * wi), h1i = Xi[mb][e0 + 1] + (a2r_s * wi + a2i_s * wr);
                    const float h2r = Xr[mb][e0 + 2] + (a3r_s * wr - a3i_s * wi), h2i = Xi[mb][e0 + 2] + (a3r_s * wi + a3i_s * wr);
                    const float h3r = Xr[mb][e0 + 3] + (a4r[sh] * wr - a4i[sh] * wi), h3i = Xi[mb][e0 + 3] + (a4r[sh] * wi + a4i[sh] * wr);
                    LAS unsigned char* hp = Ht + (32 * mb + 8 * m + 4 * hh) * 144 + r * 2;
                    *(LAS bf16_t*)(hp) = (bf16_t)f2bf(h0r); *(LAS bf16_t*)(hp + 64) = (bf16_t)f2bf(h0i);
                    *(LAS bf16_t*)(hp + 144) = (bf16_t)f2bf(h1r); *(LAS bf16_t*)(hp + 144 + 64) = (bf16_t)f2bf(h1i);
                    *(LAS bf16_t*)(hp + 288) = (bf16_t)f2bf(h2r); *(LAS bf16_t*)(hp + 288 + 64) = (bf16_t)f2bf(h2i);
                    *(LAS bf16_t*)(hp + 432) = (bf16_t)f2bf(h3r); *(LAS bf16_t*)(hp + 432 + 64) = (bf16_t)f2bf(h3i); }
                asm volatile("s_waitcnt lgkmcnt(0)" ::: "memory"); __builtin_amdgcn_wave_barrier();
#pragma unroll
                for (int ks = 0; ks < 4; ++ks) { const bf16x8_t cmk = *(const LAS bf16x8_t*)(Cms + ((sh * 4 + ks) * 64 + lane) * 16);
#pragma unroll
                    for (int nb = 0; nb < 2; ++nb) { const bf16x8_t b = *(const LAS bf16x8_t*)(Ht + (32 * nb + r) * 144 + (16 * ks + 8 * hh) * 2); Y[nb] = __builtin_amdgcn_mfma_f32_32x32x16_bf16(cmk, b, Y[nb], 0, 0, 0); } }
                asm volatile("s_waitcnt lgkmcnt(0)" ::: "memory"); __builtin_amdgcn_wave_barrier();
            }
        }
        if (PASSB) {
            LAS float* Ys = (LAS float*)Ht;
#pragma unroll
            for (int nb = 0; nb < 2; ++nb)
#pragma unroll
                for (int e = 0; e < 8; ++e) Ys[(32 * nb + r) * 17 + (e & 3) + 8 * (e >> 2) + 4 * hh] = Y[nb][e];
            asm volatile("s_waitcnt lgkmcnt(0)" ::: "memory"); __builtin_amdgcn_wave_barrier();
            const int jj = lane & 15, ts = lane >> 4;
#pragma unroll
            for (int q = 0; q < 16; ++q) { const int i = 64 * c + 4 * q + ts, t = dir ? base + SEG - 1 - i : base + i;
                gatomic_add(osum + (size_t)t * 512 + g * 16 + jj, Ys[(4 * q + ts) * 17 + jj]); }
        }
    }
    if (hh == 0) {
#pragma unroll
        for (int sh = 0; sh < 2; ++sh) { const int st = 32 * sh + r; float2 e; e.x = hcr[sh]; e.y = hci[sh];
            if (!PASSB) ((float2*)(WSP(p) + WS_C2E))[(((seg - 16) * 2 + dir) * 32 + g) * 64 + st] = e;
            else if (seg < 16) ((float2*)(POUT() + OUT_S5))[(((seg * 2 + jl) * 2 + dir) * 32 + g) * 64 + st] = e; } }
}

constexpr int G_QD = 0, G_ATT = 9216, G_KE = 18432, G_DEC = 27648, G_VT = 27904, G_STAGE = 49152, G_BYTES = 49152;
__device__ __forceinline__ int pinv16(int x) { const int o = x & 15; return (x & ~15) + 8 * ((o >> 2) & 1) + (o & 3) + ((o >> 3) << 2); }

__device__ __forceinline__ void gla_pre(const Params& p, LAS unsigned char* lds, int jl, int which, int fb) {
    const int tid = otid(), lane = tid & 63, wave = __builtin_amdgcn_readfirstlane(tid >> 6);
    const bf16_t* proj = (const bf16_t*)(WSP(p) + WS_PROJ);
    LAS unsigned char* Qs = lds; LAS unsigned char* Ks = lds + 9216; LAS unsigned char* Vs = lds + 18432;
    LAS float* bs = (LAS float*)(lds + 35840);
    LAS unsigned char* QDs = lds + 69120;
    LAS unsigned char* KIs = lds + 87552;
    LAS float* wgs = (LAS float*)(lds + 105984);
    const int head = obid() & 3;
    for (int e = tid; e < 2048; e += 512) { const int dir = e >> 10, r = (e >> 6) & 15, k = e & 63; wgs[e] = PIN(I_WG2)[((size_t)(jl * 2 + dir) * 16 + r) * 256 + head * 64 + k]; }
    if (tid < 128) wgs[2048 + tid] = PIN(I_BG)[(jl * 2 + (tid >> 6)) * 256 + head * 64 + (tid & 63)];
    __syncthreads();
    for (int it = obid() - fb; it < (which ? 256 : 512); it += gridDim.x - fb) {
        const int c = (which ? 0 : 64) + (it >> 2), t0 = c * 64;
        { const int i = tid >> 3, part = tid & 7; const bf16_t* pr = proj + (size_t)(t0 + i) * PLD;
          const u32x4 qv = *(const u32x4*)(pr + head * 64 + part * 8), kv = *(const u32x4*)(pr + 256 + head * 64 + part * 8);
          const u32x4 v0 = *(const u32x4*)(pr + 512 + head * 128 + part * 16), v1 = *(const u32x4*)(pr + 512 + head * 128 + part * 16 + 8);
          *(LAS u32x4*)(Qs + i * 144 + part * 16) = qv; *(LAS u32x4*)(Ks + i * 144 + part * 16) = kv;
          *(LAS u32x4*)(Vs + i * 272 + part * 32) = v0; *(LAS u32x4*)(Vs + i * 272 + part * 32 + 16) = v1;
#pragma unroll
          for (int dir = 0; dir < 2; ++dir) { const u32x4 l0 = *(const u32x4*)(pr + 1536 + dir * 16), l1 = *(const u32x4*)(pr + 1536 + dir * 16 + 8);
              float lr[16]; lr[0] = bflo(l0.x); lr[1] = bfhi(l0.x); lr[2] = bflo(l0.y); lr[3] = bfhi(l0.y); lr[4] = bflo(l0.z); lr[5] = bfhi(l0.z); lr[6] = bflo(l0.w); lr[7] = bfhi(l0.w);
              lr[8] = bflo(l1.x); lr[9] = bfhi(l1.x); lr[10] = bflo(l1.y); lr[11] = bfhi(l1.y); lr[12] = bflo(l1.z); lr[13] = bfhi(l1.z); lr[14] = bflo(l1.w); lr[15] = bfhi(l1.w);
              const int il = dir ? 63 - i : i;
#pragma unroll
              for (int kk = 0; kk < 8; ++kk) { const int k = part * 8 + kk; float pre = wgs[2048 + dir * 64 + k];
#pragma unroll
                  for (int r = 0; r < 16; ++r) pre += lr[r] * wgs[(dir * 16 + r) * 64 + k];
                  bs[(dir * 64 + il) * 65 + k] = (fminf(pre, 0.f) - __logf(1.0f + __expf(-fabsf(pre)))) * (1.0f / 16.0f); } } }
        __syncthreads();
#pragma unroll 1
        for (int s = 0; s < 16; ++s) { const int dk = wave * 16 + s, dir = dk >> 6, k = dk & 63; float x = bs[(dir * 64 + lane) * 65 + k];
#pragma unroll
            for (int off = 1; off < 64; off <<= 1) { const float y = __shfl_up(x, off); if (lane >= off) x += y; }
            bs[(dir * 64 + lane) * 65 + k] = x; }
        __syncthreads();
        for (int u = tid; u < 1024; u += 512) { const int k8 = u & 7, i = (u >> 3) & 63, dir = u >> 9, pi = dir ? 63 - i : i;
            const u32x4 qv = *(const LAS u32x4*)(Qs + pi * 144 + k8 * 16), kv = *(const LAS u32x4*)(Ks + pi * 144 + k8 * 16); const LAS float* bp = bs + (dir * 64 + i) * 65 + k8 * 8;
            float e[8];
#pragma unroll
            for (int j = 0; j < 8; ++j) e[j] = __expf(bp[j]);
            u32x4 o; o.x = pk2(bflo(qv.x) * 0.125f * e[0], bfhi(qv.x) * 0.125f * e[1]); o.y = pk2(bflo(qv.y) * 0.125f * e[2], bfhi(qv.y) * 0.125f * e[3]);
            o.z = pk2(bflo(qv.z) * 0.125f * e[4], bfhi(qv.z) * 0.125f * e[5]); o.w = pk2(bflo(qv.w) * 0.125f * e[6], bfhi(qv.w) * 0.125f * e[7]);
            *(LAS u32x4*)(QDs + dir * 9216 + i * 144 + k8 * 16) = o;
            o.x = pk2(bflo(kv.x) / e[0], bfhi(kv.x) / e[1]); o.y = pk2(bflo(kv.y) / e[2], bfhi(kv.y) / e[3]); o.z = pk2(bflo(kv.z) / e[4], bfhi(kv.z) / e[5]); o.w = pk2(bflo(kv.w) / e[6], bfhi(kv.w) / e[7]);
            *(LAS u32x4*)(KIs + dir * 9216 + i * 144 + k8 * 16) = o; }
        __syncthreads();
        { const int dir = wave >> 2, mb = (wave >> 1) & 1, nb = wave & 1, r = lane & 31, hh = lane >> 5;
          f32x16 acc;
#pragma unroll
          for (int e = 0; e < 16; ++e) acc[e] = 0.f;
          if (nb <= mb) {
#pragma unroll
              for (int ks = 0; ks < 4; ++ks) { const bf16x8_t a = *(const LAS bf16x8_t*)(QDs + dir * 9216 + (32 * mb + r) * 144 + (16 * ks + 8 * hh) * 2), b = *(const LAS bf16x8_t*)(KIs + dir * 9216 + (32 * nb + r) * 144 + (16 * ks + 8 * hh) * 2);
                  acc = __builtin_amdgcn_mfma_f32_32x32x16_bf16(a, b, acc, 0, 0, 0); } }
          unsigned char* img = WSP(p) + WS_IMG + (size_t)((c * 4 + head) * 2 + dir) * G_BYTES; const int j = 32 * nb + r; bf16_t* ap = (bf16_t*)(img + G_ATT) + pinv16(j);
#pragma unroll
          for (int e = 0; e < 16; ++e) { const int i = 32 * mb + (e & 3) + 8 * (e >> 2) + 4 * hh; ap[i * 72] = (bf16_t)f2bf(j <= i ? acc[e] : 0.f); } }
        for (int u = tid; u < 1024; u += 512) {
            const int hh = u & 1, ks = (u >> 1) & 3, i = (u >> 3) & 63, dir = u >> 9;
            const u32x2 a = *(const LAS u32x2*)(QDs + dir * 9216 + i * 144 + (16 * ks + 4 * hh) * 2), b = *(const LAS u32x2*)(QDs + dir * 9216 + i * 144 + (16 * ks + 8 + 4 * hh) * 2);
            u32x4 o; o.x = a.x; o.y = a.y; o.z = b.x; o.w = b.y;
            *(u32x4*)(WSP(p) + WS_IMG + (size_t)((c * 4 + head) * 2 + dir) * G_BYTES + G_QD + i * 144 + (16 * ks + 8 * hh) * 2) = o; }
        for (int u = tid; u < 1024; u += 512) {
            const int k = u & 63, hh = (u >> 6) & 1, ks = (u >> 7) & 3, dir = u >> 9; const float be = bs[(dir * 64 + 63) * 65 + k]; float v[8];
#pragma unroll
            for (int j = 0; j < 8; ++j) { const int ja = 16 * ks + kact16(j, hh), pj = dir ? 63 - ja : ja; v[j] = bf2f(*(const LAS bf16_t*)(Ks + pj * 144 + k * 2)) * __expf(be - bs[(dir * 64 + ja) * 65 + k]); }
            u32x4 o; o.x = pk2(v[0], v[1]); o.y = pk2(v[2], v[3]); o.z = pk2(v[4], v[5]); o.w = pk2(v[6], v[7]);
            *(u32x4*)(WSP(p) + WS_IMG + (size_t)((c * 4 + head) * 2 + dir) * G_BYTES + G_KE + k * 144 + (16 * ks + 8 * hh) * 2) = o; }
        for (int u = tid; u < 2048; u += 512) {
            const int n = u & 127, hh = (u >> 7) & 1, ks = (u >> 8) & 3, dir = u >> 10; unsigned short v[8];
#pragma unroll
            for (int j = 0; j < 8; ++j) { const int ja = 16 * ks + kact16(j, hh), pj = dir ? 63 - ja : ja; v[j] = *(const LAS bf16_t*)(Vs + pj * 272 + n * 2); }
            u32x4 o; o.x = v[0] | ((unsigned)v[1] << 16); o.y = v[2] | ((unsigned)v[3] << 16); o.z = v[4] | ((unsigned)v[5] << 16); o.w = v[6] | ((unsigned)v[7] << 16);
            *(u32x4*)(WSP(p) + WS_IMG + (size_t)((c * 4 + head) * 2 + dir) * G_BYTES + G_VT + n * 144 + (16 * ks + 8 * hh) * 2) = o; }
        if (tid < 128) { const int dir = tid >> 6, k = tid & 63; *(float*)(WSP(p) + WS_IMG + (size_t)((c * 4 + head) * 2 + dir) * G_BYTES + G_DEC + k * 4) = __expf(bs[(dir * 64 + 63) * 65 + k]); }
        __syncthreads();
    }
}

__device__ __forceinline__ void gla_chain(const Params& p, LAS unsigned char* lds, int cfirst, int nch, int dir, int head, const float* s_init, float* s_out) {
    const int tid = otid(), lane = tid & 63, wave = __builtin_amdgcn_readfirstlane(tid >> 6), r = lane & 31, hh = lane >> 5;
    const unsigned char* imgbase = WSP(p) + WS_IMG; float* obuf = (float*)(WSP(p) + (dir ? WS_OB : WS_OSUM));
    const int cstep = dir ? -1 : 1, c0 = dir ? cfirst + nch - 1 : cfirst;
    { const unsigned char* img = imgbase + (size_t)((c0 * 4 + head) * 2 + dir) * G_BYTES;
      for (int q = tid; q < G_STAGE / 16; q += 512) *(LAS u32x4*)(lds + q * 16) = *(const u32x4*)(img + q * 16); }
    if (wave >= 4) {
        if (nch == 64) chain_loader<64, G_STAGE, G_BYTES, 4>(lds, imgbase, c0, cstep, head, dir, tid - 256); else chain_loader<4, G_STAGE, G_BYTES, 4>(lds, imgbase, c0, cstep, head, dir, tid - 256);
    } else {
        f32x16 S[2];
        const int col = wave * 32 + r;
        { const float* sp = s_init ? s_init + (4 * hh) * 128 + col : nullptr;
#pragma unroll
          for (int mb = 0; mb < 2; ++mb)
#pragma unroll
            for (int m = 0; m < 4; ++m) { asm volatile("" : "+v"(sp));
#pragma unroll
                for (int rr = 0; rr < 4; ++rr) S[mb][4 * m + rr] = sp ? sp[rr * 128] : 0.f;
                if (sp) sp += 8 * 128; } }
        __syncthreads();
        for (int s = 0; s < nch; ++s) {
            const int cidx = c0 + cstep * s;
            LAS unsigned char* buf = lds + (s & 1) * G_STAGE;
            bf16x8_t vb[4];
#pragma unroll
            for (int ks = 0; ks < 4; ++ks) vb[ks] = *(const LAS bf16x8_t*)(buf + G_VT + col * 144 + (16 * ks + 8 * hh) * 2);
#pragma unroll
            for (int mb = 0; mb < 2; ++mb) { f32x16 O; asm volatile("" ::: "memory");
                bf16x8_t af[8];
#pragma unroll
                for (int ks = 0; ks < 4; ++ks) { af[ks] = *(const LAS bf16x8_t*)(buf + G_QD + (32 * mb + r) * 144 + (16 * ks + 8 * hh) * 2); af[4 + ks] = *(const LAS bf16x8_t*)(buf + G_ATT + (32 * mb + r) * 144 + (16 * ks + 8 * hh) * 2); }
#pragma unroll
                for (int e = 0; e < 16; ++e) O[e] = 0.f;
#pragma unroll
                for (int ks = 0; ks < 4; ++ks) O = __builtin_amdgcn_mfma_f32_32x32x16_bf16(af[ks], SBF(ks), O, 0, 0, 0);
#pragma unroll
                for (int ks = 0; ks < 4; ++ks) O = __builtin_amdgcn_mfma_f32_32x32x16_bf16(af[4 + ks], vb[ks], O, 0, 0, 0);
#pragma unroll
                for (int m = 0; m < 4; ++m) { const int g4 = 8 * mb + 2 * m + hh, tg = cidx * 16 + (dir ? 15 - g4 : g4);
                    f32x4 ov; if (dir) { ov[0] = O[4 * m + 3]; ov[1] = O[4 * m + 2]; ov[2] = O[4 * m + 1]; ov[3] = O[4 * m + 0]; } else { ov[0] = O[4 * m + 0]; ov[1] = O[4 * m + 1]; ov[2] = O[4 * m + 2]; ov[3] = O[4 * m + 3]; }
                    *(f32x4*)(obuf + ((size_t)tg * 512 + head * 128 + col) * 4) = ov; } }
            { asm volatile("" ::: "memory");
              bf16x8_t af[8]; f32x4 dv[8];
#pragma unroll
              for (int mb = 0; mb < 2; ++mb)
#pragma unroll
                for (int ks = 0; ks < 4; ++ks) { af[4 * mb + ks] = *(const LAS bf16x8_t*)(buf + G_KE + (32 * mb + r) * 144 + (16 * ks + 8 * hh) * 2); dv[4 * mb + ks] = *(const LAS f32x4*)(buf + G_DEC + (32 * mb + 8 * ks + 4 * hh) * 4); }
#pragma unroll
              for (int mb = 0; mb < 2; ++mb) {
#pragma unroll
                for (int m = 0; m < 4; ++m)
#pragma unroll
                    for (int rr = 0; rr < 4; ++rr) S[mb][4 * m + rr] *= dv[4 * mb + m][rr];
#pragma unroll
                for (int ks = 0; ks < 4; ++ks) S[mb] = __builtin_amdgcn_mfma_f32_32x32x16_bf16(af[4 * mb + ks], vb[ks], S[mb], 0, 0, 0); } }
            lds_barrier();
        }
        if (s_out) {
            float* sp = s_out + (4 * hh) * 128 + col;
#pragma unroll
            for (int mb = 0; mb < 2; ++mb)
#pragma unroll
                for (int m = 0; m < 4; ++m) { asm volatile("" : "+v"(sp));
#pragma unroll
                    for (int rr = 0; rr < 4; ++rr) sp[rr * 128] = S[mb][4 * m + rr];
                    sp += 8 * 128; }
        }
    }
}
constexpr size_t WS_RGAB = WS_IMG + (size_t)1536 * 49152;
__device__ __forceinline__ void rg_pre(const Params& p, LAS unsigned char* lds, int jl, int which, int fb) {
    const int tid = otid(), lane = tid & 63, wave = __builtin_amdgcn_readfirstlane(tid >> 6), r = lane & 31, hh = lane >> 5;
    const bf16_t* proj = (const bf16_t*)(WSP(p) + WS_PROJ);
    LAS unsigned char* xcs = lds;
    LAS float* xcf = (LAS float*)(lds + 9216);
    LAS unsigned char* wts = lds + 9216 + 16640;
    LAS float* prm = (LAS float*)(lds + 9216 + 16640 + 36864);
    const int n = obid() & 7;
    for (int e = tid; e < 4 * 4096; e += 512) { const int m = e >> 12, j = (e >> 6) & 63, c = e & 63, dir = m >> 1, gate = m & 1;
        const float w = PIN(gate ? I_RGWX : I_RGWA)[((size_t)((jl * 2 + dir) * 8 + n) * 64 + j) * 64 + c];
        *(LAS bf16_t*)(wts + m * 9216 + c * 144 + j * 2) = (bf16_t)f2bf(w); }
    if (tid < 128) { const int dir = tid >> 6, c = tid & 63, ch = n * 64 + c; prm[(dir * 3 + 0) * 64 + c] = PIN(I_RGBA)[(jl * 2 + dir) * 512 + ch]; prm[(dir * 3 + 1) * 64 + c] = PIN(I_RGBX)[(jl * 2 + dir) * 512 + ch];
        prm[(dir * 3 + 2) * 64 + c] = softplusf_(-PIN(I_RGLAM)[(jl * 2 + dir) * 512 + ch]); }
    __syncthreads();
    unsigned* AB = (unsigned*)(WSP(p) + WS_RGAB);
    for (int it = obid() - fb; it < (which ? 512 : 1024); it += gridDim.x - fb) {
        const int c64 = (which ? 0 : 64) + (it >> 3), t0 = c64 * 64; int lo, hi; seq_bounds(t0, lo, hi);
        { const int i = tid >> 3, part = tid & 7, ch = n * 64 + part * 8; float acc[8];
          const f32x4 b0 = *(const f32x4*)(PIN(I_RGCB) + jl * 512 + ch), b1 = *(const f32x4*)(PIN(I_RGCB) + jl * 512 + ch + 4);
          acc[0] = b0[0]; acc[1] = b0[1]; acc[2] = b0[2]; acc[3] = b0[3]; acc[4] = b1[0]; acc[5] = b1[1]; acc[6] = b1[2]; acc[7] = b1[3];
#pragma unroll
          for (int tap = 0; tap < 4; ++tap) { const int tt = t0 + i + tap - 1;
              if (tt >= lo && tt < hi) { const u32x4 x = *(const u32x4*)(proj + (size_t)tt * PLD + 1568 + ch); const float* wp = PIN(I_RGCW) + (jl * 4 + tap) * 512 + ch; const f32x4 w0 = *(const f32x4*)wp, w1 = *(const f32x4*)(wp + 4);
                  acc[0] += w0[0] * bflo(x.x); acc[1] += w0[1] * bfhi(x.x); acc[2] += w0[2] * bflo(x.y); acc[3] += w0[3] * bfhi(x.y); acc[4] += w1[0] * bflo(x.z); acc[5] += w1[1] * bfhi(x.z); acc[6] += w1[2] * bflo(x.w); acc[7] += w1[3] * bfhi(x.w); } }
          u32x4 o; o.x = pk2(acc[0], acc[1]); o.y = pk2(acc[2], acc[3]); o.z = pk2(acc[4], acc[5]); o.w = pk2(acc[6], acc[7]);
          *(LAS u32x4*)(xcs + i * 144 + part * 16) = o;
#pragma unroll
          for (int q = 0; q < 8; ++q) xcf[i * 65 + part * 8 + q] = acc[q]; }
        __syncthreads();
        { const int dir = wave >> 2, mb = (wave >> 1) & 1, nb = wave & 1; f32x16 ar, ai;
#pragma unroll
          for (int e = 0; e < 16; ++e) { ar[e] = 0.f; ai[e] = 0.f; }
#pragma unroll
          for (int ks = 0; ks < 4; ++ks) { const bf16x8_t a = *(const LAS bf16x8_t*)(xcs + (32 * mb + r) * 144 + (16 * ks + 8 * hh) * 2);
              const bf16x8_t br = *(const LAS bf16x8_t*)(wts + (dir * 2 + 0) * 9216 + (32 * nb + r) * 144 + (16 * ks + 8 * hh) * 2), bi = *(const LAS bf16x8_t*)(wts + (dir * 2 + 1) * 9216 + (32 * nb + r) * 144 + (16 * ks + 8 * hh) * 2);
              ar = __builtin_amdgcn_mfma_f32_32x32x16_bf16(a, br, ar, 0, 0, 0); ai = __builtin_amdgcn_mfma_f32_32x32x16_bf16(a, bi, ai, 0, 0, 0); }
          const int c = 32 * nb + r; const float ba = prm[(dir * 3 + 0) * 64 + c], bx = prm[(dir * 3 + 1) * 64 + c], sp = prm[(dir * 3 + 2) * 64 + c];
          unsigned* dst = AB + ((size_t)dir * NT + t0) * 512 + n * 64 + c;
#pragma unroll
          for (int e = 0; e < 16; ++e) { const int i = 32 * mb + (e & 3) + 8 * (e >> 2) + 4 * hh;
              const float rr = sigmoidf_(ar[e] + ba), ig = sigmoidf_(ai[e] + bx), la = -8.0f * rr * sp;
              const float a_ = __expf(la); dst[(size_t)i * 512] = pk2(1.0f - a_, __builtin_amdgcn_sqrtf(1.0f - a_ * a_) * (ig * xcf[i * 65 + c])); } }
        __syncthreads();
    }
}
template <bool STORE_TMP, bool FINAL, int NB>
__device__ __forceinline__ float rg_scan256(const unsigned* ab, int dir, int base, float h, float& dprod, float* tmp, const bf16_t* gatep, bf16_t* mixp) {
#pragma unroll 1
    for (int i0 = 0; i0 < SEG; i0 += NB) { unsigned u[NB]; float tv[NB]; unsigned short gv[NB];
#pragma unroll
        for (int q = 0; q < NB; ++q) { const int t = dir ? base + SEG - 1 - (i0 + q) : base + i0 + q; u[q] = ab[(size_t)t * 512]; if (FINAL) { tv[q] = tmp[(size_t)t * 512]; gv[q] = gatep[(size_t)t * PLD]; } }
#pragma unroll
        for (int q = 0; q < NB; ++q) { const int t = dir ? base + SEG - 1 - (i0 + q) : base + i0 + q; const float a = 1.0f - bflo(u[q]); h = a * h + bfhi(u[q]); dprod *= a;
            if (STORE_TMP) tmp[(size_t)t * 512] = h;
            if (FINAL) mixp[(size_t)t * 1024] = (bf16_t)f2bf(geluf_(bf2f(gv[q])) * (tv[q] + h)); } }
    return h;
}
__device__ __forceinline__ float rg_carry(const Params& p, int jl, int seg, int dir, int chn) {
    const int sseg = seg - 16, b = sseg >> 4, j = sseg & 15, nst = dir ? 15 - j : j; float h = PIN(I_SRG)[((b * 2 + jl) * 2 + dir) * 512 + chn];
    float dv[15], ev[15];
#pragma unroll
    for (int q = 0; q < 15; ++q) { const int sj = b * 16 + (dir ? 15 - q : q), o = (sj * 2 + dir) * 512 + chn; dv[q] = q < nst ? ((const float*)(WSP(p) + WS_C2D))[o] : 1.f; ev[q] = q < nst ? ((const float*)(WSP(p) + WS_C2E))[o] : 0.f; }
#pragma unroll
    for (int q = 0; q < 15; ++q) h = dv[q] * h + ev[q];
    return h;
}
__device__ __forceinline__ void rg_passA(const Params& p, int seg, int dir, int n) {
    const int lane = otid() & 63, chn = n * 64 + lane, sseg = seg - 16; float dprod = 1.f;
    const unsigned* ab = (const unsigned*)(WSP(p) + WS_RGAB) + (size_t)dir * NT * 512 + chn;
    const float h = rg_scan256<false, false, 32>(ab, dir, seg * SEG, 0.f, dprod, nullptr, nullptr, nullptr);
    ((float*)(WSP(p) + WS_C2E))[(sseg * 2 + dir) * 512 + chn] = h; ((float*)(WSP(p) + WS_C2D))[(sseg * 2 + dir) * 512 + chn] = dprod;
}
__device__ __forceinline__ void rg_passB(const Params& p, int jl, int seg, int n) {
    const int lane = otid() & 63, chn = n * 64 + lane; float dprod = 1.f;
    const unsigned* ab = (const unsigned*)(WSP(p) + WS_RGAB) + chn; float* tmp = (float*)(WSP(p) + WS_YS) + chn;
    const bf16_t* gatep = (const bf16_t*)(WSP(p) + WS_PROJ) + 2080 + chn; bf16_t* mixp = (bf16_t*)(WSP(p) + WS_HN) + 512 + chn;
    const float hf0 = seg >= 16 ? rg_carry(p, jl, seg, 0, chn) : 0.f, hb0 = seg >= 16 ? rg_carry(p, jl, seg, 1, chn) : 0.f;
    const float hf = rg_scan256<true, false, 32>(ab, 0, seg * SEG, hf0, dprod, tmp, nullptr, nullptr);
    const float hb = rg_scan256<false, true, 16>(ab + (size_t)NT * 512, 1, seg * SEG, hb0, dprod, tmp, gatep, mixp);
    if (seg < 16) { POUT()[OUT_RG + ((seg * 2 + jl) * 2 + 0) * 512 + chn] = hf; POUT()[OUT_RG + ((seg * 2 + jl) * 2 + 1) * 512 + chn] = hb; }
}

__device__ __forceinline__ void inproj_tail(const Params& p, int first_blk) {
    const int lane = otid() & 63, wave = __builtin_amdgcn_readfirstlane(otid() >> 6), r = lane & 31, hh = lane >> 5;
    const int nblk = gridDim.x - first_blk;
    const bf16_t* hn = (const bf16_t*)(WSP(p) + WS_HN); const bf16_t* wt = (const bf16_t*)(WSP(p) + WS_WIN) + (size_t)(2560 + r) * 1024 + 8 * hh; bf16_t* proj = (bf16_t*)(WSP(p) + WS_PROJ);
    for (int tile = (obid() - first_blk) * 8 + wave; tile < NT / 32; tile += nblk * 8) {
        const bf16_t* ap = hn + (size_t)(tile * 32 + r) * 1024 + 8 * hh;
        f32x16 acc;
#pragma unroll
        for (int e = 0; e < 16; ++e) acc[e] = 0.f;
#pragma unroll 1
        for (int k0 = 0; k0 < 64; k0 += 8) { bf16x8_t a[8], b[8];
#pragma unroll
            for (int q = 0; q < 8; ++q) { a[q] = *(const bf16x8_t*)(ap + (k0 + q) * 16); b[q] = *(const bf16x8_t*)(wt + (k0 + q) * 16); }
#pragma unroll
            for (int q = 0; q < 8; ++q) acc = __builtin_amdgcn_mfma_f32_32x32x16_bf16(a[q], b[q], acc, 0, 0, 0); }
        bf16_t* op = proj + (size_t)(tile * 32) * PLD + 2560 + r;
#pragma unroll
        for (int e = 0; e < 16; ++e) op[(size_t)((e & 3) + 8 * (e >> 2) + 4 * hh) * PLD] = (bf16_t)f2bf(acc[e]);
    }
}
__device__ __forceinline__ void ab_pre(const Params& p, LAS unsigned char* lds, int jl) {
    gla_pre(p, lds, jl, 0, 0);
    rg_pre(p, lds, jl, 0, 0);
}
__device__ __forceinline__ void ab_chain(const Params& p, LAS unsigned char* lds, int jl, const XcdBarrier& sub) {
    const int bid = obid();
    if (bid >= 16) { gla_pre(p, lds, jl, 1, 16); rg_pre(p, lds, jl, 1, 16); xcd_barrier(sub); }
    if (bid < 144) { const bool smp = bid < 16; const int q = smp ? bid : bid - 16, b = q >> 3, dir = (q >> 2) & 1, head = q & 3;
        const size_t so = (size_t)(((b * 2 + jl) * 2 + dir) * 4 + head) * 8192;
        gla_chain(p, lds, smp ? 64 + 64 * b : 4 * b, smp ? 64 : 4, dir, head, smp ? PIN(I_SGLA) + so : nullptr, smp ? nullptr : POUT() + OUT_GLA + so); }
    if (bid >= 16) { const int wave = __builtin_amdgcn_readfirstlane(otid() >> 6);
        for (int idx = (bid - 16) * 8 + wave; idx < NSSEG * 16; idx += (gridDim.x - 16) * 8) { const int seg = 16 + idx / 16, r = idx % 16; rg_passA(p, seg, r >> 3, r & 7); } }
    if (bid >= 144) inproj_tail(p, 144);
}
__device__ __forceinline__ void ab_fin(const Params& p, int jl) {
    { const int wave = __builtin_amdgcn_readfirstlane(otid() >> 6), G = gridDim.x;
      for (int idx = wave * G + obid(); idx < NSEG * 8; idx += 8 * G) rg_passB(p, jl, idx >> 3, idx & 7); }
    ab_combine(p, jl);
}
__device__ __forceinline__ void cd_pre(const Params& p, LAS unsigned char* lds, int jl) {
    dn_pre(p, lds, jl, 0, 0);
}
__device__ __forceinline__ void cd_chain(const Params& p, LAS unsigned char* lds, int jl, const XcdBarrier& sub) {
    const int bid = obid();
    if (bid >= 16) { dn_pre(p, lds, jl, 1, 16);
        { const int wave = __builtin_amdgcn_readfirstlane(otid() >> 6);
          for (int idx = (bid - 16) * 8 + wave; idx < NSSEG * 64; idx += (gridDim.x - 16) * 8) { const int seg = 16 + idx / 64, r = idx % 64; s5_task<false>(p, lds, jl, seg, r >> 5, r & 31); } }
        xcd_barrier(sub); }
    if (bid < 144) { const bool smp = bid < 16; const int q = smp ? bid : bid - 16, b = q >> 3, dir = (q >> 2) & 1, head = q & 3;
        const size_t so = (size_t)(((b * 2 + jl) * 2 + dir) * 4 + head) * 16384;
        dn_chain(p, lds, jl, smp ? 64 + 64 * b : 4 * b, smp ? 64 : 4, dir, head, smp ? PIN(I_SDN) + so : nullptr, smp ? nullptr : POUT() + OUT_DN + so); }
    if (bid >= 16) { const int wave = __builtin_amdgcn_readfirstlane(otid() >> 6);
        for (int idx = (bid - 16) * 8 + wave; idx < NSEG * 64; idx += (gridDim.x - 16) * 8) { const int seg = idx / 64, r = idx % 64; s5_task<true>(p, lds, jl, seg, r >> 5, r & 31); } }
}
__device__ __forceinline__ void cd_combine(const Params& p, int jl) {
    const int lane = otid() & 63, gw = obid() * 8 + (otid() >> 6), nw = gridDim.x * 8;
    const bf16_t* proj = (const bf16_t*)(WSP(p) + WS_PROJ); const float* ys = (const float*)(WSP(p) + WS_YS); bf16_t* zg = (bf16_t*)(WSP(p) + WS_ZG);
    for (int t = gw; t < NT; t += nw) {
        const bf16_t* pr = proj + (size_t)t * PLD; const float* os = ys + (size_t)t * 512;
#pragma unroll
        for (int i = 0; i < 4; ++i) { const int c = i * 128 + 2 * lane; const float2 y = *(const float2*)(os + c); const unsigned u = *(const unsigned*)(pr + c); const float2 d = *(const float2*)(PIN(I_S5D) + jl * 512 + c);
            *(unsigned*)(zg + (size_t)t * 512 + c) = pk2(geluf_(y.x + d.x * bflo(u)), geluf_(y.y + d.y * bfhi(u))); }
    }
}

__global__ void __launch_bounds__(512) fwd_mega(Params p) {
    extern __shared__ __attribute__((aligned(16))) unsigned char lds_raw[];
    LAS unsigned char* lds = (LAS unsigned char*)lds_raw;
    cg::grid_group grid = cg::this_grid();
    const int G = gridDim.x, bid = obid();
    unsigned char* ws = WSP(p);
    float* X = (float*)(ws + WS_X); bf16_t* HN = (bf16_t*)(ws + WS_HN); bf16_t* PROJ = (bf16_t*)(ws + WS_PROJ);
    const float* MOD = (const float*)(ws + WS_MOD);

    if (otid() < 8) ((LAS unsigned*)(lds + LDS_BAR))[otid()] = 0u;
    __syncthreads();
    const XcdBarrier xbar = xcd_barrier_post((unsigned*)(ws + WS_BAR), (volatile LAS unsigned*)(lds + LDS_BAR), gridDim.x);
    XcdBarrier xsub = xbar; if (bid >= 16) xsub = xcd_barrier_post((unsigned*)(ws + WS_BAR + 16384), (volatile LAS unsigned*)(lds + LDS_BAR + 16), gridDim.x - 16);
#define GSYNC() xcd_barrier(xbar)
    phase0(p, lds);
    grid.sync();
#pragma unroll 1
    for (int l = 0; l < 4; ++l) {
        const int jl = l >> 1; const bool isAB = (l & 1) == 0;
        const float* mod = MOD + (size_t)l * 3 * 6144;
        if (l > 0) prep_rest(p, lds, l);
        if (l & 1) zero_osum(p);
        norm_phase<false>(X, PIN(I_N1W) + l * 1024, mod + 0, mod + 1024, HN, nullptr);
        GSYNC();
        { const int n1 = isAB ? 2560 : 2816;
          pg8::Gemm g{HN, (const bf16_t*)(ws + WS_WIN), NT, n1, 1024}; pg8::StaticOrder S; S.init(NT, n1, G, bid); EpiProj E{PROJ, PLD};
          pg8::gemm_phase<EpiProj, pg8::StaticOrder>(lds, g, S, E, nullptr); }
        GSYNC();
        if (isAB) {
            ab_pre(p, lds, jl); GSYNC();
            ab_chain(p, lds, jl, xsub); GSYNC();
            ab_fin(p, jl); GSYNC();
        } else {
            cd_pre(p, lds, jl); GSYNC();
            cd_chain(p, lds, jl, xsub); GSYNC();
            cd_combine(p, jl); GSYNC();
            { pg8::Gemm g{(const bf16_t*)(ws + WS_ZG), (const bf16_t*)(ws + WS_WGLU), NT, 512, 512}; pg8::StaticOrder S; S.init(NT, 512, G, bid);
              EpiGLU E{HN, (const bf16_t*)(ws + WS_ZG), PIN(I_GLUB) + jl * 512};
              pg8::gemm_phase<EpiGLU, pg8::StaticOrder>(lds, g, S, E, nullptr);
              if (bid >= 96) chain_combine(p, PIN(I_DNNW) + jl * 128, 2048, 512, 96); }
            GSYNC();
        }
        { pg8::Gemm g{HN, (const bf16_t*)(ws + WS_WOUT), NT, 1024, 1024}; pg8::StaticOrder S; S.init(NT, 1024, G, bid); EpiResid E{X, mod + 2048};
          pg8::gemm_phase<EpiResid, pg8::StaticOrder>(lds, g, S, E, nullptr); }
        GSYNC();
        norm_phase<false>(X, PIN(I_N2W) + l * 1024, mod + 3072, mod + 4096, HN, nullptr);
        GSYNC();
        { pg8::Gemm g{HN, (const bf16_t*)(ws + WS_WGU), NT, 5632, 1024}; pg8::StaticOrder S; S.init(NT, 5632, G, bid); EpiSwiGLU E{PROJ};
          pg8::gemm_phase<EpiSwiGLU, pg8::StaticOrder>(lds, g, S, E, nullptr); }
        GSYNC();
        { pg8::Gemm g{PROJ, (const bf16_t*)(ws + WS_WDN), NT, 1024, 2816}; pg8::StaticOrder S; S.init(NT, 1024, G, bid); EpiResid E{X, mod + 5120};
          pg8::gemm_phase<EpiResid, pg8::StaticOrder>(lds, g, S, E, nullptr);
          if (bid >= 192 && l < 3) prep_in_out(p, lds, l + 1, 192); }
        GSYNC();
    }
    norm_phase<true>(X, PIN(I_FNW), nullptr, nullptr, nullptr, POUT() + OUT_Y);
}

extern "C" void kernel_launch(void* const* d_in, const int* in_sizes, int n_in, void* d_out, int out_size, void* d_ws, size_t ws_size, hipStream_t stream) {
    static int grid_blocks = 0;
    if (grid_blocks == 0) {
        if (n_in != 44 || ws_size < WS_END) { fprintf(stderr, "kernel_launch: need 44 inputs and %zu bytes of workspace; got %d, %zu\n", (size_t)WS_END, n_in, ws_size); grid_blocks = -1; return; }
        int dev = 0, cus = 0, per_cu = 0;
        (void)hipGetDevice(&dev); (void)hipDeviceGetAttribute(&cus, hipDeviceAttributeMultiprocessorCount, dev);
        if (hipFuncSetAttribute((const void*)fwd_mega, hipFuncAttributeMaxDynamicSharedMemorySize, LDS_BYTES) != hipSuccess) { fprintf(stderr, "kernel_launch: hipFuncSetAttribute failed\n"); grid_blocks = -1; return; }
        if (hipOccupancyMaxActiveBlocksPerMultiprocessor(&per_cu, (const void*)fwd_mega, 512, LDS_BYTES) != hipSuccess || per_cu < 1) { fprintf(stderr, "kernel_launch: occupancy query gave %d\n", per_cu); per_cu = 1; }
        (void)hipGetLastError();
        grid_blocks = cus;
    }
    if (grid_blocks < 0) return;
    if (hipMemsetAsync((char*)d_ws + WS_BAR, 0, 32768, stream) != hipSuccess) { fprintf(stderr, "kernel_launch: memset failed\n"); return; }
    Params p{};
    for (int i = 0; i < 44; ++i) p.in[i] = (const float*)d_in[i];
    p.out = (float*)d_out; p.ws = (unsigned char*)d_ws;
    void* args[] = {&p};
    hipError_t e = hipLaunchCooperativeKernel((const void*)fwd_mega, dim3(grid_blocks), dim3(512), args, LDS_BYTES, stream);
    if (e != hipSuccess) fprintf(stderr, "cooperative launch failed: %s (grid %d)\n", hipGetErrorString(e), grid_blocks);
}
```

```cpp
#include <hip/hip_runtime.h>
#include <hip/hip_cooperative_groups.h>
#include <cstdio>
namespace cg = cooperative_groups;
__device__ __forceinline__ int otid() { int t = threadIdx.x; asm volatile("" : "+v"(t)); return t; }
__device__ __forceinline__ int obid() { int b = blockIdx.x; asm volatile("" : "+s"(b)); return b; }
namespace pg8 {
#define PG8_LAS __attribute__((address_space(3)))
typedef unsigned short bf16_t;
typedef short bf16x8 __attribute__((ext_vector_type(8)));
typedef float f32x4 __attribute__((ext_vector_type(4)));
typedef unsigned u32x4 __attribute__((ext_vector_type(4)));
constexpr int BM = 256, BK = 64, HALF = 128, HTB = HALF * BK * 2  , STAGE_BYTES = 8 * HTB, NXCD = 8, WGM = 8;

__host__ __device__ __forceinline__ int lds_byte(int r, int c) { const int st = (r >> 4) * 2 + (c >> 5), rr = r & 15, cc = c & 31, ob = rr * 64 + cc * 2; return st * 1024 + (ob ^ (((ob >> 9) & 1) << 5)); }
__host__ __device__ __forceinline__ void stage_rc(int b, int& R, int& C) { const int st = b / 1024, sb = b % 1024, swz = sb ^ (((sb >> 9) & 1) << 5); R = (st >> 1) * 16 + swz / 64; C = (st & 1) * 32 + (swz % 64) / 2; }
__host__ __device__ __forceinline__ int perm32(int rho) { const int n = rho >> 4, i = rho & 15; return 8 * (i >> 2) + 4 * n + (i & 3); }

struct Unit { int pm, pn; };
struct Gemm { const bf16_t* A; const bf16_t* Bt; int M, N, K; };

struct StaticOrder {
    int nM, nN, nwg, G, c;
    __host__ __device__ void init(int M, int N, int G_, int c_) { nM = M / BM; nN = N / BM; nwg = nM * nN; G = G_; c = c_; }
    __host__ __device__ bool next(int i, Unit& u) const {
        const long L = (long)i * G + c; if (L >= nwg) return false;
        int wgid = (int)L; { const int q = nwg / NXCD, r = nwg % NXCD, xcd = wgid % NXCD, off = wgid / NXCD; wgid = (xcd < r ? xcd * (q + 1) : r * (q + 1) + (xcd - r) * q) + off; }
        const int nig = WGM * nN, gid = wgid / nig, fm = gid * WGM, gsz = (nM - fm) < WGM ? (nM - fm) : WGM;
        u.pm = fm + ((wgid % nig) % gsz); u.pn = (wgid % nig) / gsz; return true;
    }
    __device__ __forceinline__ void a_ready(const Unit&) const {}
    __device__ __forceinline__ void done(const Unit&) const {}
};
__device__ __forceinline__ unsigned cvt_pk_bf16(float lo, float hi) { unsigned r; asm volatile("v_cvt_pk_bf16_f32 %0, %1, %2" : "=v"(r) : "v"(lo), "v"(hi)); return r; }
typedef float f32x2 __attribute__((ext_vector_type(2)));
template <class Epi, class Sched, bool STAMP = false>
__device__ __forceinline__ void gemm_phase(PG8_LAS unsigned char* lds, const Gemm g, const Sched& S, const Epi& E, unsigned long long* stamps) {
    const int tid = otid(), wid = __builtin_amdgcn_readfirstlane(tid >> 6), lane = tid & 63, wr = wid >> 2, wc = wid & 3, fr = lane & 15, fq = lane >> 4;
    const int K = g.K, nt = K / BK;
    int ts_lo = 0, ts_hi = 0, nts = 0; const unsigned long long rt_entry = STAMP ? (unsigned long long)wall_clock64() : 0ull;
#define PG8_STAMP() do { if (STAMP && wid == 0 && nts < 64) { const unsigned long long _c = (unsigned long long)clock64(); \
        ts_lo = (lane == nts) ? (int)(unsigned)_c : ts_lo; ts_hi = (lane == nts) ? (int)(unsigned)(_c >> 32) : ts_hi; ++nts; } } while (0)
    PG8_STAMP();
    unsigned voffA[2], voffB[2];
#pragma unroll
    for (int i = 0; i < 2; ++i) { int R, C; stage_rc(tid * 16 + i * 8192, R, C); const int Rb = Epi::PERM ? ((R & ~31) + perm32(R & 31)) : R;
        voffA[i] = (unsigned)(R * K + C) * 2u; voffB[i] = (unsigned)(Rb * K + C) * 2u; }
    const size_t kstep = (size_t)(BK * 2);
    const size_t hstep = (size_t)HALF * K * 2;
    const size_t tstep = 2 * hstep;
    const unsigned ldsw = (unsigned)wid * 1024u;
    const int aoff = lds_byte(wr * 64 + fr, fq * 8), boff = lds_byte(wc * 32 + fr, fq * 8);
#define PG8_SA(b, h) (((b) * 2 + (h)) * HTB)
#define PG8_SB(b, h) ((4 + (b) * 2 + (h)) * HTB)
#define PG8_STAGE(bufoff, gbase, voff) do { _Pragma("unroll") for (int _i = 0; _i < 2; ++_i) \
        __builtin_amdgcn_global_load_lds((const unsigned*)((const char*)(gbase) + (voff)[_i]), (PG8_LAS unsigned*)(lds + (bufoff) + ldsw + _i * 8192), 16, 0, 0); } while (0)
#define PG8_LDA(dst, b, h) do { _Pragma("unroll") for (int m = 0; m < 4; ++m) _Pragma("unroll") for (int k = 0; k < 2; ++k) dst[m][k] = *(const PG8_LAS bf16x8*)(lds + PG8_SA(b, h) + aoff + m * 2048 + k * 1024); } while (0)
#define PG8_LDB(dst, b, h) do { _Pragma("unroll") for (int n = 0; n < 2; ++n) _Pragma("unroll") for (int k = 0; k < 2; ++k) dst[n][k] = *(const PG8_LAS bf16x8*)(lds + PG8_SB(b, h) + boff + n * 2048 + k * 1024); } while (0)
#define PG8_MMA(ai, bj, At, Bt) do { __builtin_amdgcn_s_setprio(1); _Pragma("unroll") for (int m = 0; m < 4; ++m) _Pragma("unroll") for (int n = 0; n < 2; ++n) _Pragma("unroll") for (int k = 0; k < 2; ++k) \
        acc[ai][bj][m][n] = __builtin_amdgcn_mfma_f32_16x16x32_bf16(Bt[n][k], At[m][k], acc[ai][bj][m][n], 0, 0, 0); __builtin_amdgcn_s_setprio(0); } while (0)
#define PG8_WAIT_V(n) asm volatile("s_waitcnt vmcnt(" #n ")" ::: "memory")
#define PG8_WAIT_L(n) asm volatile("s_waitcnt lgkmcnt(" #n ")" ::: "memory")
#define PG8_BAR __builtin_amdgcn_s_barrier()
#define PG8_SCHED __builtin_amdgcn_sched_barrier(0)
    Unit cur, nxt; int ui = 0;
    if (!S.next(0, cur)) return;
    f32x4 acc[2][2][4][2];
#pragma unroll
    for (int a = 0; a < 2; ++a)
#pragma unroll
        for (int b = 0; b < 2; ++b)
#pragma unroll
            for (int m = 0; m < 4; ++m)
#pragma unroll
                for (int n = 0; n < 2; ++n) acc[a][b][m][n] = (f32x4){0.f, 0.f, 0.f, 0.f};
    bf16x8 At[4][2], B0[2][2], B1[2][2];
    const char* cA = (const char*)g.A + (size_t)cur.pm * tstep; const char* cB = (const char*)g.Bt + (size_t)cur.pn * tstep;
    S.a_ready(cur);
    PG8_STAGE(PG8_SB(0, 0), cB, voffB); PG8_STAGE(PG8_SA(0, 0), cA, voffA); PG8_STAGE(PG8_SB(0, 1), cB + hstep, voffB); PG8_STAGE(PG8_SA(0, 1), cA + hstep, voffA);
    if (wr == 1) PG8_BAR;
    PG8_WAIT_V(4); PG8_BAR;
    PG8_STAGE(PG8_SB(1, 0), cB + kstep, voffB); PG8_STAGE(PG8_SA(1, 0), cA + kstep, voffA); PG8_STAGE(PG8_SB(1, 1), cB + hstep + kstep, voffB);
    PG8_WAIT_V(6); PG8_BAR;
    PG8_STAMP();
    for (;;) {
        const bool has_next = S.next(ui + 1, nxt);
        const char* nA = has_next ? (const char*)g.A + (size_t)nxt.pm * tstep : cA; const char* nB = has_next ? (const char*)g.Bt + (size_t)nxt.pn * tstep : cB;
        for (int t = 0; t < nt; t += 2) {
            const bool last = (t == nt - 2);
            const char* a1 = cA + (size_t)(t + 1) * kstep;
            const char* a2 = last ? nA : cA + (size_t)(t + 2) * kstep; const char* b2 = last ? nB : cB + (size_t)(t + 2) * kstep;
            const char* a3 = a2 + kstep; const char* b3 = b2 + kstep;
            if (last && has_next) S.a_ready(nxt);
            PG8_LDB(B0, 0, 0); PG8_SCHED; PG8_LDA(At, 0, 0); PG8_STAGE(PG8_SA(1, 1), a1 + hstep, voffA);
            PG8_WAIT_L(8); PG8_BAR; PG8_WAIT_L(0); PG8_MMA(0, 0, At, B0); PG8_BAR; PG8_SCHED;
            PG8_LDB(B1, 0, 1); PG8_STAGE(PG8_SB(0, 0), b2, voffB);
            PG8_BAR; PG8_WAIT_L(0); PG8_MMA(0, 1, At, B1); PG8_BAR;
            PG8_LDA(At, 0, 1); PG8_STAGE(PG8_SA(0, 0), a2, voffA);
            PG8_BAR; PG8_WAIT_L(0); PG8_MMA(1, 0, At, B0); PG8_BAR; PG8_SCHED;
            PG8_STAGE(PG8_SB(0, 1), b2 + hstep, voffB);
            PG8_WAIT_V(6); PG8_BAR; PG8_MMA(1, 1, At, B1); PG8_BAR;
            PG8_LDB(B0, 1, 0); PG8_SCHED; PG8_LDA(At, 1, 0); PG8_STAGE(PG8_SA(0, 1), a2 + hstep, voffA);
            PG8_WAIT_L(8); PG8_BAR; PG8_WAIT_L(0); PG8_MMA(0, 0, At, B0); PG8_BAR; PG8_SCHED;
            PG8_LDB(B1, 1, 1); PG8_STAGE(PG8_SB(1, 0), b3, voffB);
            PG8_BAR; PG8_WAIT_L(0); PG8_MMA(0, 1, At, B1); PG8_BAR;
            PG8_LDA(At, 1, 1); PG8_STAGE(PG8_SA(1, 0), a3, voffA);
            PG8_BAR; PG8_WAIT_L(0); PG8_MMA(1, 0, At, B0); PG8_BAR; PG8_SCHED;
            PG8_STAGE(PG8_SB(1, 1), b3 + hstep, voffB);
            PG8_WAIT_V(6); PG8_BAR; PG8_MMA(1, 1, At, B1); PG8_BAR;
        }
        PG8_STAMP();
        if constexpr (!Epi::AFTER_DRAIN) { E(acc, cur, wr, wc, fr, fq); S.done(cur); }
        PG8_STAMP();
        if (!has_next) break;
#pragma unroll
        for (int a = 0; a < 2; ++a)
#pragma unroll
            for (int b = 0; b < 2; ++b)
#pragma unroll
                for (int m = 0; m < 4; ++m)
#pragma unroll
                    for (int n = 0; n < 2; ++n) acc[a][b][m][n] = (f32x4){0.f, 0.f, 0.f, 0.f};
        cur = nxt; cA = nA; cB = nB; ++ui;
    }
    PG8_WAIT_V(0);
    if (wr == 0) PG8_BAR;
    PG8_BAR;
    if constexpr (Epi::AFTER_DRAIN) { E.fused(acc, cur, wr, wc, fr, fq, lds, wid, lane); S.done(cur); }
    PG8_STAMP();
    if (STAMP && wid == 0) { stamps[lane] = lane < nts ? (((unsigned long long)(unsigned)ts_hi << 32) | (unsigned)ts_lo) : 0ull;
        if (lane == 62) stamps[62] = rt_entry; if (lane == 63) stamps[63] = (unsigned long long)wall_clock64(); }
#undef PG8_STAMP
#undef PG8_SA
#undef PG8_SB
#undef PG8_STAGE
#undef PG8_LDA
#undef PG8_LDB
#undef PG8_MMA
#undef PG8_WAIT_V
#undef PG8_WAIT_L
#undef PG8_BAR
#undef PG8_SCHED
}
}

using pg8::bf16_t; using pg8::f32x4; using pg8::u32x4; using pg8::Unit;
#define LAS __attribute__((address_space(3)))
typedef unsigned u32x2 __attribute__((ext_vector_type(2)));
typedef float f32x2 __attribute__((ext_vector_type(2)));

constexpr int NT = 12288, DM = 1024, SEG = 256, NSEG = 48, NSSEG = 32, PLD = 2816, DFF = 2816;
constexpr float EPS = 1e-6f;
constexpr int LDS_BAR = 159776, LDS_BYTES = LDS_BAR + 256;

constexpr size_t WS_X     = 0;
constexpr size_t WS_HN    = WS_X + (size_t)NT * DM * 4;
constexpr size_t WS_PROJ  = WS_HN + (size_t)NT * DM * 2;
constexpr size_t WS_WIN   = WS_PROJ + (size_t)NT * PLD * 2;
constexpr size_t WS_WOUT  = WS_WIN + (size_t)2816 * 1024 * 2;
constexpr size_t WS_WGU   = WS_WOUT + (size_t)1024 * 1024 * 2;
constexpr size_t WS_WDN   = WS_WGU + (size_t)5632 * 1024 * 2;
constexpr size_t WS_WGLU  = WS_WDN + (size_t)1024 * 2816 * 2;
constexpr size_t WS_MOD   = WS_WGLU + (size_t)512 * 512 * 2;
constexpr size_t WS_OSUM  = WS_MOD + (size_t)4 * 3 * 6144 * 4;
constexpr size_t WS_YS    = WS_OSUM + (size_t)NT * 512 * 4;
constexpr size_t WS_IMG   = WS_OSUM + (size_t)NT * 1024 * 4;
constexpr size_t WS_ZG    = WS_IMG + (size_t)1536 * 81984;
constexpr size_t WS_CE    = WS_ZG + (size_t)NT * 512 * 2;
constexpr size_t CARRY_SZ = (size_t)NSSEG * 2 * 4 * 64 * 128 * 4;
constexpr size_t WS_OB    = WS_CE;
constexpr size_t WS_CP    = WS_CE + CARRY_SZ;
constexpr size_t WS_CS    = WS_CP + CARRY_SZ;
constexpr size_t WS_C2E   = WS_CS + CARRY_SZ;
constexpr size_t C2_SZ    = (size_t)NSSEG * 2 * 32 * 64 * 2 * 4;
constexpr size_t WS_C2D   = WS_C2E + C2_SZ;
constexpr size_t WS_C2S   = WS_C2D + C2_SZ;
constexpr size_t WS_BAR   = WS_C2S + C2_SZ;
constexpr size_t WS_END   = WS_BAR + 32768;

constexpr size_t OUT_Y   = 0;
constexpr size_t OUT_GLA = (size_t)NT * 1024;
constexpr size_t OUT_RG  = OUT_GLA + (size_t)16 * 2 * 2 * 4 * 64 * 128;
constexpr size_t OUT_S5  = OUT_RG + (size_t)16 * 2 * 2 * 512;
constexpr size_t OUT_DN  = OUT_S5 + (size_t)16 * 2 * 2 * 32 * 64 * 2;

struct Params { const float* in[44]; float* out; unsigned char* ws; };

typedef const __attribute__((address_space(4))) char* kptr_t;
__device__ __forceinline__ kptr_t KARG() { kptr_t k = (kptr_t)__builtin_amdgcn_kernarg_segment_ptr(); asm volatile("" : "+s"(k)); return k; }
#define AS1 __attribute__((address_space(1)))
__device__ __forceinline__ const float* PIN(int i) { const float* q = *(const float* const __attribute__((address_space(4)))*)(KARG() + i * 8); return (const float*)(const AS1 float*)q; }
__device__ __forceinline__ float* POUT() { float* q = *(float* const __attribute__((address_space(4)))*)(KARG() + 44 * 8); return (float*)(AS1 float*)q; }
__device__ __forceinline__ unsigned char* WSP(const Params& p) { unsigned char* w = *(unsigned char* const __attribute__((address_space(4)))*)(KARG() + 45 * 8); asm volatile("" : "+s"(w)); return (unsigned char*)(AS1 unsigned char*)w; }
__device__ __forceinline__ void gatomic_add(float* q, float v) { (void)__builtin_amdgcn_global_atomic_fadd_f32((AS1 float*)q, v); }
enum { I_XP = 0, I_XS, I_SGLA, I_SRG, I_SS5, I_SDN, I_C, I_CCTX, I_N1W, I_N2W, I_WMOD, I_BMOD, I_ABIN, I_ABOUT, I_WG2, I_BG, I_GLANW,
       I_RGCW, I_RGCB, I_RGWA, I_RGBA, I_RGWX, I_RGBX, I_RGLAM, I_CDIN, I_CDOUT, I_LAMRE, I_LAMIM, I_LOGDT, I_BRE, I_BIM, I_CRE, I_CIM,
       I_S5D, I_GLUW, I_GLUB, I_DNCW, I_ALOG, I_DTB, I_DNNW, I_FG, I_FU, I_FD, I_FNW };

__device__ __forceinline__ float bf2f(bf16_t b) { return __uint_as_float(((unsigned)b) << 16); }
__device__ __forceinline__ float bflo(unsigned w) { return __uint_as_float(w << 16); }
__device__ __forceinline__ float bfhi(unsigned w) { return __uint_as_float(w & 0xffff0000u); }
typedef __bf16 bf16x2_t __attribute__((ext_vector_type(2)));
__device__ __forceinline__ unsigned pk2(float lo, float hi) { f32x2 f = {lo, hi}; bf16x2_t r = __builtin_convertvector(f, bf16x2_t); return __builtin_bit_cast(unsigned, r); }
__device__ __forceinline__ unsigned f2bf(float f) { return pk2(f, 0.f) & 0xffffu; }
__device__ __forceinline__ float rdl(float v, int l) { return __int_as_float(__builtin_amdgcn_readlane(__float_as_int(v), l)); }
__device__ __forceinline__ float sigmoidf_(float x) { return __builtin_amdgcn_rcpf(1.0f + __expf(-x)); }
__device__ __forceinline__ float siluf_(float x) { return x * __builtin_amdgcn_rcpf(1.0f + __expf(-x)); }
__device__ __forceinline__ float softplusf_(float x) { return fmaxf(x, 0.f) + __logf(1.0f + __expf(-fabsf(x))); }
__device__ __forceinline__ float geluf_(float x) { return x * sigmoidf_(1.5957691216057308f * (x + 0.044715f * x * x * x)); }
__device__ __forceinline__ float wave_sum(float v) {
#pragma unroll
    for (int o = 32; o >= 1; o >>= 1) v += __shfl_xor(v, o);
    return v;
}
__device__ __forceinline__ int cv_of_tok(int t) { return t < 4096 ? 0 : 1 + ((t - 4096) >> 12); }
__device__ __forceinline__ void seq_bounds(int t, int& lo, int& hi) { if (t < 4096) { lo = t & ~255; hi = lo + 256; } else { lo = 4096 + ((t - 4096) & ~4095); hi = lo + 4096; } }

#define XB_TMO      128
#define XB_XCNT(j)  (256  + 64 * (j))
#define XB_XSUB(j)  (1280 + 64 * (j))
#define XB_XGEN(j)  (2304 + 64 * (j))
#define XB_TOP      3328
#define XB_TOPGEN   3392
#define XCD_BAR_WORDS 3456
#define XB_SPIN_CAP (1u << 18)

__device__ __forceinline__ unsigned xb_ld(unsigned* p)              { return __hip_atomic_load(p, __ATOMIC_RELAXED, __HIP_MEMORY_SCOPE_AGENT); }
__device__ __forceinline__ unsigned xb_add(unsigned* p, unsigned v) { return __hip_atomic_fetch_add(p, v, __ATOMIC_RELAXED, __HIP_MEMORY_SCOPE_AGENT); }
__device__ __forceinline__ unsigned xb_xcc_id() { return (unsigned)__builtin_amdgcn_s_getreg((3 << 11) | 20) & 0xFu; }
#define XB_SPIN(cond, bar) do { unsigned _sp = 0; while (cond) { __builtin_amdgcn_s_sleep(1); \
    if ((++_sp & 255u) == 0u) { if (xb_ld(&(bar)[XB_TMO])) break; if (_sp > XB_SPIN_CAP) { atomicAdd(&(bar)[XB_TMO], 1u); break; } } } } while (0)
struct XcdBarrier {
    unsigned* bar; unsigned x; unsigned G;
    volatile LAS unsigned* st;
};

__device__ __forceinline__ XcdBarrier xcd_barrier_post(unsigned* bar, volatile LAS unsigned* st, unsigned G) {
    XcdBarrier b; b.bar = bar; b.x = xb_xcc_id(); b.st = st; b.G = G;
    if (threadIdx.x == 0) (void)xb_add(&bar[XB_XCNT(b.x)], 1u);
    return b;
}
__device__ __forceinline__ void xcd_barrier_complete(unsigned* bar, unsigned x, unsigned G, unsigned& nloc, unsigned& nx) {
    unsigned sum, cnt, mine, sp = 0u;
    for (;;) {
        sum = 0u; cnt = 0u; mine = 0u;
#pragma unroll
        for (unsigned j = 0; j < 16; ++j) { const unsigned c = xb_ld(&bar[XB_XCNT(j)]); sum += c; cnt += (c > 0u) ? 1u : 0u; mine = (j == x) ? c : mine; }
        if (sum == G) break;
        __builtin_amdgcn_s_sleep(1);
        if ((++sp & 255u) == 0u) { if (xb_ld(&bar[XB_TMO])) break; if (sp > XB_SPIN_CAP) { atomicAdd(&bar[XB_TMO], 1u); break; } }
    }
    nloc = mine > 0u ? mine : 1u; nx = cnt > 0u ? cnt : 1u;
}

__device__ __forceinline__ void xcd_barrier(const XcdBarrier& b) {
    asm volatile("s_waitcnt vmcnt(0)" ::: "memory");
    __syncthreads();
    if (threadIdx.x == 0) {
        unsigned* bar = b.bar;
        __builtin_amdgcn_s_waitcnt(0);
        unsigned nloc = b.st[0], nx = b.st[1];
        if (nloc == 0u) { xcd_barrier_complete(bar, b.x, b.G, nloc, nx); b.st[0] = nloc; b.st[1] = nx; }
        const unsigned old = xb_add(&bar[XB_XSUB(b.x)], 1u);
        const unsigned gen = old / nloc;
        if (old + 1u == (gen + 1u) * nloc) {
            __builtin_amdgcn_fence(__ATOMIC_RELEASE, "agent");
            asm volatile("s_waitcnt vmcnt(0)" ::: "memory");
            const unsigned og = xb_add(&bar[XB_TOP], 1u);
            const unsigned tg = og / nx;
            if (og + 1u == (tg + 1u) * nx) xb_add(&bar[XB_TOPGEN], 1u);
            else XB_SPIN(xb_ld(&bar[XB_TOPGEN]) == tg, bar);
            __builtin_amdgcn_fence(__ATOMIC_ACQUIRE, "agent");
            xb_add(&bar[XB_XGEN(b.x)], 1u);
            asm volatile("s_waitcnt vmcnt(0)" ::: "memory");
        } else {
            XB_SPIN(xb_ld(&bar[XB_XGEN(b.x)]) == gen, bar);
            __builtin_amdgcn_fence(__ATOMIC_ACQUIRE, "agent");
            asm volatile("s_waitcnt vmcnt(0)" ::: "memory");
        }
    }
    __syncthreads();
}

struct EpiProj {
    static constexpr bool PERM = true, AFTER_DRAIN = false;
    bf16_t* O; int ldc;
    __device__ __forceinline__ void operator()(const f32x4 (&acc)[2][2][4][2], const Unit& u, int wr, int wc, int fr, int fq) const {
        const int row0 = u.pm * 256 + wr * 64 + fr, col0 = u.pn * 256 + wc * 32 + 8 * fq;
#pragma unroll
        for (int ai = 0; ai < 2; ++ai)
#pragma unroll
            for (int m = 0; m < 4; ++m) { bf16_t* rowp = O + (size_t)(row0 + ai * 128 + m * 16) * ldc + col0;
#pragma unroll
                for (int bj = 0; bj < 2; ++bj) { const f32x4 v0 = acc[ai][bj][m][0], v1 = acc[ai][bj][m][1];
                    u32x4 w; w.x = pk2(v0[0], v0[1]); w.y = pk2(v0[2], v0[3]); w.z = pk2(v1[0], v1[1]); w.w = pk2(v1[2], v1[3]);
                    *(u32x4*)(rowp + bj * 128) = w; } }
    }
};
struct EpiResid {
    static constexpr bool PERM = false, AFTER_DRAIN = false;
    float* X; const float* gate;
    __device__ __forceinline__ void operator()(const f32x4 (&acc)[2][2][4][2], const Unit& u, int wr, int wc, int fr, int fq) const {
        const int row0 = u.pm * 256 + wr * 64 + fr, col0 = u.pn * 256 + wc * 32 + 4 * fq;
        const int cv = u.pm < 16 ? 0 : 1 + ((u.pm - 16) >> 4);
        const float* gp = gate + cv * 6144 + col0;
        f32x4 gv[2][2];
#pragma unroll
        for (int bj = 0; bj < 2; ++bj)
#pragma unroll
            for (int n = 0; n < 2; ++n) gv[bj][n] = *(const f32x4*)(gp + bj * 128 + n * 16);
#pragma unroll
        for (int ai = 0; ai < 2; ++ai)
#pragma unroll
            for (int m = 0; m < 4; ++m) { float* rowp = X + (size_t)(row0 + ai * 128 + m * 16) * 1024 + col0;
#pragma unroll
                for (int bj = 0; bj < 2; ++bj)
#pragma unroll
                    for (int n = 0; n < 2; ++n) { f32x4* q = (f32x4*)(rowp + bj * 128 + n * 16); *q = *q + gv[bj][n] * acc[ai][bj][m][n]; } }
    }
};
struct EpiSwiGLU {
    static constexpr bool PERM = true, AFTER_DRAIN = false;
    bf16_t* O;
    __device__ __forceinline__ void operator()(const f32x4 (&acc)[2][2][4][2], const Unit& u, int wr, int wc, int fr, int fq) const {
        const int row0 = u.pm * 256 + wr * 64 + fr, col0 = u.pn * 128 + wc * 32 + 8 * fq;
#pragma unroll
        for (int ai = 0; ai < 2; ++ai)
#pragma unroll
            for (int m = 0; m < 4; ++m) { bf16_t* rowp = O + (size_t)(row0 + ai * 128 + m * 16) * DFF + col0;
                float r[8];
#pragma unroll
                for (int n = 0; n < 2; ++n)
#pragma unroll
                    for (int j = 0; j < 4; ++j) { const float g = acc[ai][0][m][n][j], up = acc[ai][1][m][n][j]; r[n * 4 + j] = g * __builtin_amdgcn_rcpf(1.0f + __expf(-g)) * up; }
                u32x4 w; w.x = pk2(r[0], r[1]); w.y = pk2(r[2], r[3]); w.z = pk2(r[4], r[5]); w.w = pk2(r[6], r[7]);
                *(u32x4*)rowp = w; }
    }
};
struct EpiGLU {
    static constexpr bool PERM = true, AFTER_DRAIN = false;
    bf16_t* O; const bf16_t* ZG; const float* bias;
    __device__ __forceinline__ void operator()(const f32x4 (&acc)[2][2][4][2], const Unit& u, int wr, int wc, int fr, int fq) const {
        const int row0 = u.pm * 256 + wr * 64 + fr, col0 = u.pn * 256 + wc * 32 + 8 * fq;
#pragma unroll
        for (int ai = 0; ai < 2; ++ai)
#pragma unroll
            for (int m = 0; m < 4; ++m) { const int row = row0 + ai * 128 + m * 16;
#pragma unroll
                for (int bj = 0; bj < 2; ++bj) { const int c = col0 + bj * 128;
                    const u32x4 z = *(const u32x4*)(ZG + (size_t)row * 512 + c);
                    const f32x4 b0 = *(const f32x4*)(bias + c), b1 = *(const f32x4*)(bias + c + 4);
                    const f32x4 v0 = acc[ai][bj][m][0] + b0, v1 = acc[ai][bj][m][1] + b1;
                    float r[8];
                    r[0] = bflo(z.x) * sigmoidf_(v0[0]); r[1] = bfhi(z.x) * sigmoidf_(v0[1]); r[2] = bflo(z.y) * sigmoidf_(v0[2]); r[3] = bfhi(z.y) * sigmoidf_(v0[3]);
                    r[4] = bflo(z.z) * sigmoidf_(v1[0]); r[5] = bfhi(z.z) * sigmoidf_(v1[1]); r[6] = bflo(z.w) * sigmoidf_(v1[2]); r[7] = bfhi(z.w) * sigmoidf_(v1[3]);
                    u32x4 w; w.x = pk2(r[0], r[1]); w.y = pk2(r[2], r[3]); w.z = pk2(r[4], r[5]); w.w = pk2(r[6], r[7]);
                    *(u32x4*)(O + (size_t)row * 1024 + c) = w; } }
    }
};

__device__ __forceinline__ void prep_mat(LAS unsigned char* lds, bf16_t* dst, int NR, int K, const float* src0, const float* src1, int ldsrc, int nvalid, int mode, int fb = 0) {
    LAS float* tl = (LAS float*)lds;
    const int tid = otid(), ntn = NR >> 6, ntk = K >> 7, ntile = ntn * ntk;
    for (int tile = obid() - fb; tile < ntile; tile += gridDim.x - fb) {
        const int n0 = (tile % ntn) * 64, k0 = (tile / ntn) * 128;
        { const int nl = tid & 63, kl0 = tid >> 6, n = n0 + nl; const float* sp = src0; int col;
          if (mode == 0) col = n < nvalid ? n : -1; else { col = ((n >> 8) << 7) + (n & 127); if ((n >> 7) & 1) sp = src1; }
          float v[16];
#pragma unroll
          for (int i = 0; i < 16; ++i) v[i] = col >= 0 ? sp[(size_t)(k0 + kl0 + 8 * i) * ldsrc + col] : 0.f;
#pragma unroll
          for (int i = 0; i < 16; ++i) tl[(kl0 + 8 * i) * 65 + nl] = v[i]; }
        __syncthreads();
        { const int nl = tid >> 3, ks = tid & 7;
#pragma unroll
          for (int h = 0; h < 2; ++h) { float v[8];
#pragma unroll
            for (int jq = 0; jq < 8; ++jq) v[jq] = tl[(h * 64 + ks * 8 + jq) * 65 + nl];
            u32x4 w; w.x = pk2(v[0], v[1]); w.y = pk2(v[2], v[3]); w.z = pk2(v[4], v[5]); w.w = pk2(v[6], v[7]);
            *(u32x4*)(dst + (size_t)(n0 + nl) * K + k0 + h * 64 + ks * 8) = w; } }
        __syncthreads();
    }
}
__device__ __forceinline__ void prep_in_out(const Params& p, LAS unsigned char* lds, int l, int fb) {
    unsigned char* ws = WSP(p); const int jl = l >> 1;
    if ((l & 1) == 0) { prep_mat(lds, (bf16_t*)(ws + WS_WIN), 2816, 1024, PIN(I_ABIN) + (size_t)jl * 1024 * 2592, nullptr, 2592, 2592, 0, fb);
                        prep_mat(lds, (bf16_t*)(ws + WS_WOUT), 1024, 1024, PIN(I_ABOUT) + (size_t)jl * 1024 * 1024, nullptr, 1024, 1024, 0, fb); }
    else { prep_mat(lds, (bf16_t*)(ws + WS_WIN), 2816, 1024, PIN(I_CDIN) + (size_t)jl * 1024 * 2576, nullptr, 2576, 2576, 0, fb);
           prep_mat(lds, (bf16_t*)(ws + WS_WOUT), 1024, 1024, PIN(I_CDOUT) + (size_t)jl * 1024 * 1024, nullptr, 1024, 1024, 0, fb); }
}
__device__ __forceinline__ void prep_rest(const Params& p, LAS unsigned char* lds, int l) {
    unsigned char* ws = WSP(p); const int jl = l >> 1;
    if (l & 1) prep_mat(lds, (bf16_t*)(ws + WS_WGLU), 512, 512, PIN(I_GLUW) + (size_t)jl * 512 * 512, nullptr, 512, 512, 0);
    prep_mat(lds, (bf16_t*)(ws + WS_WGU), 5632, 1024, PIN(I_FG) + (size_t)l * 1024 * 2816, PIN(I_FU) + (size_t)l * 1024 * 2816, 2816, 0, 1);
    prep_mat(lds, (bf16_t*)(ws + WS_WDN), 1024, 2816, PIN(I_FD) + (size_t)l * 2816 * 1024, nullptr, 1024, 1024, 0);
}
__device__ __forceinline__ void phase0(const Params& p, LAS unsigned char* lds) {
    const int tid = otid(), G = gridDim.x;
    {
        LAS float* sc = (LAS float*)lds;
        LAS float* red = (LAS float*)(lds + 16384);
        for (int i = tid; i < 3072; i += 512) { const int cv = i >> 10, k = i & 1023; const float c = cv == 0 ? PIN(I_CCTX)[k] : PIN(I_C)[(cv - 1) * 1024 + k]; sc[i] = siluf_(c); }
        __syncthreads();
        const int w = tid >> 6, lane = tid & 63;
        for (int item = obid(); item < 384; item += G) {
            const int l = item / 96, col = (item % 96) * 64 + lane;
            const float* wp = PIN(I_WMOD) + (size_t)l * 1024 * 6144 + (size_t)(w * 128) * 6144 + col;
            float a0 = 0.f, a1 = 0.f, a2 = 0.f;
#pragma unroll 8
            for (int k = 0; k < 128; ++k) { const float wv = wp[(size_t)k * 6144]; const int kk = w * 128 + k; a0 += sc[kk] * wv; a1 += sc[1024 + kk] * wv; a2 += sc[2048 + kk] * wv; }
            red[(w * 3 + 0) * 64 + lane] = a0; red[(w * 3 + 1) * 64 + lane] = a1; red[(w * 3 + 2) * 64 + lane] = a2;
            __syncthreads();
            if (tid < 192) { const int cv = tid >> 6, ln = tid & 63, c2 = (item % 96) * 64 + ln; float s = PIN(I_BMOD)[l * 6144 + c2];
#pragma unroll
                for (int ww = 0; ww < 8; ++ww) s += red[(ww * 3 + cv) * 64 + ln];
                ((float*)(WSP(p) + WS_MOD))[(l * 3 + cv) * 6144 + c2] = s; }
            __syncthreads();
        }
    }
    {
        float4* X = (float4*)(WSP(p) + WS_X);
        const float4* xp = (const float4*)PIN(I_XP); const float4* xs = (const float4*)PIN(I_XS);
        for (size_t i = (size_t)obid() * 512 + tid; i < (size_t)NT * 256; i += (size_t)G * 512) {
            const int t = (int)(i >> 8), d4 = (int)(i & 255) * 4;
            float4 v;
            if (t < 4096) v = xp[i];
            else { v = xs[i - (size_t)4096 * 256]; const int tt = (t - 4096) & 4095; const float row = (float)(tt >> 6), colf = (float)(tt & 63);
                float pe[4];
#pragma unroll
                for (int j = 0; j < 4; ++j) { const int d = d4 + j, q = d >> 8, fi = d & 255; const float fr = __expf(-9.210340371976184f * (float)fi / 256.0f);
                    const float arg = (q < 2 ? row : colf) * fr; pe[j] = (q & 1) ? cosf(arg) : sinf(arg); }
                v.x += pe[0]; v.y += pe[1]; v.z += pe[2]; v.w += pe[3]; }
            X[i] = v;
        }
    }
    prep_in_out(p, lds, 0, 0); prep_rest(p, lds, 0);
}

template <bool FINAL>
__device__ __forceinline__ void norm_phase(const float* X, const float* w, const float* shift, const float* scale, bf16_t* hn, float* yout) {
    const int lane = otid() & 63, gw = obid() * 8 + (otid() >> 6), nw = gridDim.x * 8;
    float4 vn[4];
    if (gw < NT) { const float4* xr = (const float4*)(X + (size_t)gw * 1024);
#pragma unroll
        for (int i = 0; i < 4; ++i) vn[i] = xr[i * 64 + lane]; }
    for (int row = gw; row < NT; row += nw) {
        float4 v[4]; float ss = 0.f;
#pragma unroll
        for (int i = 0; i < 4; ++i) v[i] = vn[i];
        if (row + nw < NT) { const float4* xr = (const float4*)(X + (size_t)(row + nw) * 1024);
#pragma unroll
            for (int i = 0; i < 4; ++i) vn[i] = xr[i * 64 + lane]; }
#pragma unroll
        for (int i = 0; i < 4; ++i) ss += v[i].x * v[i].x + v[i].y * v[i].y + v[i].z * v[i].z + v[i].w * v[i].w;
        ss = wave_sum(ss);
        const float rs = rsqrtf(ss * (1.0f / 1024.0f) + EPS);
        const int cv = cv_of_tok(row);
#pragma unroll
        for (int i = 0; i < 4; ++i) { const int c = i * 256 + lane * 4; const float4 wv = *(const float4*)(w + c);
            if (FINAL) { float4 o; o.x = v[i].x * rs * wv.x; o.y = v[i].y * rs * wv.y; o.z = v[i].z * rs * wv.z; o.w = v[i].w * rs * wv.w; *(float4*)(yout + (size_t)row * 1024 + c) = o; }
            else { const float4 sh = *(const float4*)(shift + cv * 6144 + c), sl = *(const float4*)(scale + cv * 6144 + c);
                u32x2 o; o.x = pk2(v[i].x * rs * wv.x * (1.f + sl.x) + sh.x, v[i].y * rs * wv.y * (1.f + sl.y) + sh.y);
                o.y = pk2(v[i].z * rs * wv.z * (1.f + sl.z) + sh.z, v[i].w * rs * wv.w * (1.f + sl.w) + sh.w);
                *(u32x2*)(hn + (size_t)row * 1024 + c) = o; } }
    }
}
__device__ __forceinline__ void zero_osum(const Params& p) {
    float4* o = (float4*)(WSP(p) + WS_YS); float zz = 0.f; asm volatile("" : "+v"(zz)); const float4 z = {zz, zz, zz, zz};
    for (size_t i = (size_t)obid() * 512 + otid(); i < (size_t)NT * 128; i += (size_t)gridDim.x * 512) o[i] = z;
}

__device__ __forceinline__ void chain_combine(const Params& p, const float* nw, int gate_col, int mix_col, int fb = 0) {
    const int lane = otid() & 63, gw = (obid() - fb) * 8 + (otid() >> 6), nwv = (gridDim.x - fb) * 8;
    const bf16_t* proj = (const bf16_t*)(WSP(p) + WS_PROJ); const float* oa = (const float*)(WSP(p) + WS_OSUM); const float* ob = (const float*)(WSP(p) + WS_OB); bf16_t* mixed = (bf16_t*)(WSP(p) + WS_HN);
    for (int tg = gw; tg < NT / 4; tg += nwv) {
#pragma unroll
        for (int hd = 0; hd < 4; ++hd) { const int c = hd * 128 + 2 * lane; const size_t o = ((size_t)tg * 512 + c) * 4;
            const f32x4 a0 = *(const f32x4*)(oa + o) + *(const f32x4*)(ob + o), a1 = *(const f32x4*)(oa + o + 4) + *(const f32x4*)(ob + o + 4);
            const float2 nw2 = *(const float2*)(nw + 2 * lane);
#pragma unroll
            for (int k = 0; k < 4; ++k) { const float ss = wave_sum(a0[k] * a0[k] + a1[k] * a1[k]); const float rs = rsqrtf(ss * (1.0f / 128.0f) + EPS); const int t = tg * 4 + k;
                const unsigned g = *(const unsigned*)(proj + (size_t)t * PLD + gate_col + c);
                *(unsigned*)(mixed + (size_t)t * 1024 + mix_col + c) = pk2(a0[k] * rs * nw2.x * siluf_(bflo(g)), a1[k] * rs * nw2.y * siluf_(bfhi(g))); } }
    }
}
__device__ __forceinline__ void ab_combine(const Params& p, int jl) { chain_combine(p, PIN(I_GLANW) + jl * 128, 1024, 0); }

__device__ __forceinline__ void lds_barrier() { asm volatile("s_waitcnt lgkmcnt(0)" ::: "memory"); __builtin_amdgcn_s_barrier(); asm volatile("" ::: "memory"); }
typedef short bf16x8_t __attribute__((ext_vector_type(8)));
__device__ __forceinline__ unsigned cvtpk(float lo, float hi) { return pk2(lo, hi); }

typedef float f32x16 __attribute__((ext_vector_type(16)));
constexpr int IMG_W = 0, IMG_QD = 17408, IMG_QK = 34816, IMG_KE = 44032, IMG_UT = 62464  , IMG_GE = 79872, IMG_STAGE = 79888, IMG_BYTES = 79888;
__device__ __forceinline__ int kact16(int j, int hh) { return j < 4 ? 4 * hh + j : 8 + 4 * hh + (j - 4); }

__device__ __forceinline__ void dn_pre(const Params& p, LAS unsigned char* lds, int jl, int which, int fb) {
    const int tid = otid(), lane = tid & 63, wave = __builtin_amdgcn_readfirstlane(tid >> 6);
    const bf16_t* proj = (const bf16_t*)(WSP(p) + WS_PROJ);
    LAS unsigned char* Qs = lds; LAS unsigned char* Ks = lds + 17408; LAS unsigned char* Vs = lds + 34816;
    LAS float* KKs = (LAS float*)(lds + 52224); LAS float* QKs = (LAS float*)(lds + 68864);
    LAS float* As = (LAS float*)(lds + 85504);
    LAS float* las = (LAS float*)(lds + 118272); LAS float* bes = las + 128; LAS float* gs = las + 256;
    LAS float* scl = las + 384;
    for (int it = obid() - fb; it < (which ? 256 : 512); it += gridDim.x - fb) {
        const int c = (which ? 0 : 64) + (it >> 2), head = it & 3, t0 = c * 64; int lo, hi; seq_bounds(t0, lo, hi);
        { const int i = tid >> 3, part = tid & 7;
          u32x4 xin[3][4][2];
#pragma unroll
          for (int ten = 0; ten < 3; ++ten)
#pragma unroll
            for (int tap = 0; tap < 4; ++tap) { const int tt = t0 + i + tap - 1; const bool ok = tt >= lo && tt < hi; const bf16_t* px = proj + (size_t)(ok ? tt : t0) * PLD + 512 + ten * 512 + head * 128 + part * 16;
                const u32x4 z4 = {0u, 0u, 0u, 0u}; xin[ten][tap][0] = ok ? *(const u32x4*)px : z4; xin[ten][tap][1] = ok ? *(const u32x4*)(px + 8) : z4; }
#pragma unroll
          for (int ten = 0; ten < 3; ++ten) { const int cb = ten * 512 + head * 128 + part * 16; float acc[16];
#pragma unroll
            for (int e = 0; e < 16; ++e) acc[e] = 0.f;
#pragma unroll
            for (int tap = 0; tap < 4; ++tap) { const u32x4 x0 = xin[ten][tap][0], x1 = xin[ten][tap][1];
                    const float* wp = PIN(I_DNCW) + (size_t)(jl * 4 + tap) * 1536 + cb; const f32x4 w0 = *(const f32x4*)wp, w1 = *(const f32x4*)(wp + 4), w2 = *(const f32x4*)(wp + 8), w3 = *(const f32x4*)(wp + 12);
                    acc[0] += w0[0] * bflo(x0.x); acc[1] += w0[1] * bfhi(x0.x); acc[2] += w0[2] * bflo(x0.y); acc[3] += w0[3] * bfhi(x0.y);
                    acc[4] += w1[0] * bflo(x0.z); acc[5] += w1[1] * bfhi(x0.z); acc[6] += w1[2] * bflo(x0.w); acc[7] += w1[3] * bfhi(x0.w);
                    acc[8] += w2[0] * bflo(x1.x); acc[9] += w2[1] * bfhi(x1.x); acc[10] += w2[2] * bflo(x1.y); acc[11] += w2[3] * bfhi(x1.y);
                    acc[12] += w3[0] * bflo(x1.z); acc[13] += w3[1] * bfhi(x1.z); acc[14] += w3[2] * bflo(x1.w); acc[15] += w3[3] * bfhi(x1.w); }
            float ss = 0.f;
#pragma unroll
            for (int e = 0; e < 16; ++e) { acc[e] = siluf_(acc[e]); ss += acc[e] * acc[e]; }
            if (ten < 2) { ss += __shfl_xor(ss, 1); ss += __shfl_xor(ss, 2); ss += __shfl_xor(ss, 4); float rs = rsqrtf(ss + 1e-6f); if (ten == 0) rs *= 0.08838834764831845f;
#pragma unroll
                for (int e = 0; e < 16; ++e) acc[e] *= rs; }
            u32x4 o0, o1; o0.x = pk2(acc[0], acc[1]); o0.y = pk2(acc[2], acc[3]); o0.z = pk2(acc[4], acc[5]); o0.w = pk2(acc[6], acc[7]);
            o1.x = pk2(acc[8], acc[9]); o1.y = pk2(acc[10], acc[11]); o1.z = pk2(acc[12], acc[13]); o1.w = pk2(acc[14], acc[15]);
            LAS unsigned char* dst = lds + ten * 17408 + i * 272 + part * 32;
            *(LAS u32x4*)dst = o0; *(LAS u32x4*)(dst + 16) = o1; }
          if (tid < 128) { const int dir = tid >> 6, ii = tid & 63; const bf16_t* pr = proj + (size_t)(t0 + ii) * PLD;
            const float ai = bf2f(pr[2560 + dir * 4 + head]), bi = bf2f(pr[2568 + dir * 4 + head]);
            las[dir * 64 + ii] = -__expf(PIN(I_ALOG)[(jl * 2 + dir) * 4 + head]) * softplusf_(ai + PIN(I_DTB)[(jl * 2 + dir) * 4 + head]);
            bes[dir * 64 + ii] = sigmoidf_(bi); } }
        __syncthreads();
        if (wave < 2) { const int dir = wave; float x = las[dir * 64 + (dir ? 63 - lane : lane)];
#pragma unroll
            for (int off = 1; off < 64; off <<= 1) { const float y = __shfl_up(x, off); if (lane >= off) x += y; }
            gs[dir * 64 + lane] = x; }
        { const int which = wave >> 2, mb = (wave >> 1) & 1, nb = wave & 1, r = lane & 31, hh = lane >> 5;
          const LAS unsigned char* Ab = (which ? Qs : Ks) + (32 * mb + r) * 272 + hh * 16; const LAS unsigned char* Bb = Ks + (32 * nb + r) * 272 + hh * 16;
          f32x16 acc;
#pragma unroll
          for (int e = 0; e < 16; ++e) acc[e] = 0.f;
#pragma unroll
          for (int ks = 0; ks < 8; ++ks) { const bf16x8_t a = *(const LAS bf16x8_t*)(Ab + ks * 32), b = *(const LAS bf16x8_t*)(Bb + ks * 32); acc = __builtin_amdgcn_mfma_f32_32x32x16_bf16(a, b, acc, 0, 0, 0); }
          LAS float* dst = which ? QKs : KKs;
#pragma unroll
          for (int e = 0; e < 16; ++e) dst[(32 * mb + (e & 3) + 8 * (e >> 2) + 4 * hh) * 65 + 32 * nb + r] = acc[e]; }
        __syncthreads();
        for (int e = tid; e < 8192; e += 512) { const int dir = e >> 12, i = (e >> 6) & 63, j = e & 63; const int pi = dir ? 63 - i : i, pj = dir ? 63 - j : j;
            As[e] = j < i ? bes[dir * 64 + pi] * KKs[pi * 65 + pj] * __expf(gs[dir * 64 + i] - gs[dir * 64 + j]) : 0.f; }
        for (int u = tid; u < 2048; u += 512) {
            const int hh = u & 1, ks = (u >> 1) & 7, i = (u >> 4) & 63, dir = u >> 10, pi = dir ? 63 - i : i; const float eg = __expf(gs[dir * 64 + i]);
            const u32x2 q0 = *(const LAS u32x2*)(Qs + pi * 272 + (16 * ks + 4 * hh) * 2), q1 = *(const LAS u32x2*)(Qs + pi * 272 + (16 * ks + 8 + 4 * hh) * 2);
            u32x4 o; o.x = pk2(bflo(q0.x) * eg, bfhi(q0.x) * eg); o.y = pk2(bflo(q0.y) * eg, bfhi(q0.y) * eg); o.z = pk2(bflo(q1.x) * eg, bfhi(q1.x) * eg); o.w = pk2(bflo(q1.y) * eg, bfhi(q1.y) * eg);
            *(u32x4*)(WSP(p) + WS_IMG + (size_t)((c * 4 + head) * 2 + dir) * IMG_BYTES + IMG_QD + i * 272 + (16 * ks + 8 * hh) * 2) = o; }
        for (int u = tid; u < 1024; u += 512) {
            const int hh = u & 1, ks = (u >> 1) & 3, i = (u >> 3) & 63, dir = u >> 9, pi = dir ? 63 - i : i; const float gi = gs[dir * 64 + i]; float v[8];
#pragma unroll
            for (int j = 0; j < 8; ++j) { const int ja = 16 * ks + kact16(j, hh), pj = dir ? 63 - ja : ja; v[j] = ja <= i ? QKs[pi * 65 + pj] * __expf(gi - gs[dir * 64 + ja]) : 0.f; }
            u32x4 o; o.x = pk2(v[0], v[1]); o.y = pk2(v[2], v[3]); o.z = pk2(v[4], v[5]); o.w = pk2(v[6], v[7]);
            *(u32x4*)(WSP(p) + WS_IMG + (size_t)((c * 4 + head) * 2 + dir) * IMG_BYTES + IMG_QK + i * 144 + (16 * ks + 8 * hh) * 2) = o; }
        for (int u = tid; u < 2048; u += 512) {
            const int k = u & 127, hh = (u >> 7) & 1, ks = (u >> 8) & 3, dir = u >> 10; const float ge = gs[dir * 64 + 63]; float v[8];
#pragma unroll
            for (int j = 0; j < 8; ++j) { const int ja = 16 * ks + kact16(j, hh), pj = dir ? 63 - ja : ja; v[j] = bf2f(*(const LAS bf16_t*)(Ks + pj * 272 + k * 2)) * __expf(ge - gs[dir * 64 + ja]); }
            u32x4 o; o.x = pk2(v[0], v[1]); o.y = pk2(v[2], v[3]); o.z = pk2(v[4], v[5]); o.w = pk2(v[6], v[7]);
            *(u32x4*)(WSP(p) + WS_IMG + (size_t)((c * 4 + head) * 2 + dir) * IMG_BYTES + IMG_KE + k * 144 + (16 * ks + 8 * hh) * 2) = o; }
        if (tid < 2) *(float*)(WSP(p) + WS_IMG + (size_t)((c * 4 + head) * 2 + tid) * IMG_BYTES + IMG_GE) = __expf(gs[tid * 64 + 63]);
        if (tid < 256) { const int i = tid & 63, w = (tid >> 6) & 1, dir = tid >> 7; const float b = bes[dir * 64 + (dir ? 63 - i : i)]; scl[tid] = w ? b * __expf(gs[dir * 64 + i]) : b; }
        __syncthreads();
        { int dir = wave >> 2; asm volatile("" : "+s"(dir)); const int part = wave & 3, isW = part >> 1, cc = (part & 1) * 64 + lane;
          const LAS float* Ad = As + dir * 4096; const LAS float* sp = scl + (dir * 2 + isW) * 64;
          const LAS unsigned char* srcp = (isW ? Ks : Vs) + cc * 2 + (dir ? 63 * 272 : 0); const int sstep = dir ? -272 : 272;
          float x[64];
#pragma unroll
          for (int i = 0; i < 64; ++i) { asm volatile("" : "+v"(srcp) :: "memory");
              float a0 = sp[i] * bf2f(*(const LAS bf16_t*)srcp), a1 = 0.f; srcp += sstep;
#pragma unroll
              for (int j4 = 0; j4 < i; j4 += 4) { const f32x4 av = *(const LAS f32x4*)(Ad + i * 64 + j4);
                  a0 -= av[0] * x[j4]; if (j4 + 1 < i) a1 -= av[1] * x[j4 + 1]; if (j4 + 2 < i) a0 -= av[2] * x[j4 + 2]; if (j4 + 3 < i) a1 -= av[3] * x[j4 + 3]; }
              x[i] = a0 + a1; }
          unsigned char* img = WSP(p) + WS_IMG + (size_t)((c * 4 + head) * 2 + dir) * IMG_BYTES;
          if (!isW) { unsigned char* ut = img + IMG_UT + cc * 136;
#pragma unroll
              for (int i = 0; i < 64; i += 4) { u32x2 o; o.x = pk2(x[i], x[i + 1]); o.y = pk2(x[i + 2], x[i + 3]); *(u32x2*)(ut + i * 2) = o; } }
          else { const int o16 = cc & 15, hh = (o16 >> 2) & 1, j = (o16 & 3) + ((o16 >> 3) << 2), pp = (cc & ~15) + 8 * hh + j; bf16_t* wp = (bf16_t*)(img + IMG_W) + pp;
#pragma unroll
              for (int i = 0; i < 64; ++i) wp[i * 136] = (bf16_t)f2bf(-x[i]); } }
        __syncthreads();
    }
}

template <int NCH, int STAGE, int BYTES, int D>
__device__ __forceinline__ void chain_loader(LAS unsigned char* lds, const unsigned char* imgbase, int c0, int cstep, int head, int dir, int lt) {
    constexpr int NCH16 = STAGE / 16, NL = (NCH16 + 255) / 256;
    asm volatile("" : "+s"(c0), "+s"(head));
    u32x4 ring[D][NL];
#pragma unroll
    for (int d = 1; d <= D; ++d) if (d < NCH) { const unsigned char* img = imgbase + (size_t)(((c0 + cstep * d) * 4 + head) * 2 + dir) * BYTES;
        const __attribute__((address_space(1))) unsigned char* gp = (const __attribute__((address_space(1))) unsigned char*)(img + lt * 16);
#pragma unroll
        for (int q = 0; q < NL; ++q) { asm volatile("" : "+v"(gp)); if ((q + 1) * 256 <= NCH16 || lt + q * 256 < NCH16) ring[d % D][q] = *(const __attribute__((address_space(1))) u32x4*)gp; gp += 4096; } }
    __syncthreads();
#pragma unroll
    for (int s = 0; s < NCH; ++s) {
        if (s + 1 < NCH) { LAS unsigned char* nb = lds + ((s + 1) & 1) * STAGE;
#pragma unroll
            for (int q = 0; q < NL; ++q) if ((q + 1) * 256 <= NCH16 || lt + q * 256 < NCH16) *(LAS u32x4*)(nb + (lt + q * 256) * 16) = ring[(s + 1) % D][q]; }
        if (s + 1 + D < NCH) { const unsigned char* img = imgbase + (size_t)(((c0 + cstep * (s + 1 + D)) * 4 + head) * 2 + dir) * BYTES;
            const __attribute__((address_space(1))) unsigned char* gp = (const __attribute__((address_space(1))) unsigned char*)(img + lt * 16);
#pragma unroll
            for (int q = 0; q < NL; ++q) { asm volatile("" : "+v"(gp)); if ((q + 1) * 256 <= NCH16 || lt + q * 256 < NCH16) ring[(s + 1) % D][q] = *(const __attribute__((address_space(1))) u32x4*)gp; gp += 4096; } }
        lds_barrier(); }
}
#define SBF(ks) __builtin_bit_cast(bf16x8_t, (u32x4){cvtpk(S[(ks) >> 1][((ks) & 1) * 8 + 0], S[(ks) >> 1][((ks) & 1) * 8 + 1]), cvtpk(S[(ks) >> 1][((ks) & 1) * 8 + 2], S[(ks) >> 1][((ks) & 1) * 8 + 3]), cvtpk(S[(ks) >> 1][((ks) & 1) * 8 + 4], S[(ks) >> 1][((ks) & 1) * 8 + 5]), cvtpk(S[(ks) >> 1][((ks) & 1) * 8 + 6], S[(ks) >> 1][((ks) & 1) * 8 + 7])})
__device__ __forceinline__ void dn_chain(const Params& p, LAS unsigned char* lds, int jl, int cfirst, int nch, int dir, int head, const float* s_init, float* s_out) {
    const int tid = otid(), lane = tid & 63, wave = __builtin_amdgcn_readfirstlane(tid >> 6), r = lane & 31, hh = lane >> 5;
    const unsigned char* imgbase = WSP(p) + WS_IMG; float* obuf = (float*)(WSP(p) + (dir ? WS_OB : WS_OSUM));
    const int cstep = dir ? -1 : 1, c0 = dir ? cfirst + nch - 1 : cfirst;
    { const unsigned char* img = imgbase + (size_t)((c0 * 4 + head) * 2 + dir) * IMG_BYTES;
      for (int q = tid; q < IMG_STAGE / 16; q += 512) *(LAS u32x4*)(lds + q * 16) = *(const u32x4*)(img + q * 16); }
    if (wave >= 4) {
        if (nch == 64) chain_loader<64, IMG_STAGE, IMG_BYTES, 2>(lds, imgbase, c0, cstep, head, dir, tid - 256); else chain_loader<4, IMG_STAGE, IMG_BYTES, 2>(lds, imgbase, c0, cstep, head, dir, tid - 256);
    } else {
        f32x16 S[4];
        const int col = wave * 32 + r;
        { const float* sp = s_init ? s_init + (4 * hh) * 128 + col : nullptr;
#pragma unroll
          for (int mb = 0; mb < 4; ++mb)
#pragma unroll
            for (int m = 0; m < 4; ++m) { asm volatile("" : "+v"(sp));
#pragma unroll
                for (int rr = 0; rr < 4; ++rr) S[mb][4 * m + rr] = sp ? sp[rr * 128] : 0.f;
                if (sp) sp += 8 * 128; } }
        __syncthreads();
        for (int s = 0; s < nch; ++s) {
            { const int cidx = c0 + cstep * s;
                LAS unsigned char* buf = lds + (s & 1) * IMG_STAGE;
                bf16x8_t sb[8];
#pragma unroll
                for (int ks = 0; ks < 8; ++ks) sb[ks] = SBF(ks);
                f32x16 Wn[2];
#pragma unroll
                for (int mb = 0; mb < 2; ++mb)
#pragma unroll
                    for (int m = 0; m < 4; ++m) { const u32x2 uv = *(const LAS u32x2*)(buf + IMG_UT + col * 136 + (32 * mb + 8 * m + 4 * hh) * 2);
                        Wn[mb][4 * m + 0] = bflo(uv.x); Wn[mb][4 * m + 1] = bfhi(uv.x); Wn[mb][4 * m + 2] = bflo(uv.y); Wn[mb][4 * m + 3] = bfhi(uv.y); }
                const float ge = *(const LAS float*)(buf + IMG_GE);
                asm volatile("" ::: "memory");
#pragma unroll
                for (int mb = 0; mb < 2; ++mb) { bf16x8_t af[8];
#pragma unroll
                    for (int ks = 0; ks < 8; ++ks) af[ks] = *(const LAS bf16x8_t*)(buf + IMG_W + (32 * mb + r) * 272 + (16 * ks + 8 * hh) * 2);
#pragma unroll
                    for (int ks = 0; ks < 8; ++ks) Wn[mb] = __builtin_amdgcn_mfma_f32_32x32x16_bf16(af[ks], sb[ks], Wn[mb], 0, 0, 0);
                    asm volatile("" ::: "memory"); }
                bf16x8_t wb[4];
#pragma unroll
                for (int ks = 0; ks < 4; ++ks) { u32x4 w; const int mb = ks >> 1, h8 = (ks & 1) * 8;
                    w.x = cvtpk(Wn[mb][h8 + 0], Wn[mb][h8 + 1]); w.y = cvtpk(Wn[mb][h8 + 2], Wn[mb][h8 + 3]); w.z = cvtpk(Wn[mb][h8 + 4], Wn[mb][h8 + 5]); w.w = cvtpk(Wn[mb][h8 + 6], Wn[mb][h8 + 7]); wb[ks] = __builtin_bit_cast(bf16x8_t, w); }
#pragma unroll
                for (int mb = 0; mb < 2; ++mb) { f32x16 O; asm volatile("" ::: "memory");
                    bf16x8_t af[8], ag[4];
#pragma unroll
                    for (int ks = 0; ks < 8; ++ks) af[ks] = *(const LAS bf16x8_t*)(buf + IMG_QD + (32 * mb + r) * 272 + (16 * ks + 8 * hh) * 2);
#pragma unroll
                    for (int ks = 0; ks < 4; ++ks) ag[ks] = *(const LAS bf16x8_t*)(buf + IMG_QK + (32 * mb + r) * 144 + (16 * ks + 8 * hh) * 2);
#pragma unroll
                    for (int e = 0; e < 16; ++e) O[e] = 0.f;
#pragma unroll
                    for (int ks = 0; ks < 8; ++ks) O = __builtin_amdgcn_mfma_f32_32x32x16_bf16(af[ks], sb[ks], O, 0, 0, 0);
#pragma unroll
                    for (int ks = 0; ks < 4; ++ks) O = __builtin_amdgcn_mfma_f32_32x32x16_bf16(ag[ks], wb[ks], O, 0, 0, 0);
#pragma unroll
                for (int m = 0; m < 4; ++m) { const int g4 = 8 * mb + 2 * m + hh, tg = cidx * 16 + (dir ? 15 - g4 : g4);
                    f32x4 ov; if (dir) { ov[0] = O[4 * m + 3]; ov[1] = O[4 * m + 2]; ov[2] = O[4 * m + 1]; ov[3] = O[4 * m + 0]; } else { ov[0] = O[4 * m + 0]; ov[1] = O[4 * m + 1]; ov[2] = O[4 * m + 2]; ov[3] = O[4 * m + 3]; }
                    *(f32x4*)(obuf + ((size_t)tg * 512 + head * 128 + col) * 4) = ov; } }
#pragma unroll
                for (int mp = 0; mp < 2; ++mp) { asm volatile("" ::: "memory"); bf16x8_t af[8];
#pragma unroll
                    for (int q = 0; q < 8; ++q) af[q] = *(const LAS bf16x8_t*)(buf + IMG_KE + (32 * (2 * mp + (q >> 2)) + r) * 144 + (16 * (q & 3) + 8 * hh) * 2);
#pragma unroll
                    for (int q = 0; q < 2; ++q) { const int mb = 2 * mp + q;
#pragma unroll
                        for (int e = 0; e < 16; ++e) S[mb][e] *= ge;
#pragma unroll
                        for (int ks = 0; ks < 4; ++ks) S[mb] = __builtin_amdgcn_mfma_f32_32x32x16_bf16(af[4 * q + ks], wb[ks], S[mb], 0, 0, 0); } }
                lds_barrier(); } }
        if (s_out) {
            float* sp = s_out + (4 * hh) * 128 + col;
#pragma unroll
            for (int mb = 0; mb < 4; ++mb)
#pragma unroll
                for (int m = 0; m < 4; ++m) { asm volatile("" : "+v"(sp));
#pragma unroll
                    for (int rr = 0; rr < 4; ++rr) sp[rr * 128] = S[mb][4 * m + rr];
                    sp += 8 * 128; }
        }
    }
}

template <bool PASSB>
__device__ __forceinline__ void s5_task(const Params& p, LAS unsigned char* lds, int jl, int seg, int dir, int g) {
    const int lane = otid() & 63, wave = __builtin_amdgcn_readfirstlane(otid() >> 6), r = lane & 31, hh = lane >> 5;
    const bf16_t* proj = (const bf16_t*)(WSP(p) + WS_PROJ); float* osum = (float*)(WSP(p) + WS_YS);
    LAS unsigned char* Us = lds + wave * 19456;
    LAS unsigned char* Ht = Us + 2048;
    LAS unsigned char* Cms = Us + 2048 + 9216;
    const float dtv = __expf(PIN(I_LOGDT)[(jl * 2 + dir) * 32 + g]);
    float a1r[2], a1i[2], a4r[2], a4i[2], hcr[2], hci[2];
    bf16x8_t bbr[2], bbi[2];
#pragma unroll
    for (int sh = 0; sh < 2; ++sh) { const int st = 32 * sh + r, pi = ((jl * 2 + dir) * 32 + g) * 64 + st;
        const float lre = PIN(I_LAMRE)[pi], lim = PIN(I_LAMIM)[pi]; const float xr = lre * dtv, xi = lim * dtv; float sn, cs; sincosf(xi, &sn, &cs);
        const float ea = __expf(xr), ar = ea * cs, ai = ea * sn;
        const float sh2 = sinf(0.5f * xi); const float nr = expm1f(xr) * cs - 2.0f * sh2 * sh2, ni = ai;
        const float den = 1.0f / (lre * lre + lim * lim); const float cr = (nr * lre + ni * lim) * den, ci = (ni * lre - nr * lim) * den;
        a1r[sh] = ar; a1i[sh] = ai; { const float b2r = ar * ar - ai * ai, b2i = 2.f * ar * ai; a4r[sh] = b2r * b2r - b2i * b2i; a4i[sh] = 2.f * b2r * b2i; }
        { const float* bre = PIN(I_BRE) + (size_t)pi * 16 + 8 * hh; const float* bim = PIN(I_BIM) + (size_t)pi * 16 + 8 * hh; float vr[8], vi[8];
#pragma unroll
          for (int j = 0; j < 8; ++j) { vr[j] = cr * bre[j] - ci * bim[j]; vi[j] = cr * bim[j] + ci * bre[j]; }
          u32x4 w; w.x = pk2(vr[0], vr[1]); w.y = pk2(vr[2], vr[3]); w.z = pk2(vr[4], vr[5]); w.w = pk2(vr[6], vr[7]); bbr[sh] = __builtin_bit_cast(bf16x8_t, w);
          w.x = pk2(vi[0], vi[1]); w.y = pk2(vi[2], vi[3]); w.z = pk2(vi[4], vi[5]); w.w = pk2(vi[6], vi[7]); bbi[sh] = __builtin_bit_cast(bf16x8_t, w); }
        hcr[sh] = 0.f; hci[sh] = 0.f;
        if (PASSB && seg >= 16) { const int sseg = seg - 16, b = sseg >> 4, j = sseg & 15;
            const float er = __expf(256.0f * xr); double ph = 256.0 * ((double)lim * (double)dtv); ph -= 6.283185307179586 * rint(ph * 0.15915494309189535);
            float s2, c2; sincosf((float)ph, &s2, &c2); const float a2r_ = er * c2, a2i_ = er * s2;
            const float2 s0 = *(const float2*)(PIN(I_SS5) + ((size_t)(((b * 2 + jl) * 2 + dir) * 32 + g) * 64 + st) * 2); float hr = s0.x, hi = s0.y;
            const int nst = dir ? 15 - j : j; float2 ev[15];
#pragma unroll
            for (int q = 0; q < 15; ++q) { const int sj = b * 16 + (dir ? 15 - q : q); ev[q] = q < nst ? ((const float2*)(WSP(p) + WS_C2E))[((sj * 2 + dir) * 32 + g) * 64 + st] : make_float2(0.f, 0.f); }
#pragma unroll
            for (int q = 0; q < 15; ++q) if (q < nst) { const float nhr = a2r_ * hr - a2i_ * hi + ev[q].x, nhi = a2r_ * hi + a2i_ * hr + ev[q].y; hr = nhr; hi = nhi; }
            hcr[sh] = hr; hci[sh] = hi; } }
    if (PASSB) {
        asm volatile("s_waitcnt lgkmcnt(0)" ::: "memory"); __builtin_amdgcn_wave_barrier();
#pragma unroll
        for (int sh = 0; sh < 2; ++sh)
#pragma unroll
            for (int ks = 0; ks < 4; ++ks) { float v[8];
                const float* src = PIN((ks >> 1) ? I_CIM : I_CRE) + ((size_t)((jl * 2 + dir) * 32 + g) * 16 + (r & 15)) * 64 + 32 * sh + ((16 * ks + 8 * hh) & 31); const float sg = (ks >> 1) ? -1.f : 1.f;
                const f32x4 s0 = *(const f32x4*)src, s1 = *(const f32x4*)(src + 4);
                v[0] = s0[0]; v[1] = s0[1]; v[2] = s0[2]; v[3] = s0[3]; v[4] = s1[0]; v[5] = s1[1]; v[6] = s1[2]; v[7] = s1[3];
#pragma unroll
                for (int j = 0; j < 8; ++j) v[j] = r < 16 ? sg * v[j] : 0.f;
                u32x4 w; w.x = pk2(v[0], v[1]); w.y = pk2(v[2], v[3]); w.z = pk2(v[4], v[5]); w.w = pk2(v[6], v[7]);
                *(LAS u32x4*)(Cms + ((sh * 4 + ks) * 64 + lane) * 16) = w; }
    }
    const int base = seg * SEG;
    u32x4 nu0, nu1; { const int t = dir ? base + SEG - 1 - lane : base + lane; const bf16_t* pu = proj + (size_t)t * PLD + g * 16; nu0 = *(const u32x4*)pu; nu1 = *(const u32x4*)(pu + 8); }
#pragma unroll 1
    for (int c = 0; c < 4; ++c) {
        asm volatile("s_waitcnt lgkmcnt(0)" ::: "memory"); __builtin_amdgcn_wave_barrier();
        *(LAS u32x4*)(Us + lane * 32) = nu0; *(LAS u32x4*)(Us + lane * 32 + 16) = nu1;
        if (c + 1 < 4) { const int i = 64 * (c + 1) + lane, t = dir ? base + SEG - 1 - i : base + i; const bf16_t* pu = proj + (size_t)t * PLD + g * 16; nu0 = *(const u32x4*)pu; nu1 = *(const u32x4*)(pu + 8); }
        asm volatile("s_waitcnt lgkmcnt(0)" ::: "memory"); __builtin_amdgcn_wave_barrier();
        const bf16x8_t ua0 = *(const LAS bf16x8_t*)(Us + r * 32 + hh * 16), ua1 = *(const LAS bf16x8_t*)(Us + (32 + r) * 32 + hh * 16);
        f32x16 Y[2];
        if (PASSB) {
#pragma unroll
            for (int e = 0; e < 16; ++e) { Y[0][e] = 0.f; Y[1][e] = 0.f; } }
#pragma unroll
        for (int sh = 0; sh < 2; ++sh) {
            f32x16 Xr[2], Xi[2];
#pragma unroll
            for (int e = 0; e < 16; ++e) { Xr[0][e] = 0.f; Xr[1][e] = 0.f; Xi[0][e] = 0.f; Xi[1][e] = 0.f; }
            Xr[0] = __builtin_amdgcn_mfma_f32_32x32x16_bf16(ua0, bbr[sh], Xr[0], 0, 0, 0); Xr[1] = __builtin_amdgcn_mfma_f32_32x32x16_bf16(ua1, bbr[sh], Xr[1], 0, 0, 0);
            Xi[0] = __builtin_amdgcn_mfma_f32_32x32x16_bf16(ua0, bbi[sh], Xi[0], 0, 0, 0); Xi[1] = __builtin_amdgcn_mfma_f32_32x32x16_bf16(ua1, bbi[sh], Xi[1], 0, 0, 0);
            const float ar = a1r[sh], ai = a1i[sh];
            float eor[8], eoi[8];
#pragma unroll
            for (int q = 0; q < 8; ++q) { const int mb = q >> 2, e0 = 4 * (q & 3);
#pragma unroll
                for (int k = 1; k < 4; ++k) { const float pr_ = Xr[mb][e0 + k - 1], pi_ = Xi[mb][e0 + k - 1]; Xr[mb][e0 + k] += ar * pr_ - ai * pi_; Xi[mb][e0 + k] += ar * pi_ + ai * pr_; }
                eor[q] = Xr[mb][e0 + 3]; eoi[q] = Xi[mb][e0 + 3]; }
            float cwr[8], cwi[8]; float cr_ = hcr[sh], ci_ = hci[sh]; const float qr = a4r[sh], qi = a4i[sh];
#pragma unroll
            for (int q = 0; q < 8; ++q) { const float epr = __shfl_xor(eor[q], 32), epi = __shfl_xor(eoi[q], 32);
                const float ear = hh ? epr : eor[q], eai = hh ? epi : eoi[q], ebr = hh ? eor[q] : epr, ebi = hh ? eoi[q] : epi;
                const float odr = qr * cr_ - qi * ci_ + ear, odi = qr * ci_ + qi * cr_ + eai;
                cwr[q] = hh ? odr : cr_; cwi[q] = hh ? odi : ci_;
                const float nr_ = qr * odr - qi * odi + ebr, ni_ = qr * odi + qi * odr + ebi; cr_ = nr_; ci_ = ni_; }
            hcr[sh] = cr_; hci[sh] = ci_;
            if (PASSB) {
                const float a2r_s = ar * ar - ai * ai, a2i_s = 2.f * ar * ai, a3r_s = a2r_s * ar - a2i_s * ai, a3i_s = a2r_s * ai + a2i_s * ar;
#pragma unroll
                for (int q = 0; q < 8; ++q) { const int mb = q >> 2, m = q & 3, e0 = 4 * m; const float wr = cwr[q], wi = cwi[q];
                    const float h0r = Xr[mb][e0 + 0] + (a1r[sh] * wr - a1i[sh] * wi), h0i = Xi[mb][e0 + 0] + (a1r[sh] * wi + a1i[sh] * wr);
                    const float h1r = Xr[mb][e0 + 1] + (a2r_s * wr - a2i_s * wi), h1i = Xi[mb][e0 + 1] + (a2r_s * wi + a2i_s * wr);
                    const float h2r = Xr[mb][e0 + 2] + (a3r_s * wr - a3i_s * wi), h2i = Xi[mb][e0 + 2] + (a3r_s * wi + a3i_s * wr);
                    const float h3r = Xr[mb][e0 + 3] + (a4r[sh] * wr - a4i[sh] * wi), h3i = Xi[mb][e0 + 3] + (a4r[sh] * wi + a4i[sh] * wr);
                    LAS unsigned char* hp = Ht + (32 * mb + 8 * m + 4 * hh) * 144 + r * 2;
                    *(LAS bf16_t*)(hp) = (bf16_t)f2bf(h0r); *(LAS bf16_t*)(hp + 64) = (bf16_t)f2bf(h0i);
                    *(LAS bf16_t*)(hp + 144) = (bf16_t)f2bf(h1r); *(LAS bf16_t*)(hp + 144 + 64) = (bf16_t)f2bf(h1i);
                    *(LAS bf16_t*)(hp + 288) = (bf16_t)f2bf(h2r); *(LAS bf16_t*)(hp + 288 + 64) = (bf16_t)f2bf(h2i);
                    *(LAS bf16_t*)(hp + 432) = (bf16_t)f2bf(h3r); *(LAS bf16_t*)(hp + 432 + 64) = (bf16_t)f2bf(h3i); }
                asm volatile("s_waitcnt lgkmcnt(0)" ::: "memory"); __builtin_amdgcn_wave_barrier();
#pragma unroll
                for (int ks = 0; ks < 4; ++ks) { const bf16x8_t cmk = *(const LAS bf16x8_t*)(Cms + ((sh * 4 + ks) * 64 + lane) * 16);
#pragma unroll
                    for (int nb = 0; nb < 2; ++nb) { const bf16x8_t b = *(const LAS bf16x8_t*)(Ht + (32 * nb + r) * 144 + (16 * ks + 8 * hh) * 2); Y[nb] = __builtin_amdgcn_mfma_f32_32x32x16_bf16(cmk, b, Y[nb], 0, 0, 0); } }
                asm volatile("s_waitcnt lgkmcnt(0)" ::: "memory"); __builtin_amdgcn_wave_barrier();
            }
        }
        if (PASSB) {
            LAS float* Ys = (LAS float*)Ht;
#pragma unroll
            for (int nb = 0; nb < 2; ++nb)
#pragma unroll
                for (int e = 0; e < 8; ++e) Ys[(32 * nb + r) * 17 + (e & 3) + 8 * (e >> 2) + 4 * hh] = Y[nb][e];
            asm volatile("s_waitcnt lgkmcnt(0)" ::: "memory"); __builtin_amdgcn_wave_barrier();
            const int jj = lane & 15, ts = lane >> 4;
#pragma unroll
            for (int q = 0; q < 16; ++q) { const int i = 64 * c + 4 * q + ts, t = dir ? base + SEG - 1 - i : base + i;
                gatomic_add(osum + (size_t)t * 512 + g * 16 + jj, Ys[(4 * q + ts) * 17 + jj]); }
        }
    }
    if (hh == 0) {
#pragma unroll
        for (int sh = 0; sh < 2; ++sh) { const int st = 32 * sh + r; float2 e; e.x = hcr[sh]; e.y = hci[sh];
            if (!PASSB) ((float2*)(WSP(p) + WS_C2E))[(((seg - 16) * 2 + dir) * 32 + g) * 64 + st] = e;
            else if (seg < 16) ((float2*)(POUT() + OUT_S5))[(((seg * 2 + jl) * 2 + dir) * 32 + g) * 64 + st] = e; } }
}

constexpr int G_QD = 0, G_ATT = 9216, G_KE = 18432, G_DEC = 27648, G_VT = 27904, G_STAGE = 49152, G_BYTES = 49152;
__device__ __forceinline__ int pinv16(int x) { const int o = x & 15; return (x & ~15) + 8 * ((o >> 2) & 1) + (o & 3) + ((o >> 3) << 2); }

__device__ __forceinline__ void gla_pre(const Params& p, LAS unsigned char* lds, int jl, int which, int fb) {
    const int tid = otid(), lane = tid & 63, wave = __builtin_amdgcn_readfirstlane(tid >> 6);
    const bf16_t* proj = (const bf16_t*)(WSP(p) + WS_PROJ);
    LAS unsigned char* Qs = lds; LAS unsigned char* Ks = lds + 9216; LAS unsigned char* Vs = lds + 18432;
    LAS float* bs = (LAS float*)(lds + 35840);
    LAS unsigned char* QDs = lds + 69120;
    LAS unsigned char* KIs = lds + 87552;
    LAS float* wgs = (LAS float*)(lds + 105984);
    const int head = obid() & 3;
    for (int e = tid; e < 2048; e += 512) { const int dir = e >> 10, r = (e >> 6) & 15, k = e & 63; wgs[e] = PIN(I_WG2)[((size_t)(jl * 2 + dir) * 16 + r) * 256 + head * 64 + k]; }
    if (tid < 128) wgs[2048 + tid] = PIN(I_BG)[(jl * 2 + (tid >> 6)) * 256 + head * 64 + (tid & 63)];
    __syncthreads();
    for (int it = obid() - fb; it < (which ? 256 : 512); it += gridDim.x - fb) {
        const int c = (which ? 0 : 64) + (it >> 2), t0 = c * 64;
        { const int i = tid >> 3, part = tid & 7; const bf16_t* pr = proj + (size_t)(t0 + i) * PLD;
          const u32x4 qv = *(const u32x4*)(pr + head * 64 + part * 8), kv = *(const u32x4*)(pr + 256 + head * 64 + part * 8);
          const u32x4 v0 = *(const u32x4*)(pr + 512 + head * 128 + part * 16), v1 = *(const u32x4*)(pr + 512 + head * 128 + part * 16 + 8);
          *(LAS u32x4*)(Qs + i * 144 + part * 16) = qv; *(LAS u32x4*)(Ks + i * 144 + part * 16) = kv;
          *(LAS u32x4*)(Vs + i * 272 + part * 32) = v0; *(LAS u32x4*)(Vs + i * 272 + part * 32 + 16) = v1;
#pragma unroll
          for (int dir = 0; dir < 2; ++dir) { const u32x4 l0 = *(const u32x4*)(pr + 1536 + dir * 16), l1 = *(const u32x4*)(pr + 1536 + dir * 16 + 8);
              float lr[16]; lr[0] = bflo(l0.x); lr[1] = bfhi(l0.x); lr[2] = bflo(l0.y); lr[3] = bfhi(l0.y); lr[4] = bflo(l0.z); lr[5] = bfhi(l0.z); lr[6] = bflo(l0.w); lr[7] = bfhi(l0.w);
              lr[8] = bflo(l1.x); lr[9] = bfhi(l1.x); lr[10] = bflo(l1.y); lr[11] = bfhi(l1.y); lr[12] = bflo(l1.z); lr[13] = bfhi(l1.z); lr[14] = bflo(l1.w); lr[15] = bfhi(l1.w);
              const int il = dir ? 63 - i : i;
#pragma unroll
              for (int kk = 0; kk < 8; ++kk) { const int k = part * 8 + kk; float pre = wgs[2048 + dir * 64 + k];
#pragma unroll
                  for (int r = 0; r < 16; ++r) pre += lr[r] * wgs[(dir * 16 + r) * 64 + k];
                  bs[(dir * 64 + il) * 65 + k] = (fminf(pre, 0.f) - __logf(1.0f + __expf(-fabsf(pre)))) * (1.0f / 16.0f); } } }
        __syncthreads();
#pragma unroll 1
        for (int s = 0; s < 16; ++s) { const int dk = wave * 16 + s, dir = dk >> 6, k = dk & 63; float x = bs[(dir * 64 + lane) * 65 + k];
#pragma unroll
            for (int off = 1; off < 64; off <<= 1) { const float y = __shfl_up(x, off); if (lane >= off) x += y; }
            bs[(dir * 64 + lane) * 65 + k] = x; }
        __syncthreads();
        for (int u = tid; u < 1024; u += 512) { const int k8 = u & 7, i = (u >> 3) & 63, dir = u >> 9, pi = dir ? 63 - i : i;
            const u32x4 qv = *(const LAS u32x4*)(Qs + pi * 144 + k8 * 16), kv = *(const LAS u32x4*)(Ks + pi * 144 + k8 * 16); const LAS float* bp = bs + (dir * 64 + i) * 65 + k8 * 8;
            float e[8];
#pragma unroll
            for (int j = 0; j < 8; ++j) e[j] = __expf(bp[j]);
            u32x4 o; o.x = pk2(bflo(qv.x) * 0.125f * e[0], bfhi(qv.x) * 0.125f * e[1]); o.y = pk2(bflo(qv.y) * 0.125f * e[2], bfhi(qv.y) * 0.125f * e[3]);
            o.z = pk2(bflo(qv.z) * 0.125f * e[4], bfhi(qv.z) * 0.125f * e[5]); o.w = pk2(bflo(qv.w) * 0.125f * e[6], bfhi(qv.w) * 0.125f * e[7]);
            *(LAS u32x4*)(QDs + dir * 9216 + i * 144 + k8 * 16) = o;
            o.x = pk2(bflo(kv.x) / e[0], bfhi(kv.x) / e[1]); o.y = pk2(bflo(kv.y) / e[2], bfhi(kv.y) / e[3]); o.z = pk2(bflo(kv.z) / e[4], bfhi(kv.z) / e[5]); o.w = pk2(bflo(kv.w) / e[6], bfhi(kv.w) / e[7]);
            *(LAS u32x4*)(KIs + dir * 9216 + i * 144 + k8 * 16) = o; }
        __syncthreads();
        { const int dir = wave >> 2, mb = (wave >> 1) & 1, nb = wave & 1, r = lane & 31, hh = lane >> 5;
          f32x16 acc;
#pragma unroll
          for (int e = 0; e < 16; ++e) acc[e] = 0.f;
          if (nb <= mb) {
#pragma unroll
              for (int ks = 0; ks < 4; ++ks) { const bf16x8_t a = *(const LAS bf16x8_t*)(QDs + dir * 9216 + (32 * mb + r) * 144 + (16 * ks + 8 * hh) * 2), b = *(const LAS bf16x8_t*)(KIs + dir * 9216 + (32 * nb + r) * 144 + (16 * ks + 8 * hh) * 2);
                  acc = __builtin_amdgcn_mfma_f32_32x32x16_bf16(a, b, acc, 0, 0, 0); } }
          unsigned char* img = WSP(p) + WS_IMG + (size_t)((c * 4 + head) * 2 + dir) * G_BYTES; const int j = 32 * nb + r; bf16_t* ap = (bf16_t*)(img + G_ATT) + pinv16(j);
#pragma unroll
          for (int e = 0; e < 16; ++e) { const int i = 32 * mb + (e & 3) + 8 * (e >> 2) + 4 * hh; ap[i * 72] = (bf16_t)f2bf(j <= i ? acc[e] : 0.f); } }
        for (int u = tid; u < 1024; u += 512) {
            const int hh = u & 1, ks = (u >> 1) & 3, i = (u >> 3) & 63, dir = u >> 9;
            const u32x2 a = *(const LAS u32x2*)(QDs + dir * 9216 + i * 144 + (16 * ks + 4 * hh) * 2), b = *(const LAS u32x2*)(QDs + dir * 9216 + i * 144 + (16 * ks + 8 + 4 * hh) * 2);
            u32x4 o; o.x = a.x; o.y = a.y; o.z = b.x; o.w = b.y;
            *(u32x4*)(WSP(p) + WS_IMG + (size_t)((c * 4 + head) * 2 + dir) * G_BYTES + G_QD + i * 144 + (16 * ks + 8 * hh) * 2) = o; }
        for (int u = tid; u < 1024; u += 512) {
            const int k = u & 63, hh = (u >> 6) & 1, ks = (u >> 7) & 3, dir = u >> 9; const float be = bs[(dir * 64 + 63) * 65 + k]; float v[8];
#pragma unroll
            for (int j = 0; j < 8; ++j) { const int ja = 16 * ks + kact16(j, hh), pj = dir ? 63 - ja : ja; v[j] = bf2f(*(const LAS bf16_t*)(Ks + pj * 144 + k * 2)) * __expf(be - bs[(dir * 64 + ja) * 65 + k]); }
            u32x4 o; o.x = pk2(v[0], v[1]); o.y = pk2(v[2], v[3]); o.z = pk2(v[4], v[5]); o.w = pk2(v[6], v[7]);
            *(u32x4*)(WSP(p) + WS_IMG + (size_t)((c * 4 + head) * 2 + dir) * G_BYTES + G_KE + k * 144 + (16 * ks + 8 * hh) * 2) = o; }
        for (int u = tid; u < 2048; u += 512) {
            const int n = u & 127, hh = (u >> 7) & 1, ks = (u >> 8) & 3, dir = u >> 10; unsigned short v[8];
#pragma unroll
            for (int j = 0; j < 8; ++j) { const int ja = 16 * ks + kact16(j, hh), pj = dir ? 63 - ja : ja; v[j] = *(const LAS bf16_t*)(Vs + pj * 272 + n * 2); }
            u32x4 o; o.x = v[0] | ((unsigned)v[1] << 16); o.y = v[2] | ((unsigned)v[3] << 16); o.z = v[4] | ((unsigned)v[5] << 16); o.w = v[6] | ((unsigned)v[7] << 16);
            *(u32x4*)(WSP(p) + WS_IMG + (size_t)((c * 4 + head) * 2 + dir) * G_BYTES + G_VT + n * 144 + (16 * ks + 8 * hh) * 2) = o; }
        if (tid < 128) { const int dir = tid >> 6, k = tid & 63; *(float*)(WSP(p) + WS_IMG + (size_t)((c * 4 + head) * 2 + dir) * G_BYTES + G_DEC + k * 4) = __expf(bs[(dir * 64 + 63) * 65 + k]); }
        __syncthreads();
    }
}

__device__ __forceinline__ void gla_chain(const Params& p, LAS unsigned char* lds, int cfirst, int nch, int dir, int head, const float* s_init, float* s_out) {
    const int tid = otid(), lane = tid & 63, wave = __builtin_amdgcn_readfirstlane(tid >> 6), r = lane & 31, hh = lane >> 5;
    const unsigned char* imgbase = WSP(p) + WS_IMG; float* obuf = (float*)(WSP(p) + (dir ? WS_OB : WS_OSUM));
    const int cstep = dir ? -1 : 1, c0 = dir ? cfirst + nch - 1 : cfirst;
    { const unsigned char* img = imgbase + (size_t)((c0 * 4 + head) * 2 + dir) * G_BYTES;
      for (int q = tid; q < G_STAGE / 16; q += 512) *(LAS u32x4*)(lds + q * 16) = *(const u32x4*)(img + q * 16); }
    if (wave >= 4) {
        if (nch == 64) chain_loader<64, G_STAGE, G_BYTES, 4>(lds, imgbase, c0, cstep, head, dir, tid - 256); else chain_loader<4, G_STAGE, G_BYTES, 4>(lds, imgbase, c0, cstep, head, dir, tid - 256);
    } else {
        f32x16 S[2];
        const int col = wave * 32 + r;
        { const float* sp = s_init ? s_init + (4 * hh) * 128 + col : nullptr;
#pragma unroll
          for (int mb = 0; mb < 2; ++mb)
#pragma unroll
            for (int m = 0; m < 4; ++m) { asm volatile("" : "+v"(sp));
#pragma unroll
                for (int rr = 0; rr < 4; ++rr) S[mb][4 * m + rr] = sp ? sp[rr * 128] : 0.f;
                if (sp) sp += 8 * 128; } }
        __syncthreads();
        for (int s = 0; s < nch; ++s) {
            const int cidx = c0 + cstep * s;
            LAS unsigned char* buf = lds + (s & 1) * G_STAGE;
            bf16x8_t vb[4];
#pragma unroll
            for (int ks = 0; ks < 4; ++ks) vb[ks] = *(const LAS bf16x8_t*)(buf + G_VT + col * 144 + (16 * ks + 8 * hh) * 2);
#pragma unroll
            for (int mb = 0; mb < 2; ++mb) { f32x16 O; asm volatile("" ::: "memory");
                bf16x8_t af[8];
#pragma unroll
                for (int ks = 0; ks < 4; ++ks) { af[ks] = *(const LAS bf16x8_t*)(buf + G_QD + (32 * mb + r) * 144 + (16 * ks + 8 * hh) * 2); af[4 + ks] = *(const LAS bf16x8_t*)(buf + G_ATT + (32 * mb + r) * 144 + (16 * ks + 8 * hh) * 2); }
#pragma unroll
                for (int e = 0; e < 16; ++e) O[e] = 0.f;
#pragma unroll
                for (int ks = 0; ks < 4; ++ks) O = __builtin_amdgcn_mfma_f32_32x32x16_bf16(af[ks], SBF(ks), O, 0, 0, 0);
#pragma unroll
                for (int ks = 0; ks < 4; ++ks) O = __builtin_amdgcn_mfma_f32_32x32x16_bf16(af[4 + ks], vb[ks], O, 0, 0, 0);
#pragma unroll
                for (int m = 0; m < 4; ++m) { const int g4 = 8 * mb + 2 * m + hh, tg = cidx * 16 + (dir ? 15 - g4 : g4);
                    f32x4 ov; if (dir) { ov[0] = O[4 * m + 3]; ov[1] = O[4 * m + 2]; ov[2] = O[4 * m + 1]; ov[3] = O[4 * m + 0]; } else { ov[0] = O[4 * m + 0]; ov[1] = O[4 * m + 1]; ov[2] = O[4 * m + 2]; ov[3] = O[4 * m + 3]; }
                    *(f32x4*)(obuf + ((size_t)tg * 512 + head * 128 + col) * 4) = ov; } }
            { asm volatile("" ::: "memory");
              bf16x8_t af[8]; f32x4 dv[8];
#pragma unroll
              for (int mb = 0; mb < 2; ++mb)
#pragma unroll
                for (int ks = 0; ks < 4; ++ks) { af[4 * mb + ks] = *(const LAS bf16x8_t*)(buf + G_KE + (32 * mb + r) * 144 + (16 * ks + 8 * hh) * 2); dv[4 * mb + ks] = *(const LAS f32x4*)(buf + G_DEC + (32 * mb + 8 * ks + 4 * hh) * 4); }
#pragma unroll
              for (int mb = 0; mb < 2; ++mb) {
#pragma unroll
                for (int m = 0; m < 4; ++m)
#pragma unroll
                    for (int rr = 0; rr < 4; ++rr) S[mb][4 * m + rr] *= dv[4 * mb + m][rr];
#pragma unroll
                for (int ks = 0; ks < 4; ++ks) S[mb] = __builtin_amdgcn_mfma_f32_32x32x16_bf16(af[4 * mb + ks], vb[ks], S[mb], 0, 0, 0); } }
            lds_barrier();
        }
        if (s_out) {
            float* sp = s_out + (4 * hh) * 128 + col;
#pragma unroll
            for (int mb = 0; mb < 2; ++mb)
#pragma unroll
                for (int m = 0; m < 4; ++m) { asm volatile("" : "+v"(sp));
#pragma unroll
                    for (int rr = 0; rr < 4; ++rr) sp[rr * 128] = S[mb][4 * m + rr];
                    sp += 8 * 128; }
        }
    }
}
constexpr size_t WS_RGAB = WS_IMG + (size_t)1536 * 49152;
__device__ __forceinline__ void rg_pre(const Params& p, LAS unsigned char* lds, int jl, int which, int fb) {
    const int tid = otid(), lane = tid & 63, wave = __builtin_amdgcn_readfirstlane(tid >> 6), r = lane & 31, hh = lane >> 5;
    const bf16_t* proj = (const bf16_t*)(WSP(p) + WS_PROJ);
    LAS unsigned char* xcs = lds;
    LAS float* xcf = (LAS float*)(lds + 9216);
    LAS unsigned char* wts = lds + 9216 + 16640;
    LAS float* prm = (LAS float*)(lds + 9216 + 16640 + 36864);
    const int n = obid() & 7;
    for (int e = tid; e < 4 * 4096; e += 512) { const int m = e >> 12, j = (e >> 6) & 63, c = e & 63, dir = m >> 1, gate = m & 1;
        const float w = PIN(gate ? I_RGWX : I_RGWA)[((size_t)((jl * 2 + dir) * 8 + n) * 64 + j) * 64 + c];
        *(LAS bf16_t*)(wts + m * 9216 + c * 144 + j * 2) = (bf16_t)f2bf(w); }
    if (tid < 128) { const int dir = tid >> 6, c = tid & 63, ch = n * 64 + c; prm[(dir * 3 + 0) * 64 + c] = PIN(I_RGBA)[(jl * 2 + dir) * 512 + ch]; prm[(dir * 3 + 1) * 64 + c] = PIN(I_RGBX)[(jl * 2 + dir) * 512 + ch];
        prm[(dir * 3 + 2) * 64 + c] = softplusf_(-PIN(I_RGLAM)[(jl * 2 + dir) * 512 + ch]); }
    __syncthreads();
    unsigned* AB = (unsigned*)(WSP(p) + WS_RGAB);
    for (int it = obid() - fb; it < (which ? 512 : 1024); it += gridDim.x - fb) {
        const int c64 = (which ? 0 : 64) + (it >> 3), t0 = c64 * 64; int lo, hi; seq_bounds(t0, lo, hi);
        { const int i = tid >> 3, part = tid & 7, ch = n * 64 + part * 8; float acc[8];
          const f32x4 b0 = *(const f32x4*)(PIN(I_RGCB) + jl * 512 + ch), b1 = *(const f32x4*)(PIN(I_RGCB) + jl * 512 + ch + 4);
          acc[0] = b0[0]; acc[1] = b0[1]; acc[2] = b0[2]; acc[3] = b0[3]; acc[4] = b1[0]; acc[5] = b1[1]; acc[6] = b1[2]; acc[7] = b1[3];
#pragma unroll
          for (int tap = 0; tap < 4; ++tap) { const int tt = t0 + i + tap - 1;
              if (tt >= lo && tt < hi) { const u32x4 x = *(const u32x4*)(proj + (size_t)tt * PLD + 1568 + ch); const float* wp = PIN(I_RGCW) + (jl * 4 + tap) * 512 + ch; const f32x4 w0 = *(const f32x4*)wp, w1 = *(const f32x4*)(wp + 4);
                  acc[0] += w0[0] * bflo(x.x); acc[1] += w0[1] * bfhi(x.x); acc[2] += w0[2] * bflo(x.y); acc[3] += w0[3] * bfhi(x.y); acc[4] += w1[0] * bflo(x.z); acc[5] += w1[1] * bfhi(x.z); acc[6] += w1[2] * bflo(x.w); acc[7] += w1[3] * bfhi(x.w); } }
          u32x4 o; o.x = pk2(acc[0], acc[1]); o.y = pk2(acc[2], acc[3]); o.z = pk2(acc[4], acc[5]); o.w = pk2(acc[6], acc[7]);
          *(LAS u32x4*)(xcs + i * 144 + part * 16) = o;
#pragma unroll
          for (int q = 0; q < 8; ++q) xcf[i * 65 + part * 8 + q] = acc[q]; }
        __syncthreads();
        { const int dir = wave >> 2, mb = (wave >> 1) & 1, nb = wave & 1; f32x16 ar, ai;
#pragma unroll
          for (int e = 0; e < 16; ++e) { ar[e] = 0.f; ai[e] = 0.f; }
#pragma unroll
          for (int ks = 0; ks < 4; ++ks) { const bf16x8_t a = *(const LAS bf16x8_t*)(xcs + (32 * mb + r) * 144 + (16 * ks + 8 * hh) * 2);
              const bf16x8_t br = *(const LAS bf16x8_t*)(wts + (dir * 2 + 0) * 9216 + (32 * nb + r) * 144 + (16 * ks + 8 * hh) * 2), bi = *(const LAS bf16x8_t*)(wts + (dir * 2 + 1) * 9216 + (32 * nb + r) * 144 + (16 * ks + 8 * hh) * 2);
              ar = __builtin_amdgcn_mfma_f32_32x32x16_bf16(a, br, ar, 0, 0, 0); ai = __builtin_amdgcn_mfma_f32_32x32x16_bf16(a, bi, ai, 0, 0, 0); }
          const int c = 32 * nb + r; const float ba = prm[(dir * 3 + 0) * 64 + c], bx = prm[(dir * 3 + 1) * 64 + c], sp = prm[(dir * 3 + 2) * 64 + c];
          unsigned* dst = AB + ((size_t)dir * NT + t0) * 512 + n * 64 + c;
#pragma unroll
          for (int e = 0; e < 16; ++e) { const int i = 32 * mb + (e & 3) + 8 * (e >> 2) + 4 * hh;
              const float rr = sigmoidf_(ar[e] + ba), ig = sigmoidf_(ai[e] + bx), la = -8.0f * rr * sp;
              const float a_ = __expf(la); dst[(size_t)i * 512] = pk2(1.0f - a_, __builtin_amdgcn_sqrtf(1.0f - a_ * a_) * (ig * xcf[i * 65 + c])); } }
        __syncthreads();
    }
}
template <bool STORE_TMP, bool FINAL, int NB>
__device__ __forceinline__ float rg_scan256(const unsigned* ab, int dir, int base, float h, float& dprod, float* tmp, const bf16_t* gatep, bf16_t* mixp) {
#pragma unroll 1
    for (int i0 = 0; i0 < SEG; i0 += NB) { unsigned u[NB]; float tv[NB]; unsigned short gv[NB];
#pragma unroll
        for (int q = 0; q < NB; ++q) { const int t = dir ? base + SEG - 1 - (i0 + q) : base + i0 + q; u[q] = ab[(size_t)t * 512]; if (FINAL) { tv[q] = tmp[(size_t)t * 512]; gv[q] = gatep[(size_t)t * PLD]; } }
#pragma unroll
        for (int q = 0; q < NB; ++q) { const int t = dir ? base + SEG - 1 - (i0 + q) : base + i0 + q; const float a = 1.0f - bflo(u[q]); h = a * h + bfhi(u[q]); dprod *= a;
            if (STORE_TMP) tmp[(size_t)t * 512] = h;
            if (FINAL) mixp[(size_t)t * 1024] = (bf16_t)f2bf(geluf_(bf2f(gv[q])) * (tv[q] + h)); } }
    return h;
}
__device__ __forceinline__ float rg_carry(const Params& p, int jl, int seg, int dir, int chn) {
    const int sseg = seg - 16, b = sseg >> 4, j = sseg & 15, nst = dir ? 15 - j : j; float h = PIN(I_SRG)[((b * 2 + jl) * 2 + dir) * 512 + chn];
    float dv[15], ev[15];
#pragma unroll
    for (int q = 0; q < 15; ++q) { const int sj = b * 16 + (dir ? 15 - q : q), o = (sj * 2 + dir) * 512 + chn; dv[q] = q < nst ? ((const float*)(WSP(p) + WS_C2D))[o] : 1.f; ev[q] = q < nst ? ((const float*)(WSP(p) + WS_C2E))[o] : 0.f; }
#pragma unroll
    for (int q = 0; q < 15; ++q) h = dv[q] * h + ev[q];
    return h;
}
__device__ __forceinline__ void rg_passA(const Params& p, int seg, int dir, int n) {
    const int lane = otid() & 63, chn = n * 64 + lane, sseg = seg - 16; float dprod = 1.f;
    const unsigned* ab = (const unsigned*)(WSP(p) + WS_RGAB) + (size_t)dir * NT * 512 + chn;
    const float h = rg_scan256<false, false, 32>(ab, dir, seg * SEG, 0.f, dprod, nullptr, nullptr, nullptr);
    ((float*)(WSP(p) + WS_C2E))[(sseg * 2 + dir) * 512 + chn] = h; ((float*)(WSP(p) + WS_C2D))[(sseg * 2 + dir) * 512 + chn] = dprod;
}
__device__ __forceinline__ void rg_passB(const Params& p, int jl, int seg, int n) {
    const int lane = otid() & 63, chn = n * 64 + lane; float dprod = 1.f;
    const unsigned* ab = (const unsigned*)(WSP(p) + WS_RGAB) + chn; float* tmp = (float*)(WSP(p) + WS_YS) + chn;
    const bf16_t* gatep = (const bf16_t*)(WSP(p) + WS_PROJ) + 2080 + chn; bf16_t* mixp = (bf16_t*)(WSP(p) + WS_HN) + 512 + chn;
    const float hf0 = seg >= 16 ? rg_carry(p, jl, seg, 0, chn) : 0.f, hb0 = seg >= 16 ? rg_carry(p, jl, seg, 1, chn) : 0.f;
    const float hf = rg_scan256<true, false, 32>(ab, 0, seg * SEG, hf0, dprod, tmp, nullptr, nullptr);
    const float hb = rg_scan256<false, true, 16>(ab + (size_t)NT * 512, 1, seg * SEG, hb0, dprod, tmp, gatep, mixp);
    if (seg < 16) { POUT()[OUT_RG + ((seg * 2 + jl) * 2 + 0) * 512 + chn] = hf; POUT()[OUT_RG + ((seg * 2 + jl) * 2 + 1) * 512 + chn] = hb; }
}

__device__ __forceinline__ void inproj_tail(const Params& p, int first_blk) {
    const int lane = otid() & 63, wave = __builtin_amdgcn_readfirstlane(otid() >> 6), r = lane & 31, hh = lane >> 5;
    const int nblk = gridDim.x - first_blk;
    const bf16_t* hn = (const bf16_t*)(WSP(p) + WS_HN); const bf16_t* wt = (const bf16_t*)(WSP(p) + WS_WIN) + (size_t)(2560 + r) * 1024 + 8 * hh; bf16_t* proj = (bf16_t*)(WSP(p) + WS_PROJ);
    for (int tile = (obid() - first_blk) * 8 + wave; tile < NT / 32; tile += nblk * 8) {
        const bf16_t* ap = hn + (size_t)(tile * 32 + r) * 1024 + 8 * hh;
        f32x16 acc;
#pragma unroll
        for (int e = 0; e < 16; ++e) acc[e] = 0.f;
#pragma unroll 1
        for (int k0 = 0; k0 < 64; k0 += 8) { bf16x8_t a[8], b[8];
#pragma unroll
            for (int q = 0; q < 8; ++q) { a[q] = *(const bf16x8_t*)(ap + (k0 + q) * 16); b[q] = *(const bf16x8_t*)(wt + (k0 + q) * 16); }
#pragma unroll
            for (int q = 0; q < 8; ++q) acc = __builtin_amdgcn_mfma_f32_32x32x16_bf16(a[q], b[q], acc, 0, 0, 0); }
        bf16_t* op = proj + (size_t)(tile * 32) * PLD + 2560 + r;
#pragma unroll
        for (int e = 0; e < 16; ++e) op[(size_t)((e & 3) + 8 * (e >> 2) + 4 * hh) * PLD] = (bf16_t)f2bf(acc[e]);
    }
}
__device__ __forceinline__ void ab_pre(const Params& p, LAS unsigned char* lds, int jl) {
    gla_pre(p, lds, jl, 0, 0);
}
__device__ __forceinline__ void ab_chain(const Params& p, LAS unsigned char* lds, int jl, const XcdBarrier& sub) {
    const int bid = obid();
    if (bid >= 16) { gla_pre(p, lds, jl, 1, 16); rg_pre(p, lds, jl, 0, 16); rg_pre(p, lds, jl, 1, 16); xcd_barrier(sub); }
    if (bid < 144) { const bool smp = bid < 16; const int q = smp ? bid : bid - 16, b = q >> 3, dir = (q >> 2) & 1, head = q & 3;
        const size_t so = (size_t)(((b * 2 + jl) * 2 + dir) * 4 + head) * 8192;
        gla_chain(p, lds, smp ? 64 + 64 * b : 4 * b, smp ? 64 : 4, dir, head, smp ? PIN(I_SGLA) + so : nullptr, smp ? nullptr : POUT() + OUT_GLA + so); }
    if (bid >= 16) { const int wave = __builtin_amdgcn_readfirstlane(otid() >> 6);
        for (int idx = (bid - 16) * 8 + wave; idx < NSSEG * 16; idx += (gridDim.x - 16) * 8) { const int seg = 16 + idx / 16, r = idx % 16; rg_passA(p, seg, r >> 3, r & 7); } }
    if (bid >= 144) inproj_tail(p, 144);
}
__device__ __forceinline__ void ab_fin(const Params& p, int jl) {
    { const int wave = __builtin_amdgcn_readfirstlane(otid() >> 6), G = gridDim.x;
      for (int idx = wave * G + obid(); idx < NSEG * 8; idx += 8 * G) rg_passB(p, jl, idx >> 3, idx & 7); }
    ab_combine(p, jl);
}
__device__ __forceinline__ void cd_pre(const Params& p, LAS unsigned char* lds, int jl) {
    dn_pre(p, lds, jl, 0, 0);
}
__device__ __forceinline__ void cd_chain(const Params& p, LAS unsigned char* lds, int jl, const XcdBarrier& sub) {
    const int bid = obid();
    if (bid >= 16) { dn_pre(p, lds, jl, 1, 16);
        { const int wave = __builtin_amdgcn_readfirstlane(otid() >> 6);
          for (int idx = (bid - 16) * 8 + wave; idx < NSSEG * 64; idx += (gridDim.x - 16) * 8) { const int seg = 16 + idx / 64, r = idx % 64; s5_task<false>(p, lds, jl, seg, r >> 5, r & 31); } }
        xcd_barrier(sub); }
    if (bid < 144) { const bool smp = bid < 16; const int q = smp ? bid : bid - 16, b = q >> 3, dir = (q >> 2) & 1, head = q & 3;
        const size_t so = (size_t)(((b * 2 + jl) * 2 + dir) * 4 + head) * 16384;
        dn_chain(p, lds, jl, smp ? 64 + 64 * b : 4 * b, smp ? 64 : 4, dir, head, smp ? PIN(I_SDN) + so : nullptr, smp ? nullptr : POUT() + OUT_DN + so); }
    if (bid >= 16) { const int wave = __builtin_amdgcn_readfirstlane(otid() >> 6);
        for (int idx = (bid - 16) * 8 + wave; idx < NSEG * 64; idx += (gridDim.x - 16) * 8) { const int seg = idx / 64, r = idx % 64; s5_task<true>(p, lds, jl, seg, r >> 5, r & 31); } }
}
__device__ __forceinline__ void cd_combine(const Params& p, int jl) {
    const int lane = otid() & 63, gw = obid() * 8 + (otid() >> 6), nw = gridDim.x * 8;
    const bf16_t* proj = (const bf16_t*)(WSP(p) + WS_PROJ); const float* ys = (const float*)(WSP(p) + WS_YS); bf16_t* zg = (bf16_t*)(WSP(p) + WS_ZG);
    for (int t = gw; t < NT; t += nw) {
        const bf16_t* pr = proj + (size_t)t * PLD; const float* os = ys + (size_t)t * 512;
#pragma unroll
        for (int i = 0; i < 4; ++i) { const int c = i * 128 + 2 * lane; const float2 y = *(const float2*)(os + c); const unsigned u = *(const unsigned*)(pr + c); const float2 d = *(const float2*)(PIN(I_S5D) + jl * 512 + c);
            *(unsigned*)(zg + (size_t)t * 512 + c) = pk2(geluf_(y.x + d.x * bflo(u)), geluf_(y.y + d.y * bfhi(u))); }
    }
}

__global__ void __launch_bounds__(512) fwd_mega(Params p) {
    extern __shared__ __attribute__((aligned(16))) unsigned char lds_raw[];
    LAS unsigned char* lds = (LAS unsigned char*)lds_raw;
    cg::grid_group grid = cg::this_grid();
    const int G = gridDim.x, bid = obid();
    unsigned char* ws = WSP(p);
    float* X = (float*)(ws + WS_X); bf16_t* HN = (bf16_t*)(ws + WS_HN); bf16_t* PROJ = (bf16_t*)(ws + WS_PROJ);
    const float* MOD = (const float*)(ws + WS_MOD);

    if (otid() < 8) ((LAS unsigned*)(lds + LDS_BAR))[otid()] = 0u;
    __syncthreads();
    const XcdBarrier xbar = xcd_barrier_post((unsigned*)(ws + WS_BAR), (volatile LAS unsigned*)(lds + LDS_BAR), gridDim.x);
    XcdBarrier xsub = xbar; if (bid >= 16) xsub = xcd_barrier_post((unsigned*)(ws + WS_BAR + 16384), (volatile LAS unsigned*)(lds + LDS_BAR + 16), gridDim.x - 16);
#define GSYNC() xcd_barrier(xbar)
    phase0(p, lds);
    grid.sync();
#pragma unroll 1
    for (int l = 0; l < 4; ++l) {
        const int jl = l >> 1; const bool isAB = (l & 1) == 0;
        const float* mod = MOD + (size_t)l * 3 * 6144;
        if (l > 0) prep_rest(p, lds, l);
        if (l & 1) zero_osum(p);
        norm_phase<false>(X, PIN(I_N1W) + l * 1024, mod + 0, mod + 1024, HN, nullptr);
        GSYNC();
        { const int n1 = isAB ? 2560 : 2816;
          pg8::Gemm g{HN, (const bf16_t*)(ws + WS_WIN), NT, n1, 1024}; pg8::StaticOrder S; S.init(NT, n1, G, bid); EpiProj E{PROJ, PLD};
          pg8::gemm_phase<EpiProj, pg8::StaticOrder>(lds, g, S, E, nullptr); }
        GSYNC();
        if (isAB) {
            ab_pre(p, lds, jl); GSYNC();
            ab_chain(p, lds, jl, xsub); GSYNC();
            ab_fin(p, jl); GSYNC();
        } else {
            cd_pre(p, lds, jl); GSYNC();
            cd_chain(p, lds, jl, xsub); GSYNC();
            cd_combine(p, jl); GSYNC();
            { pg8::Gemm g{(const bf16_t*)(ws + WS_ZG), (const bf16_t*)(ws + WS_WGLU), NT, 512, 512}; pg8::StaticOrder S; S.init(NT, 512, G, bid);
              EpiGLU E{HN, (const bf16_t*)(ws + WS_ZG), PIN(I_GLUB) + jl * 512};
              pg8::gemm_phase<EpiGLU, pg8::StaticOrder>(lds, g, S, E, nullptr);
              if (bid >= 96) chain_combine(p, PIN(I_DNNW) + jl * 128, 2048, 512, 96); }
            GSYNC();
        }
        { pg8::Gemm g{HN, (const bf16_t*)(ws + WS_WOUT), NT, 1024, 1024}; pg8::StaticOrder S; S.init(NT, 1024, G, bid); EpiResid E{X, mod + 2048};
          pg8::gemm_phase<EpiResid, pg8::StaticOrder>(lds, g, S, E, nullptr); }
        GSYNC();
        norm_phase<false>(X, PIN(I_N2W) + l * 1024, mod + 3072, mod + 4096, HN, nullptr);
        GSYNC();
        { pg8::Gemm g{HN, (const bf16_t*)(ws + WS_WGU), NT, 5632, 1024}; pg8::StaticOrder S; S.init(NT, 5632, G, bid); EpiSwiGLU E{PROJ};
          pg8::gemm_phase<EpiSwiGLU, pg8::StaticOrder>(lds, g, S, E, nullptr); }
        GSYNC();
        { pg8::Gemm g{PROJ, (const bf16_t*)(ws + WS_WDN), NT, 1024, 2816}; pg8::StaticOrder S; S.init(NT, 1024, G, bid); EpiResid E{X, mod + 5120};
          pg8::gemm_phase<EpiResid, pg8::StaticOrder>(lds, g, S, E, nullptr);
          if (bid >= 192 && l < 3) prep_in_out(p, lds, l + 1, 192); }
        GSYNC();
    }
    norm_phase<true>(X, PIN(I_FNW), nullptr, nullptr, nullptr, POUT() + OUT_Y);
}

extern "C" void kernel_launch(void* const* d_in, const int* in_sizes, int n_in, void* d_out, int out_size, void* d_ws, size_t ws_size, hipStream_t stream) {
    static int grid_blocks = 0;
    if (grid_blocks == 0) {
        if (n_in != 44 || ws_size < WS_END) { fprintf(stderr, "kernel_launch: need 44 inputs and %zu bytes of workspace; got %d, %zu\n", (size_t)WS_END, n_in, ws_size); grid_blocks = -1; return; }
        int dev = 0, cus = 0, per_cu = 0;
        (void)hipGetDevice(&dev); (void)hipDeviceGetAttribute(&cus, hipDeviceAttributeMultiprocessorCount, dev);
        if (hipFuncSetAttribute((const void*)fwd_mega, hipFuncAttributeMaxDynamicSharedMemorySize, LDS_BYTES) != hipSuccess) { fprintf(stderr, "kernel_launch: hipFuncSetAttribute failed\n"); grid_blocks = -1; return; }
        if (hipOccupancyMaxActiveBlocksPerMultiprocessor(&per_cu, (const void*)fwd_mega, 512, LDS_BYTES) != hipSuccess || per_cu < 1) { fprintf(stderr, "kernel_launch: occupancy query gave %d\n", per_cu); per_cu = 1; }
        (void)hipGetLastError();
        grid_blocks = cus;
    }
    if (grid_blocks < 0) return;
    if (hipMemsetAsync((char*)d_ws + WS_BAR, 0, 32768, stream) != hipSuccess) { fprintf(stderr, "kernel_launch: memset failed\n"); return; }
    Params p{};
    for (int i = 0; i < 44; ++i) p.in[i] = (const float*)d_in[i];
    p.out = (float*)d_out; p.ws = (unsigned char*)d_ws;
    void* args[] = {&p};
    hipError_t e = hipLaunchCooperativeKernel((const void*)fwd_mega, dim3(grid_blocks), dim3(512), args, LDS_BYTES, stream);
    if (e != hipSuccess) fprintf(stderr, "cooperative launch failed: %s (grid %d)\n", hipGetErrorString(e), grid_blocks);
}
```
